# Optimizing an MI355X kernel written in HIP

```python
import jax, jax.numpy as jnp
from jax import lax
import numpy as np

D_MODEL = 1024
BATCH = 4
SEQ = 4096
DEPTH = 4

GRID_W = 64
CTX_LEN = 256
HEAD_DIM = 64
A_GROUPS = 4
A_W = A_GROUPS * HEAD_DIM
CHUNK = 128
ATT_HEADS = 8
ATT_KV_HEADS = 2
ATT_Q = ATT_HEADS * HEAD_DIM
ATT_KV = ATT_KV_HEADS * HEAD_DIM
WINDOW = 128
QBLOCK = 128
ROPE_THETA = 10000.0
ROPE_FREQS = HEAD_DIM // 4
NEG_INF = -1e30
RW_HEADS = 4
RW_W = RW_HEADS * HEAD_DIM
W_LORA = 64
A_LORA = 64
G_LORA = 128
N_DIR = 2
GN_EPS = 64e-5
MIX_W = A_W + ATT_Q + RW_W
D_FF = -(-8 * D_MODEL // (3 * 256)) * 256
RMS_EPS = 1e-6
OFF_Q = 2 * A_W
OFF_R = OFF_Q + ATT_Q
OFF_CTX = OFF_R + RW_W + G_LORA
OFF_RWK = OFF_CTX + 2 * ATT_KV
IN_COLS = OFF_RWK + 2 * RW_W + N_DIR * (W_LORA + A_LORA)
MU_HEAD = RW_W + G_LORA
MU_W = MU_HEAD + 2 * RW_W + N_DIR * (W_LORA + A_LORA)

kernel_name = 'hybrid_flow_trunk'


def rms_norm(x, g):
    xf = x.astype(jnp.float32)
    y = xf * lax.rsqrt(jnp.mean(xf * xf, axis=-1, keepdims=True) + RMS_EPS)
    return (y * g.astype(jnp.float32)).astype(x.dtype)


def layer_norm(x, g, b):
    xf = x.astype(jnp.float32)
    mu = jnp.mean(xf, axis=-1, keepdims=True)
    var = jnp.mean(jnp.square(xf - mu), axis=-1, keepdims=True)
    return ((xf - mu) * lax.rsqrt(var + 1e-5) * g + b).astype(x.dtype)


def modulate(x, shift, scale):
    return x * (1.0 + scale) + shift


def swiglu(h, w_gu, w_down):
    gu = h @ w_gu
    return (jax.nn.silu(gu[..., :D_FF]) * gu[..., D_FF:]) @ w_down


def spatial_gating(z, ln_g, ln_b, w_s, b_s):
    z = jax.nn.gelu(z)
    u, v = z[..., :A_W], z[..., A_W:]
    B, T, _ = v.shape
    v = layer_norm(v, ln_g, ln_b).reshape(B, T // CHUNK, CHUNK, A_GROUPS, HEAD_DIM)
    mixed = jnp.einsum('gpq,bnqgd->bnpgd', w_s, v) + b_s.T[None, None, :, :, None]
    return u * mixed.reshape(B, T, A_W)


def rope_tables(T):
    t = jnp.arange(T)
    pos = jnp.stack([t // GRID_W, t % GRID_W], axis=-1).astype(jnp.float32)
    inv = ROPE_THETA ** (-jnp.arange(ROPE_FREQS, dtype=jnp.float32) / ROPE_FREQS)
    ang = pos[:, :, None] * inv
    return jnp.cos(ang), jnp.sin(ang)


def apply_rope(x, cos, sin):
    B, T, H, Dh = x.shape
    xr = x.astype(jnp.float32).reshape(B, T, H, 2, 2, ROPE_FREQS)
    x1, x2 = xr[..., 0, :], xr[..., 1, :]
    c, s = cos[None, :, None], sin[None, :, None]
    out = jnp.stack([x1 * c - x2 * s, x2 * c + x1 * s], axis=-2)
    return out.reshape(B, T, H, Dh).astype(x.dtype)


def window_attention(q, k, v, kc, vc, sink):
    B, T, H, Dh = q.shape
    G = H // ATT_KV_HEADS
    nb = T // QBLOCK
    C = kc.shape[1]
    scale = Dh ** -0.5
    qb = q.reshape(B, nb, QBLOCK, ATT_KV_HEADS, G, Dh)

    def band(t):
        tp = jnp.pad(t, ((0, 0), (QBLOCK, QBLOCK), (0, 0), (0, 0))).reshape(B, nb + 2, QBLOCK, ATT_KV_HEADS, Dh)
        return jnp.concatenate([tp[:, :-2], tp[:, 1:-1], tp[:, 2:]], axis=2)

    kw, vw = band(k), band(v)
    s_loc = jnp.einsum('bnqhgd,bnkhd->bnhgqk', qb, kw).astype(jnp.float32) * scale
    s_ctx = jnp.einsum('bnqhgd,bchd->bnhgqc', qb, kc).astype(jnp.float32) * scale
    qi = jnp.arange(QBLOCK)[:, None]
    kj = jnp.arange(3 * QBLOCK)[None, :]
    in_band = jnp.abs(kj - QBLOCK - qi) <= WINDOW
    kpos = jnp.arange(nb)[:, None] * QBLOCK - QBLOCK + jnp.arange(3 * QBLOCK)[None, :]
    in_seq = (kpos >= 0) & (kpos < T)
    mask = in_band[None] & in_seq[:, None, :]
    s_loc = jnp.where(mask[None, :, None, None], s_loc, NEG_INF)
    sink_l = jnp.broadcast_to(sink.astype(jnp.float32).reshape(ATT_KV_HEADS, G, 1, 1), s_ctx.shape[:-1] + (1,))
    p = jax.nn.softmax(jnp.concatenate([sink_l, s_ctx, s_loc], axis=-1), axis=-1)
    p_ctx = p[..., 1:1 + C].astype(v.dtype)
    p_loc = p[..., 1 + C:].astype(v.dtype)
    o = jnp.einsum('bnhgqc,bchd->bnqhgd', p_ctx, vc) + jnp.einsum('bnhgqk,bnkhd->bnqhgd', p_loc, vw)
    return o.reshape(B, T, H * Dh)


def context_attention(qc, kc, vc, sink):
    B, C, H, Dh = qc.shape
    G = H // ATT_KV_HEADS
    qg = qc.reshape(B, C, ATT_KV_HEADS, G, Dh)
    s = jnp.einsum('bqhgd,bkhd->bhgqk', qg, kc).astype(jnp.float32) * Dh ** -0.5
    sink_l = jnp.broadcast_to(sink.astype(jnp.float32).reshape(ATT_KV_HEADS, G, 1, 1), s.shape[:-1] + (1,))
    p = jax.nn.softmax(jnp.concatenate([sink_l, s], axis=-1), axis=-1)[..., 1:].astype(vc.dtype)
    return jnp.einsum('bhgqk,bkhd->bqhgd', p, vc).reshape(B, C, H * Dh)


def grid_shift(f):
    B, T, C = f.shape
    rows = T // GRID_W
    g = f.reshape(B, rows, GRID_W, C)
    q = C // 4
    left = jnp.pad(g[:, :, :-1, :q], ((0, 0), (0, 0), (1, 0), (0, 0)))
    right = jnp.pad(g[:, :, 1:, q:2 * q], ((0, 0), (0, 0), (0, 1), (0, 0)))
    up = jnp.pad(g[:, :-1, :, 2 * q:3 * q], ((0, 0), (1, 0), (0, 0), (0, 0)))
    down = jnp.pad(g[:, 1:, :, 3 * q:], ((0, 0), (0, 1), (0, 0), (0, 0)))
    return jnp.concatenate([left, right, up, down], axis=-1).reshape(B, T, C)


def seq_shift(f):
    h = f.shape[-1] // 2
    prev = jnp.pad(f[:, :-1, :h], ((0, 0), (1, 0), (0, 0)))
    nxt = jnp.pad(f[:, 1:, h:], ((0, 0), (0, 1), (0, 0)))
    return jnp.concatenate([prev, nxt], axis=-1)


def token_mix(f, shifted, mu):
    return f + (shifted - f) * mu


def heads(t):
    return t.reshape(t.shape[:-1] + (RW_HEADS, HEAD_DIM))


def rwkv_inputs(rwk, lp):
    f = rwk.astype(jnp.float32)
    base = 2 * RW_W
    k = f[..., :RW_W]
    v = f[..., RW_W:base]
    wd = f[..., base:base + N_DIR * W_LORA].reshape(f.shape[:-1] + (N_DIR, W_LORA))
    ad = f[..., base + N_DIR * W_LORA:].reshape(f.shape[:-1] + (N_DIR, A_LORA))
    kk = heads(k * lp['rw_kk'])
    kk = kk / jnp.maximum(jnp.sqrt(jnp.sum(kk * kk, axis=-1, keepdims=True)), 1e-12)
    z = lp['rw_w0'] + jnp.einsum('btdr,drc->btdc', jnp.tanh(wd), lp['rw_w2'])
    w = jnp.exp(-jnp.exp(-jax.nn.softplus(-z) - 0.5))
    a = jax.nn.sigmoid(lp['rw_a0'] + jnp.einsum('btdr,drc->btdc', ad, lp['rw_a2']))
    kd = k[..., None, :] * (1.0 + (a - 1.0) * lp['rw_ka'])
    return heads(v), kk, heads(w), heads(a), heads(kd)


def wkv_scan(w, k, v, kk, a, s0, reverse, r):
    tm = lambda t: jnp.moveaxis(t, 1, 0)

    def update(S, w_t, k_t, v_t, kk_t, a_t):
        sa = jnp.einsum('bhvk,bhk->bhv', S, kk_t)
        return (S * w_t[:, :, None, :] - sa[..., None] * (kk_t * a_t)[:, :, None, :]
                + v_t[..., None] * k_t[:, :, None, :])

    xs = (tm(w), tm(k), tm(v), tm(kk), tm(a))
    if r is None:
        S, _ = lax.scan(lambda S, x: (update(S, *x), None), s0, xs, reverse=reverse)
        return S, None

    def step(S, x):
        S = update(S, *x[1:])
        return S, jnp.einsum('bhvk,bhk->bhv', S, x[0])

    S, y = lax.scan(step, s0, (tm(r),) + xs, reverse=reverse)
    return S, jnp.moveaxis(y, 0, 1)


def rwkv_output(y, r, kd, v, gd, lp):
    B, T = y.shape[:2]
    mu = jnp.mean(y, axis=-1, keepdims=True)
    var = jnp.mean(jnp.square(y - mu), axis=-1, keepdims=True)
    yn = ((y - mu) * lax.rsqrt(var + GN_EPS)).reshape(B, T, RW_W) * lp['rw_lnx_g'] + lp['rw_lnx_b']
    bonus = jnp.sum(r[:, :, None] * kd * lp['rw_rk'], axis=-1, keepdims=True).sum(axis=2) * v
    g = jax.nn.sigmoid(gd) @ lp['rw_g2']
    return (yn + bonus.reshape(B, T, RW_W)) * g


def mix_tokens(h, hc, lp, last):
    B, T, _ = h.shape
    C = hc.shape[1]
    w_in = lp['w_in']
    mu = lp['rw_mu']
    px = h @ w_in
    pc_tail = hc @ w_in[:, OFF_CTX:]
    kc = pc_tail[..., :ATT_KV].reshape(B, C, ATT_KV_HEADS, HEAD_DIM)
    vc = pc_tail[..., ATT_KV:2 * ATT_KV].reshape(B, C, ATT_KV_HEADS, HEAD_DIM)
    rwk_c = pc_tail[..., 2 * ATT_KV:]
    vC, kkC, wC, aC, kdC = rwkv_inputs(token_mix(rwk_c, seq_shift(rwk_c), mu[MU_HEAD:]), lp)
    rC = None
    if not last:
        pc_head = hc @ w_in[:, :OFF_CTX]
        rg_c = pc_head[..., OFF_R:]
        rg_c = token_mix(rg_c, seq_shift(rg_c), mu[:MU_HEAD])
        rC = heads(rg_c[..., :RW_W].astype(jnp.float32))
    s0 = jnp.zeros((B, RW_HEADS, HEAD_DIM, HEAD_DIM), jnp.float32)
    Sc_f, yc_f = wkv_scan(wC[:, :, 0], kdC[:, :, 0], vC, kkC, aC[:, :, 0], s0, False, rC)
    Sc_b, yc_b = wkv_scan(wC[:, :, 1], kdC[:, :, 1], vC, kkC, aC[:, :, 1], s0, True, rC)

    cos, sin = rope_tables(T)
    q = apply_rope(px[..., OFF_Q:OFF_R].reshape(B, T, ATT_HEADS, HEAD_DIM), cos, sin)
    k = apply_rope(px[..., OFF_CTX:OFF_CTX + ATT_KV].reshape(B, T, ATT_KV_HEADS, HEAD_DIM), cos, sin)
    v = px[..., OFF_CTX + ATT_KV:OFF_RWK].reshape(B, T, ATT_KV_HEADS, HEAD_DIM)
    o_att = window_attention(q, k, v, kc, vc, lp['attn_sink'])
    o_sg = spatial_gating(px[..., :OFF_Q], lp['sg_ln_g'], lp['sg_ln_b'], lp['sg_w'], lp['sg_b'])
    rg = px[..., OFF_R:OFF_CTX]
    rg = token_mix(rg, grid_shift(rg), mu[:MU_HEAD])
    rwk = px[..., OFF_RWK:]
    vX, kkX, wX, aX, kdX = rwkv_inputs(token_mix(rwk, grid_shift(rwk), mu[MU_HEAD:]), lp)
    rX = heads(rg[..., :RW_W].astype(jnp.float32))
    _, y_f = wkv_scan(wX[:, :, 0], kdX[:, :, 0], vX, kkX, aX[:, :, 0], Sc_f, False, rX)
    _, y_b = wkv_scan(wX[:, :, 1], kdX[:, :, 1], vX, kkX, aX[:, :, 1], Sc_b, True, rX)
    o_rw = rwkv_output(y_f + y_b, rX, kdX, vX, rg[..., RW_W:], lp).astype(h.dtype)
    y = jnp.concatenate([o_sg, o_att, o_rw], axis=-1) @ lp['w_out']
    if last:
        return y, None

    qc = pc_head[..., OFF_Q:OFF_R].reshape(B, C, ATT_HEADS, HEAD_DIM)
    oc_att = context_attention(qc, kc, vc, lp['attn_sink'])
    oc_sg = spatial_gating(pc_head[..., :OFF_Q], lp['sg_ln_g'], lp['sg_ln_b'], lp['sg_w'], lp['sg_b'])
    oc_rw = rwkv_output(yc_f + yc_b, rC, kdC, vC, rg_c[..., RW_W:], lp).astype(hc.dtype)
    yc = jnp.concatenate([oc_sg, oc_att, oc_rw], axis=-1) @ lp['w_out']
    return y, yc


def trunk_layer(x, xc, c_act, cc_act, lp, last):
    D = D_MODEL
    g = lp['norm_g']
    sh1, sc1, gt1, sh2, sc2, gt2 = [m[:, None, :] for m in jnp.split(c_act @ lp['w_mod'] + lp['b_mod'], 6, axis=-1)]
    n_ctx = 2 if last else 6
    mc = jnp.split(cc_act @ lp['w_mod'][:, :n_ctx * D] + lp['b_mod'][:n_ctx * D], n_ctx)
    h = modulate(rms_norm(x, g[0]), sh1, sc1)
    hc = modulate(rms_norm(xc, g[0]), mc[0], mc[1])
    y, yc = mix_tokens(h, hc, lp, last)
    x = x + gt1 * rms_norm(y, g[1])
    h = modulate(rms_norm(x, g[2]), sh2, sc2)
    x = x + gt2 * rms_norm(swiglu(h, lp['w_gu'], lp['w_down']), g[3])
    if last:
        return x, xc
    xc = xc + mc[2] * rms_norm(yc, g[1])
    hc = modulate(rms_norm(xc, g[2]), mc[3], mc[4])
    xc = xc + mc[5] * rms_norm(swiglu(hc, lp['w_gu'], lp['w_down']), g[3])
    return x, xc


def setup_inputs(seed: int = 0) -> dict:
    key = jax.random.key(seed)
    k = jax.random.split(key, 27)
    D, L = D_MODEL, DEPTH
    f32 = jnp.float32
    nrm = lambda i, shape, s: jax.random.normal(k[i], shape, f32) * s
    return {
        'x': nrm(0, (BATCH, SEQ, D), 1.0),
        'c': nrm(1, (BATCH, D), 1.0),
        'ctx': nrm(2, (BATCH, CTX_LEN, D), 1.0),
        'c_ctx': nrm(3, (D,), 1.0),
        'w_mod': nrm(4, (L, D, 6 * D), 0.5 * D ** -0.5),
        'b_mod': nrm(5, (L, 6 * D), 0.01),
        'norm_g': 1.0 + nrm(6, (L, 4, D), 0.05),
        'w_in': nrm(7, (L, D, IN_COLS), D ** -0.5),
        'w_out': nrm(8, (L, MIX_W, D), MIX_W ** -0.5),
        'sg_ln_g': 1.0 + nrm(9, (L, A_W), 0.05),
        'sg_ln_b': nrm(10, (L, A_W), 0.01),
        'sg_w': nrm(11, (L, A_GROUPS, CHUNK, CHUNK), CHUNK ** -0.5),
        'sg_b': 1.0 + nrm(12, (L, A_GROUPS, CHUNK), 0.05),
        'attn_sink': nrm(13, (L, ATT_HEADS), 0.5),
        'rw_mu': jax.random.uniform(k[14], (L, MU_W), f32),
        'rw_w0': -1.0 + nrm(15, (L, N_DIR, RW_W), 0.5),
        'rw_w2': nrm(16, (L, N_DIR, W_LORA, RW_W), 0.5 * W_LORA ** -0.5),
        'rw_a0': nrm(17, (L, N_DIR, RW_W), 0.5),
        'rw_a2': nrm(18, (L, N_DIR, A_LORA, RW_W), 0.5 * A_LORA ** -0.5),
        'rw_kk': 0.85 + nrm(19, (L, RW_W), 0.05),
        'rw_ka': 1.0 + nrm(20, (L, RW_W), 0.05),
        'rw_rk': nrm(21, (L, RW_HEADS, HEAD_DIM), 0.1),
        'rw_g2': nrm(22, (L, G_LORA, RW_W), G_LORA ** -0.5),
        'rw_lnx_g': 1.0 + nrm(23, (L, RW_W), 0.05),
        'rw_lnx_b': nrm(24, (L, RW_W), 0.01),
        'w_gu': nrm(25, (L, D, 2 * D_FF), D ** -0.5),
        'w_down': nrm(26, (L, D_FF, D), D_FF ** -0.5),
    }


def reference(x, c, ctx, c_ctx, w_mod, b_mod, norm_g, w_in, w_out, sg_ln_g, sg_ln_b, sg_w, sg_b,
              attn_sink, rw_mu, rw_w0, rw_w2, rw_a0, rw_a2, rw_kk, rw_ka, rw_rk, rw_g2,
              rw_lnx_g, rw_lnx_b, w_gu, w_down):
    c_act = jax.nn.silu(c)
    cc_act = jax.nn.silu(c_ctx)
    xc = ctx
    for l in range(DEPTH):
        lp = {
            'w_mod': w_mod[l], 'b_mod': b_mod[l], 'norm_g': norm_g[l],
            'w_in': w_in[l], 'w_out': w_out[l],
            'sg_ln_g': sg_ln_g[l], 'sg_ln_b': sg_ln_b[l], 'sg_w': sg_w[l], 'sg_b': sg_b[l],
            'attn_sink': attn_sink[l], 'rw_mu': rw_mu[l],
            'rw_w0': rw_w0[l], 'rw_w2': rw_w2[l], 'rw_a0': rw_a0[l], 'rw_a2': rw_a2[l],
            'rw_kk': rw_kk[l], 'rw_ka': rw_ka[l], 'rw_rk': rw_rk[l], 'rw_g2': rw_g2[l],
            'rw_lnx_g': rw_lnx_g[l], 'rw_lnx_b': rw_lnx_b[l],
            'w_gu': w_gu[l], 'w_down': w_down[l],
        }
        x, xc = trunk_layer(x, xc, c_act, cc_act, lp, l == DEPTH - 1)
    return x
```

```cpp
#include <hip/hip_runtime.h>
#include <hip/hip_cooperative_groups.h>
#include <cstdio>
#include <cstdint>
namespace cg = cooperative_groups;
namespace pg8 {
#define PG8_LAS __attribute__((address_space(3)))
typedef unsigned short bf16_t;
typedef short bf16x8 __attribute__((ext_vector_type(8)));
typedef float f32x4 __attribute__((ext_vector_type(4)));
typedef unsigned u32x4 __attribute__((ext_vector_type(4)));
constexpr int BM = 256, BK = 64, HALF = 128, HTB = HALF * BK * 2  , STAGE_BYTES = 8 * HTB, NXCD = 8, WGM = 8;

__host__ __device__ __forceinline__ int lds_byte(int r, int c) { const int st = (r >> 4) * 2 + (c >> 5), rr = r & 15, cc = c & 31, ob = rr * 64 + cc * 2; return st * 1024 + (ob ^ (((ob >> 9) & 1) << 5)); }
__host__ __device__ __forceinline__ void stage_rc(int b, int& R, int& C) { const int st = b / 1024, sb = b % 1024, swz = sb ^ (((sb >> 9) & 1) << 5); R = (st >> 1) * 16 + swz / 64; C = (st & 1) * 32 + (swz % 64) / 2; }
__host__ __device__ __forceinline__ int perm32(int rho) { const int n = rho >> 4, i = rho & 15; return 8 * (i >> 2) + 4 * n + (i & 3); }

struct Unit { int pm, pn; };
struct Gemm { const bf16_t* A; const bf16_t* Bt; int M, N, K; };

struct StaticOrder {
    int nM, nN, nwg, G, c;
    __host__ __device__ void init(int M, int N, int G_, int c_) { nM = M / BM; nN = N / BM; nwg = nM * nN; G = G_; c = c_; }
    __host__ __device__ bool next(int i, Unit& u) const {
        const long L = (long)i * G + c; if (L >= nwg) return false;
        int wgid = (int)L; { const int q = nwg / NXCD, r = nwg % NXCD, xcd = wgid % NXCD, off = wgid / NXCD; wgid = (xcd < r ? xcd * (q + 1) : r * (q + 1) + (xcd - r) * q) + off; }
        const int nig = WGM * nN, gid = wgid / nig, fm = gid * WGM, gsz = (nM - fm) < WGM ? (nM - fm) : WGM;
        u.pm = fm + ((wgid % nig) % gsz); u.pn = (wgid % nig) / gsz; return true;
    }
    __device__ __forceinline__ void a_ready(const Unit&) const {}
    __device__ __forceinline__ void done(const Unit&) const {}
};
__device__ __forceinline__ unsigned cvt_pk_bf16(float lo, float hi) { unsigned r; asm volatile("v_cvt_pk_bf16_f32 %0, %1, %2" : "=v"(r) : "v"(lo), "v"(hi)); return r; }
template <class Epi, class Sched, bool ALIGN_EPI = false, bool SP2 = false>
__device__ __forceinline__ void gemm_phase(PG8_LAS unsigned char* lds, const Gemm g, const Sched& S, const Epi& E) {
    const int tid = threadIdx.x, wid = __builtin_amdgcn_readfirstlane(tid >> 6), lane = tid & 63, wr = wid >> 2, wc = wid & 3, fr = lane & 15, fq = lane >> 4;
    const int K = g.K, nt = K / BK;
    unsigned voffA[2], voffB[2];
#pragma unroll
    for (int i = 0; i < 2; ++i) { int R, C; stage_rc(tid * 16 + i * 8192, R, C); const int Rb = Epi::PERM ? ((R & ~31) + perm32(R & 31)) : R;
        voffA[i] = (unsigned)(R * K + C) * 2u; voffB[i] = (unsigned)(Rb * K + C) * 2u; }
    const size_t kstep = (size_t)(BK * 2);
    const size_t hstep = (size_t)HALF * K * 2;
    const size_t tstep = 2 * hstep;
    const unsigned ldsw = (unsigned)wid * 1024u;
    const int aoff = lds_byte(wr * 64 + fr, fq * 8), boff = lds_byte(wc * 32 + fr, fq * 8);
#define PG8_SA(b, h) (((b) * 2 + (h)) * HTB)
#define PG8_SB(b, h) ((4 + (b) * 2 + (h)) * HTB)
#define PG8_STAGE(bufoff, gbase, voff) do { _Pragma("unroll") for (int _i = 0; _i < 2; ++_i) \
        __builtin_amdgcn_global_load_lds((const unsigned*)((const char*)(gbase) + (voff)[_i]), (PG8_LAS unsigned*)(lds + (bufoff) + ldsw + _i * 8192), 16, 0, 0); } while (0)
#define PG8_LDA(dst, b, h) do { _Pragma("unroll") for (int m = 0; m < 4; ++m) _Pragma("unroll") for (int k = 0; k < 2; ++k) dst[m][k] = *(const PG8_LAS bf16x8*)(lds + PG8_SA(b, h) + aoff + m * 2048 + k * 1024); } while (0)
#define PG8_LDB(dst, b, h) do { _Pragma("unroll") for (int n = 0; n < 2; ++n) _Pragma("unroll") for (int k = 0; k < 2; ++k) dst[n][k] = *(const PG8_LAS bf16x8*)(lds + PG8_SB(b, h) + boff + n * 2048 + k * 1024); } while (0)
#define PG8_MMA(ai, bj, At, Bt) do { __builtin_amdgcn_s_setprio(1); _Pragma("unroll") for (int m = 0; m < 4; ++m) _Pragma("unroll") for (int n = 0; n < 2; ++n) _Pragma("unroll") for (int k = 0; k < 2; ++k) \
        acc[ai][bj][m][n] = __builtin_amdgcn_mfma_f32_16x16x32_bf16(Bt[n][k], At[m][k], acc[ai][bj][m][n], 0, 0, 0); __builtin_amdgcn_s_setprio(0); } while (0)
#define PG8_WAIT_V(n) asm volatile("s_waitcnt vmcnt(" #n ")" ::: "memory")
#define PG8_WAIT_L(n) asm volatile("s_waitcnt lgkmcnt(" #n ")" ::: "memory")
#define PG8_BAR __builtin_amdgcn_s_barrier()
#define PG8_SCHED __builtin_amdgcn_sched_barrier(0)
    Unit cur, nxt; int ui = 0;
    if (!S.next(0, cur)) return;
    f32x4 acc[2][2][4][2];
#pragma unroll
    for (int a = 0; a < 2; ++a)
#pragma unroll
        for (int b = 0; b < 2; ++b)
#pragma unroll
            for (int m = 0; m < 4; ++m)
#pragma unroll
                for (int n = 0; n < 2; ++n) acc[a][b][m][n] = (f32x4){0.f, 0.f, 0.f, 0.f};
    bf16x8 At[4][2], B0[2][2], B1[2][2];
    const char* cA = (const char*)g.A + (size_t)cur.pm * tstep; const char* cB = (const char*)g.Bt + (size_t)cur.pn * tstep;
    S.a_ready(cur);
    if constexpr (SP2) {
        PG8_STAGE(PG8_SB(0, 0), cB, voffB); PG8_STAGE(PG8_SB(0, 1), cB + hstep, voffB); PG8_STAGE(PG8_SA(0, 0), cA, voffA); PG8_STAGE(PG8_SA(0, 1), cA + hstep, voffA);
        if (wr == 1) PG8_BAR;
        PG8_WAIT_V(2); PG8_BAR;
        PG8_STAGE(PG8_SB(1, 0), cB + kstep, voffB); PG8_STAGE(PG8_SA(1, 0), cA + kstep, voffA); PG8_STAGE(PG8_SB(1, 1), cB + hstep + kstep, voffB);
        PG8_WAIT_V(6); PG8_BAR;
    } else {
        PG8_STAGE(PG8_SB(0, 0), cB, voffB); PG8_STAGE(PG8_SA(0, 0), cA, voffA); PG8_STAGE(PG8_SB(0, 1), cB + hstep, voffB); PG8_STAGE(PG8_SA(0, 1), cA + hstep, voffA);
        if (wr == 1) PG8_BAR;
        PG8_WAIT_V(4); PG8_BAR;
        PG8_STAGE(PG8_SB(1, 0), cB + kstep, voffB); PG8_STAGE(PG8_SA(1, 0), cA + kstep, voffA); PG8_STAGE(PG8_SB(1, 1), cB + hstep + kstep, voffB);
        PG8_WAIT_V(6); PG8_BAR;
    }
    for (;;) {
        const bool has_next = S.next(ui + 1, nxt);
        const char* nA = has_next ? (const char*)g.A + (size_t)nxt.pm * tstep : cA; const char* nB = has_next ? (const char*)g.Bt + (size_t)nxt.pn * tstep : cB;
        for (int t = 0; t < nt; t += 2) {
            const bool last = (t == nt - 2);
            const char* a1 = cA + (size_t)(t + 1) * kstep;
            const char* a2 = last ? nA : cA + (size_t)(t + 2) * kstep; const char* b2 = last ? nB : cB + (size_t)(t + 2) * kstep;
            const char* a3 = a2 + kstep; const char* b3 = b2 + kstep;
            if (last && has_next) S.a_ready(nxt);
            if constexpr (SP2) {
            PG8_LDB(B0, 0, 0); PG8_LDB(B1, 0, 1); PG8_SCHED; PG8_LDA(At, 0, 0); PG8_STAGE(PG8_SA(1, 1), a1 + hstep, voffA);
            PG8_WAIT_V(8); PG8_WAIT_L(0); PG8_BAR; PG8_MMA(0, 0, At, B0); PG8_MMA(0, 1, At, B1); PG8_BAR; PG8_SCHED;
            PG8_LDA(At, 0, 1); PG8_STAGE(PG8_SB(0, 0), b2, voffB); PG8_STAGE(PG8_SB(0, 1), b2 + hstep, voffB); PG8_STAGE(PG8_SA(0, 0), a2, voffA);
            PG8_WAIT_V(8); PG8_WAIT_L(0); PG8_BAR; PG8_MMA(1, 0, At, B0); PG8_MMA(1, 1, At, B1); PG8_BAR; PG8_SCHED;
            PG8_LDB(B0, 1, 0); PG8_LDB(B1, 1, 1); PG8_SCHED; PG8_LDA(At, 1, 0); PG8_STAGE(PG8_SA(0, 1), a2 + hstep, voffA);
            PG8_WAIT_V(8); PG8_WAIT_L(0); PG8_BAR; PG8_MMA(0, 0, At, B0); PG8_MMA(0, 1, At, B1); PG8_BAR; PG8_SCHED;
            PG8_LDA(At, 1, 1); PG8_STAGE(PG8_SB(1, 0), b3, voffB); PG8_STAGE(PG8_SB(1, 1), b3 + hstep, voffB); PG8_STAGE(PG8_SA(1, 0), a3, voffA);
            PG8_WAIT_V(8); PG8_WAIT_L(0); PG8_BAR; PG8_MMA(1, 0, At, B0); PG8_MMA(1, 1, At, B1); PG8_BAR; PG8_SCHED;
            } else {
            PG8_LDB(B0, 0, 0); PG8_SCHED; PG8_LDA(At, 0, 0); PG8_STAGE(PG8_SA(1, 1), a1 + hstep, voffA);
            PG8_WAIT_L(8); PG8_BAR; PG8_WAIT_L(0); PG8_MMA(0, 0, At, B0); PG8_BAR; PG8_SCHED;
            PG8_LDB(B1, 0, 1); PG8_STAGE(PG8_SB(0, 0), b2, voffB);
            PG8_BAR; PG8_WAIT_L(0); PG8_MMA(0, 1, At, B1); PG8_BAR;
            PG8_LDA(At, 0, 1); PG8_STAGE(PG8_SA(0, 0), a2, voffA);
            PG8_BAR; PG8_WAIT_L(0); PG8_MMA(1, 0, At, B0); PG8_BAR; PG8_SCHED;
            PG8_STAGE(PG8_SB(0, 1), b2 + hstep, voffB);
            PG8_WAIT_V(6); PG8_BAR; PG8_MMA(1, 1, At, B1); PG8_BAR;
            PG8_LDB(B0, 1, 0); PG8_SCHED; PG8_LDA(At, 1, 0); PG8_STAGE(PG8_SA(0, 1), a2 + hstep, voffA);
            PG8_WAIT_L(8); PG8_BAR; PG8_WAIT_L(0); PG8_MMA(0, 0, At, B0); PG8_BAR; PG8_SCHED;
            PG8_LDB(B1, 1, 1); PG8_STAGE(PG8_SB(1, 0), b3, voffB);
            PG8_BAR; PG8_WAIT_L(0); PG8_MMA(0, 1, At, B1); PG8_BAR;
            PG8_LDA(At, 1, 1); PG8_STAGE(PG8_SA(1, 0), a3, voffA);
            PG8_BAR; PG8_WAIT_L(0); PG8_MMA(1, 0, At, B0); PG8_BAR; PG8_SCHED;
            PG8_STAGE(PG8_SB(1, 1), b3 + hstep, voffB);
            PG8_WAIT_V(6); PG8_BAR; PG8_MMA(1, 1, At, B1); PG8_BAR;
            }
        }
        if constexpr (ALIGN_EPI) { if (wr == 0) PG8_BAR; }
        if constexpr (!Epi::AFTER_DRAIN) { E(acc, cur, wr, wc, fr, fq); S.done(cur); }
        if (!has_next) break;
#pragma unroll
        for (int a = 0; a < 2; ++a)
#pragma unroll
            for (int b = 0; b < 2; ++b)
#pragma unroll
                for (int m = 0; m < 4; ++m)
#pragma unroll
                    for (int n = 0; n < 2; ++n) acc[a][b][m][n] = (f32x4){0.f, 0.f, 0.f, 0.f};
        cur = nxt; cA = nA; cB = nB; ++ui;
        if constexpr (ALIGN_EPI) { if (wr == 1) PG8_BAR; }
    }
    PG8_WAIT_V(0);
    if constexpr (!ALIGN_EPI) { if (wr == 0) PG8_BAR; }
    PG8_BAR;
    if constexpr (Epi::AFTER_DRAIN) { E.fused(acc, cur, wr, wc, fr, fq, lds, wid, lane); S.done(cur); }
#undef PG8_SA
#undef PG8_SB
#undef PG8_STAGE
#undef PG8_LDA
#undef PG8_LDB
#undef PG8_MMA
#undef PG8_WAIT_V
#undef PG8_WAIT_L
#undef PG8_BAR
#undef PG8_SCHED
}
}

#ifndef MK_PER_PHASE
#define MK_PER_PHASE 1
#endif
using pg8::bf16_t; using pg8::bf16x8; using pg8::f32x4; using pg8::u32x4; using pg8::cvt_pk_bf16;
typedef unsigned u32x2 __attribute__((ext_vector_type(2)));
typedef short bf16x4 __attribute__((ext_vector_type(4)));

constexpr int DM = 1024, NB = 4, TL = 4096, CL = 256, NL = 4;
constexpr int ML = NB * TL, MC = NB * CL, MT = ML + MC;
constexpr int NIN = 2560, NPXA = 1280, NPXR = 1152, DFF = 2816, INC = 2432;
constexpr int NTHR = 512;
constexpr int LDS_BYTES = 147456;
constexpr size_t MiB = 1u << 20;
constexpr size_t WS_MODV = 0, WS_ROPE = 1 * MiB, WS_XC = 2 * MiB, WS_WIN = 6 * MiB, WS_WOUT = 11 * MiB, WS_WGU = 13 * MiB, WS_WDN = 24 * MiB;
constexpr size_t WS_HBUF = 30 * MiB, WS_PXA = 64 * MiB, WS_PXR = 107 * MiB, WS_PREP = 184 * MiB, WS_END = 354 * MiB;
constexpr size_t WS_YS = WS_PXR;
constexpr size_t WS_ACT = WS_PREP, WS_YD = 278 * MiB;
constexpr size_t PREP_W = 0, PREP_KA = (size_t)MT * 512 * 4, PREP_KD = 2 * PREP_KA, PREP_KK = 3 * PREP_KA, PREP_R = PREP_KK + (size_t)MT * 256 * 4,
                 PREP_V = PREP_R + (size_t)MT * 256 * 4, PREP_G = PREP_V + (size_t)MT * 256 * 4;
static_assert(WS_HBUF + (size_t)MT * 1024 * 2 <= WS_PXA && WS_PXA + (size_t)MT * NPXA * 2 <= WS_PXR && WS_PXR + (size_t)MT * NPXR * 4 <= WS_PREP, "ws map 1");
static_assert(WS_PREP + PREP_G + (size_t)MT * 256 * 4 <= WS_END && WS_ACT + (size_t)MT * DFF * 2 <= WS_YD && WS_YD + (size_t)MT * 1024 * 4 <= WS_END, "ws map 2");

enum { I_X = 0, I_C, I_CTX, I_CCTX, I_WMOD, I_BMOD, I_NORMG, I_WIN, I_WOUT, I_SGLNG, I_SGLNB, I_SGW, I_SGB, I_SINK, I_MU, I_W0, I_W2, I_A0, I_A2, I_KK, I_KA, I_RK, I_G2, I_LNXG, I_LNXB, I_WGU, I_WDN, N_IN };
struct Args { const float* in[N_IN]; float* out; unsigned char* ws; int ph_lo, ph_hi; };

__device__ __forceinline__ float bf2f(unsigned short h) { return __builtin_bit_cast(float, (unsigned)h << 16); }
__device__ __forceinline__ unsigned short f2bf(float f) { unsigned u = __builtin_bit_cast(unsigned, f); return (unsigned short)((u + 0x7fffu + ((u >> 16) & 1u)) >> 16); }
__device__ __forceinline__ float wave_sum(float v) { v += __shfl_xor(v, 1); v += __shfl_xor(v, 2); v += __shfl_xor(v, 4); v += __shfl_xor(v, 8); v += __shfl_xor(v, 16); v += __shfl_xor(v, 32); return v; }
template <int CTRL> __device__ __forceinline__ float dppf(float x) { return __builtin_bit_cast(float, __builtin_amdgcn_mov_dpp(__builtin_bit_cast(int, x), CTRL, 0xf, 0xf, true)); }
__device__ __forceinline__ float row16_sum(float x) { x += dppf<0xB1>(x); x += dppf<0x4E>(x); x += dppf<0x141>(x); x += dppf<0x128>(x); return x; }
__device__ __forceinline__ float gelu_tanh(float x) { const float u = 0.7978845608028654f * (x + 0.044715f * x * x * x); const float t = 1.f - 2.f / (1.f + __expf(2.f * u)); return 0.5f * x * (1.f + t); }
__device__ __forceinline__ float sigmoidf_(float x) { return 1.f / (1.f + __expf(-x)); }

struct EpiIn {
    static constexpr bool PERM = true, AFTER_DRAIN = false;
    bf16_t* pxa; float* pxr;
    __device__ __forceinline__ void operator()(const f32x4 (&acc)[2][2][4][2], const pg8::Unit& u, int wr, int wc, int fr, int fq) const {
        const int row0 = u.pm * 256 + wr * 64 + fr, colt = u.pn * 256 + wc * 32 + 8 * fq;
#pragma unroll
        for (int ai = 0; ai < 2; ++ai)
#pragma unroll
            for (int m = 0; m < 4; ++m) { const size_t row = (size_t)(row0 + ai * 128 + m * 16);
#pragma unroll
                for (int bj = 0; bj < 2; ++bj) { const int col = colt + bj * 128; const f32x4 v0 = acc[ai][bj][m][0], v1 = acc[ai][bj][m][1];
                    if (u.pn < 5) { u32x4 w; w.x = cvt_pk_bf16(v0[0], v0[1]); w.y = cvt_pk_bf16(v0[2], v0[3]); w.z = cvt_pk_bf16(v1[0], v1[1]); w.w = cvt_pk_bf16(v1[2], v1[3]);
                        *(u32x4*)(pxa + row * NPXA + col) = w; }
                    else { const int cc = col - NPXA; if (cc < NPXR) { *(f32x4*)(pxr + row * NPXR + cc) = v0; *(f32x4*)(pxr + row * NPXR + cc + 4) = v1; } } } }
    }
};
struct EpiF32 {
    static constexpr bool PERM = true, AFTER_DRAIN = false;
    float* O; static constexpr int ldc = DM;
    __device__ __forceinline__ void operator()(const f32x4 (&acc)[2][2][4][2], const pg8::Unit& u, int wr, int wc, int fr, int fq) const {
        const int row0 = u.pm * 256 + wr * 64 + fr, colt = u.pn * 256 + wc * 32 + 8 * fq;
#pragma unroll
        for (int ai = 0; ai < 2; ++ai)
#pragma unroll
            for (int m = 0; m < 4; ++m) { float* rp = O + (size_t)(row0 + ai * 128 + m * 16) * ldc + colt;
#pragma unroll
                for (int bj = 0; bj < 2; ++bj) { *(f32x4*)(rp + bj * 128) = acc[ai][bj][m][0]; *(f32x4*)(rp + bj * 128 + 4) = acc[ai][bj][m][1]; } }
    }
};
struct EpiSwiglu {
    static constexpr bool PERM = true, AFTER_DRAIN = false;
    bf16_t* O;
    __device__ __forceinline__ void operator()(const f32x4 (&acc)[2][2][4][2], const pg8::Unit& u, int wr, int wc, int fr, int fq) const {
        const int row0 = u.pm * 256 + wr * 64 + fr, col = u.pn * 128 + wc * 32 + 8 * fq;
#pragma unroll
        for (int ai = 0; ai < 2; ++ai)
#pragma unroll
            for (int m = 0; m < 4; ++m) { float r[8];
#pragma unroll
                for (int n = 0; n < 2; ++n)
#pragma unroll
                    for (int j = 0; j < 4; ++j) { const float g = acc[ai][0][m][n][j], up = acc[ai][1][m][n][j]; r[n * 4 + j] = g / (1.f + __expf(-g)) * up; }
                u32x4 w; w.x = cvt_pk_bf16(r[0], r[1]); w.y = cvt_pk_bf16(r[2], r[3]); w.z = cvt_pk_bf16(r[4], r[5]); w.w = cvt_pk_bf16(r[6], r[7]);
                *(u32x4*)(O + (size_t)(row0 + ai * 128 + m * 16) * DFF + col) = w; }
    }
};

__device__ __forceinline__ void modv_task(const Args& a, int task, unsigned char* lds) {
    float* act = (float*)lds; float* red = act + 5 * 1024;
    const int tid = threadIdx.x;
    for (int i = tid; i < 5 * 1024; i += NTHR) { const int r = i >> 10, k = i & 1023; const float v = r < 4 ? a.in[I_C][r * 1024 + k] : a.in[I_CCTX][k]; act[i] = v / (1.f + expf(-v)); }
    __syncthreads();
    const int l = task / 48, cb = task % 48, cl = tid & 127, kq = tid >> 7;
    const float* W = a.in[I_WMOD] + (size_t)l * 1024 * 6144 + cb * 128 + cl;
    float a0 = 0.f, a1 = 0.f, a2 = 0.f, a3 = 0.f, a4 = 0.f;
    for (int k = kq * 256; k < kq * 256 + 256; ++k) { const float w = W[(size_t)k * 6144]; a0 += act[k] * w; a1 += act[1024 + k] * w; a2 += act[2048 + k] * w; a3 += act[3072 + k] * w; a4 += act[4096 + k] * w; }
    red[(kq * 5 + 0) * 128 + cl] = a0; red[(kq * 5 + 1) * 128 + cl] = a1; red[(kq * 5 + 2) * 128 + cl] = a2; red[(kq * 5 + 3) * 128 + cl] = a3; red[(kq * 5 + 4) * 128 + cl] = a4;
    __syncthreads();
    float* modv = (float*)(a.ws + WS_MODV);
    for (int i = tid; i < 640; i += NTHR) { const int r = i >> 7, c2 = i & 127;
        const float s = red[(0 * 5 + r) * 128 + c2] + red[(1 * 5 + r) * 128 + c2] + red[(2 * 5 + r) * 128 + c2] + red[(3 * 5 + r) * 128 + c2];
        modv[(size_t)(l * 5 + r) * 6144 + cb * 128 + c2] = s + a.in[I_BMOD][l * 6144 + cb * 128 + c2]; }
    __syncthreads();
}
__device__ __forceinline__ void rope_task(const Args& a, int task) {
    const int idx = task * NTHR + threadIdx.x; const int t = idx >> 5, j = idx & 31, axis = j >> 4, f = j & 15;
    const float pos = (float)(axis == 0 ? (t >> 6) : (t & 63));
    const float inv = powf(10000.0f, -(float)f / 16.0f);
    const float ang = pos * inv;
    float* rc = (float*)(a.ws + WS_ROPE); float* rs = rc + TL * 32;
    rc[idx] = cosf(ang); rs[idx] = sinf(ang);
}
constexpr int WCONV_TASKS = 640 + 256 + 1408 + 704;
__device__ __forceinline__ void wconv_task(const Args& a, int l, int task, unsigned char* lds) {
    const int tid = threadIdx.x;
    const float* src; bf16_t* dst; int Ksz, Nsrc, kt, n0, sc0; bool zero = false;
    if (task < 640) { const int nt = task >> 4; kt = task & 15; Ksz = 1024; Nsrc = INC; src = a.in[I_WIN] + (size_t)l * 1024 * INC; dst = (bf16_t*)(a.ws + WS_WIN); n0 = nt * 64;
        if (n0 < 1024) sc0 = n0; else if (n0 < 1280) sc0 = 1408 + (n0 - 1024); else if (n0 < 1664) sc0 = 1024 + (n0 - 1280); else if (n0 < 2432) sc0 = n0; else { sc0 = 0; zero = true; } }
    else if (task < 896) { const int t = task - 640; const int nt = t >> 4; kt = t & 15; Ksz = 1024; Nsrc = 1024; src = a.in[I_WOUT] + (size_t)l * 1024 * 1024; dst = (bf16_t*)(a.ws + WS_WOUT); n0 = nt * 64; sc0 = n0; }
    else if (task < 2304) { const int t = task - 896; const int nt = t >> 4; kt = t & 15; Ksz = 1024; Nsrc = 2 * DFF; src = a.in[I_WGU] + (size_t)l * 1024 * 2 * DFF; dst = (bf16_t*)(a.ws + WS_WGU); n0 = nt * 64;
        const int tt = n0 >> 8, bj = (n0 >> 7) & 1, jj = n0 & 127; sc0 = bj * DFF + tt * 128 + jj; }
    else { const int t = task - 2304; const int nt = t / 44; kt = t % 44; Ksz = DFF; Nsrc = 1024; src = a.in[I_WDN] + (size_t)l * DFF * 1024; dst = (bf16_t*)(a.ws + WS_WDN); n0 = nt * 64; sc0 = n0; }
    float* tile = (float*)lds;
    { const int c4 = tid & 15;
#pragma unroll
      for (int h = 0; h < 2; ++h) { const int kr = (tid >> 4) + 32 * h; f32x4 v = {0.f, 0.f, 0.f, 0.f};
          if (!zero) v = *(const f32x4*)(src + (size_t)(kt * 64 + kr) * Nsrc + sc0 + c4 * 4);
          tile[kr * 65 + c4 * 4 + 0] = v[0]; tile[kr * 65 + c4 * 4 + 1] = v[1]; tile[kr * 65 + c4 * 4 + 2] = v[2]; tile[kr * 65 + c4 * 4 + 3] = v[3]; } }
    __syncthreads();
    { const int n = tid >> 3, k8 = tid & 7; float r[8];
#pragma unroll
      for (int i = 0; i < 8; ++i) r[i] = tile[(k8 * 8 + i) * 65 + n];
      u32x4 w; w.x = cvt_pk_bf16(r[0], r[1]); w.y = cvt_pk_bf16(r[2], r[3]); w.z = cvt_pk_bf16(r[4], r[5]); w.w = cvt_pk_bf16(r[6], r[7]);
      *(u32x4*)(dst + (size_t)(n0 + n) * Ksz + kt * 64 + k8 * 8) = w; }
    __syncthreads();
}

__device__ __forceinline__ void row_pass(const Args& a, const float* y, const float* xl_src, const float* xc_src, float* xl_dst, float* xc_dst,
                         const float* gy, int l_gate, int gate_idx, bool do_h, const float* gh, int l_h, int shift_idx, int scale_idx) {
    const int lane = threadIdx.x & 63, wave = threadIdx.x >> 6;
    const float* modv = (const float*)(a.ws + WS_MODV); bf16_t* hbuf = (bf16_t*)(a.ws + WS_HBUF);
    for (int row = blockIdx.x * 8 + wave; row < MT; row += gridDim.x * 8) {
        const int mrow = row < ML ? (row >> 12) : 4;
        const float* xs = row < ML ? xl_src + (size_t)row * DM : xc_src + (size_t)(row - ML) * DM;
        f32x4 xv[4];
#pragma unroll
        for (int j = 0; j < 4; ++j) xv[j] = *(const f32x4*)(xs + j * 256 + lane * 4);
        if (y) {
            f32x4 yv[4]; float ss = 0.f;
#pragma unroll
            for (int j = 0; j < 4; ++j) { yv[j] = *(const f32x4*)(y + (size_t)row * DM + j * 256 + lane * 4); ss += yv[j][0] * yv[j][0] + yv[j][1] * yv[j][1] + yv[j][2] * yv[j][2] + yv[j][3] * yv[j][3]; }
            ss = wave_sum(ss); const float rstd = rsqrtf(ss * (1.f / 1024.f) + 1e-6f);
            const float* gate = modv + (size_t)(l_gate * 5 + mrow) * 6144 + gate_idx * 1024;
            float* xd = row < ML ? xl_dst + (size_t)row * DM : xc_dst + (size_t)(row - ML) * DM;
#pragma unroll
            for (int j = 0; j < 4; ++j) { const f32x4 gt = *(const f32x4*)(gate + j * 256 + lane * 4), gg = *(const f32x4*)(gy + j * 256 + lane * 4);
                xv[j] = xv[j] + gt * (yv[j] * rstd * gg); *(f32x4*)(xd + j * 256 + lane * 4) = xv[j]; }
        }
        if (do_h) {
            float ss = 0.f;
#pragma unroll
            for (int j = 0; j < 4; ++j) ss += xv[j][0] * xv[j][0] + xv[j][1] * xv[j][1] + xv[j][2] * xv[j][2] + xv[j][3] * xv[j][3];
            ss = wave_sum(ss); const float rstd = rsqrtf(ss * (1.f / 1024.f) + 1e-6f);
            const float* sh = modv + (size_t)(l_h * 5 + mrow) * 6144 + shift_idx * 1024; const float* sc = modv + (size_t)(l_h * 5 + mrow) * 6144 + scale_idx * 1024;
#pragma unroll
            for (int j = 0; j < 4; ++j) { const f32x4 s1 = *(const f32x4*)(sh + j * 256 + lane * 4), s2 = *(const f32x4*)(sc + j * 256 + lane * 4), gg = *(const f32x4*)(gh + j * 256 + lane * 4);
                const f32x4 h = (xv[j] * rstd * gg) * (1.f + s2) + s1;
                u32x2 w; w.x = cvt_pk_bf16(h[0], h[1]); w.y = cvt_pk_bf16(h[2], h[3]);
                *(u32x2*)(hbuf + (size_t)row * DM + j * 256 + lane * 4) = w; }
        }
    }
}

__device__ __forceinline__ void rwkv_prep_tile(const Args& a, int l, int tile, unsigned char* lds) {
    float* mx = (float*)lds;
    const int tid = threadIdx.x;
    const float* pxr = (const float*)(a.ws + WS_PXR);
    const float* mu = a.in[I_MU] + l * NPXR;
    for (int i = tid; i < 16 * NPXR; i += NTHR) {
        const int tk = i / NPXR, j = i - tk * NPXR; const int row = tile * 16 + tk;
        const float f = pxr[(size_t)row * NPXR + j];
        int nrow; bool valid;
        if (row < ML) { const int t = row & 4095; const int q = j < 384 ? j / 96 : (j - 384) / 192;
            if (q == 0) { valid = (t & 63) > 0; nrow = row - 1; } else if (q == 1) { valid = (t & 63) < 63; nrow = row + 1; }
            else if (q == 2) { valid = t >= 64; nrow = row - 64; } else { valid = t < TL - 64; nrow = row + 64; } }
        else { const int c = (row - ML) & 255; const int hf = j < 384 ? j / 192 : (j - 384) / 384;
            if (hf == 0) { valid = c > 0; nrow = row - 1; } else { valid = c < 255; nrow = row + 1; } }
        const float s = valid ? pxr[(size_t)nrow * NPXR + j] : 0.f;
        float m = f + (s - f) * mu[j];
        if (j >= 256 && j < 384) m = 1.f / (1.f + expf(-m)); else if (j >= 896 && j < 1024) m = tanhf(m);
        mx[tk * NPXR + j] = m;
    }
    __syncthreads();
    const int c = tid & 255, hf = tid >> 8;
    unsigned char* prep = a.ws + WS_PREP;
    float* PW = (float*)(prep + PREP_W); float* PKA = (float*)(prep + PREP_KA); float* PKD = (float*)(prep + PREP_KD); float* PKK = (float*)(prep + PREP_KK);
    float* PR = (float*)(prep + PREP_R); float* PV = (float*)(prep + PREP_V); float* PG = (float*)(prep + PREP_G);
    const float* mb = mx + hf * 8 * NPXR;
    const size_t row0 = (size_t)tile * 16 + hf * 8;
    float kv[8], kk[8];
    { const float kkp = a.in[I_KK][l * 256 + c];
#pragma unroll
      for (int i = 0; i < 8; ++i) { const float r = mb[i * NPXR + c], k = mb[i * NPXR + 384 + c], v = mb[i * NPXR + 640 + c];
          PR[(row0 + i) * 256 + c] = r; PV[(row0 + i) * 256 + c] = v; kv[i] = k;
          const float kx = k * kkp; const float ss = wave_sum(kx * kx); kk[i] = kx / fmaxf(sqrtf(ss), 1e-12f); PKK[(row0 + i) * 256 + c] = kk[i]; } }
    float acc[8];
    {
#pragma unroll
      for (int i = 0; i < 8; ++i) acc[i] = 0.f;
      const float* Wm = a.in[I_G2] + (size_t)l * 128 * 256 + c;
      for (int r4 = 0; r4 < 32; ++r4) { const float w0 = Wm[(r4 * 4 + 0) * 256], w1 = Wm[(r4 * 4 + 1) * 256], w2 = Wm[(r4 * 4 + 2) * 256], w3 = Wm[(r4 * 4 + 3) * 256];
#pragma unroll
          for (int i = 0; i < 8; ++i) { const f32x4 mv = *(const f32x4*)(mb + i * NPXR + 256 + r4 * 4); acc[i] += mv[0] * w0 + mv[1] * w1 + mv[2] * w2 + mv[3] * w3; } }
#pragma unroll
      for (int i = 0; i < 8; ++i) PG[(row0 + i) * 256 + c] = acc[i];
    }
    const float kap = a.in[I_KA][l * 256 + c];
#pragma unroll 1
    for (int d = 0; d < 2; ++d) {
#pragma unroll
        for (int i = 0; i < 8; ++i) acc[i] = 0.f;
        { const float* Wm = a.in[I_W2] + ((size_t)(l * 2 + d) * 64) * 256 + c;
          for (int r4 = 0; r4 < 16; ++r4) { const float w0 = Wm[(r4 * 4 + 0) * 256], w1 = Wm[(r4 * 4 + 1) * 256], w2 = Wm[(r4 * 4 + 2) * 256], w3 = Wm[(r4 * 4 + 3) * 256];
#pragma unroll
              for (int i = 0; i < 8; ++i) { const f32x4 mv = *(const f32x4*)(mb + i * NPXR + 896 + d * 64 + r4 * 4); acc[i] += mv[0] * w0 + mv[1] * w1 + mv[2] * w2 + mv[3] * w3; } } }
        { const float w0p = a.in[I_W0][(l * 2 + d) * 256 + c];
#pragma unroll
          for (int i = 0; i < 8; ++i) { const float z = w0p + acc[i]; const float nz = -z; const float sp = fmaxf(nz, 0.f) + log1pf(expf(-fabsf(nz)));
              PW[((row0 + i) * 2 + d) * 256 + c] = expf(-expf(-sp - 0.5f)); } }
#pragma unroll
        for (int i = 0; i < 8; ++i) acc[i] = 0.f;
        { const float* Wm = a.in[I_A2] + ((size_t)(l * 2 + d) * 64) * 256 + c;
          for (int r4 = 0; r4 < 16; ++r4) { const float w0 = Wm[(r4 * 4 + 0) * 256], w1 = Wm[(r4 * 4 + 1) * 256], w2 = Wm[(r4 * 4 + 2) * 256], w3 = Wm[(r4 * 4 + 3) * 256];
#pragma unroll
              for (int i = 0; i < 8; ++i) { const f32x4 mv = *(const f32x4*)(mb + i * NPXR + 1024 + d * 64 + r4 * 4); acc[i] += mv[0] * w0 + mv[1] * w1 + mv[2] * w2 + mv[3] * w3; } } }
        { const float a0p = a.in[I_A0][(l * 2 + d) * 256 + c];
#pragma unroll
          for (int i = 0; i < 8; ++i) { const float av = 1.f / (1.f + expf(-(a0p + acc[i])));
              PKA[((row0 + i) * 2 + d) * 256 + c] = kk[i] * av; PKD[((row0 + i) * 2 + d) * 256 + c] = kv[i] * (1.f + (av - 1.f) * kap); } }
    }
    __syncthreads();
}

constexpr int SC_STEPS = 32, SC_NCH = (CL + TL) / SC_STEPS, SC_BUF = 5 * SC_STEPS * 256 + SC_STEPS * 64;
__device__ __forceinline__ int scan_row(int b, int d, int s) {
    if (d == 0) return s < CL ? ML + b * CL + s : b * TL + (s - CL);
    return s < CL ? ML + b * CL + (CL - 1 - s) : b * TL + (TL - 1 - (s - CL));
}
__device__ __forceinline__ void scan_load_chunk(const float* PW, const float* PKA, const float* PKD, const float* PKK, const float* PR, const float* PV, int b, int h, int d, int rgp, int ck, unsigned char* buf) {
    const int lt = threadIdx.x - 256;
    for (int i = lt; i < 5 * SC_STEPS * 16; i += 256) { const int arr = i >> 9, rem = i & 511, st = rem >> 4, q4 = rem & 15;
        const size_t row = (size_t)scan_row(b, d, ck * SC_STEPS + st);
        const float* src = arr == 0 ? PW + (row * 2 + d) * 256 : arr == 1 ? PKD + (row * 2 + d) * 256 : arr == 2 ? PKK + row * 256 : arr == 3 ? PKA + (row * 2 + d) * 256 : PR + row * 256;
        *(f32x4*)(buf + arr * (SC_STEPS * 256) + st * 256 + q4 * 16) = *(const f32x4*)(src + h * 64 + q4 * 4); }
    for (int i = lt; i < SC_STEPS * 4; i += 256) { const int st = i >> 2, q4 = i & 3; const size_t row = (size_t)scan_row(b, d, ck * SC_STEPS + st);
        *(f32x4*)(buf + 5 * SC_STEPS * 256 + st * 64 + q4 * 16) = *(const f32x4*)(PV + row * 256 + h * 64 + rgp * 16 + q4 * 4); }
}
__device__ __forceinline__ void scan_task(const Args& a, int task, unsigned char* lds) {
    const int tid = threadIdx.x, lane = tid & 63, wave = tid >> 6;
    const int chain = task >> 2, rgp = task & 3; const int b = chain >> 3, h = (chain >> 1) & 3, d = chain & 1;
    unsigned char* prep = a.ws + WS_PREP;
    const float* PW = (const float*)(prep + PREP_W); const float* PKA = (const float*)(prep + PREP_KA); const float* PKD = (const float*)(prep + PREP_KD); const float* PKK = (const float*)(prep + PREP_KK);
    const float* PR = (const float*)(prep + PREP_R); const float* PV = (const float*)(prep + PREP_V);
    float* YS = (float*)(a.ws + WS_YS);
    if (tid >= 256) scan_load_chunk(PW, PKA, PKD, PKK, PR, PV, b, h, d, rgp, 0, lds);
    __syncthreads();
    const int rw = lane >> 4, kq = lane & 15, ri = wave * 4 + rw;
    float S0 = 0.f, S1 = 0.f, S2 = 0.f, S3 = 0.f;
    for (int ck = 0; ck < SC_NCH; ++ck) {
        unsigned char* buf = lds + (ck & 1) * SC_BUF;
        if (tid >= 256) { if (ck + 1 < SC_NCH) scan_load_chunk(PW, PKA, PKD, PKK, PR, PV, b, h, d, rgp, ck + 1, lds + ((ck + 1) & 1) * SC_BUF); }
        else {
            for (int st = 0; st < SC_STEPS; ++st) {
                const f32x4 w4 = *(const f32x4*)(buf + 0 * (SC_STEPS * 256) + st * 256 + kq * 16), kd4 = *(const f32x4*)(buf + 1 * (SC_STEPS * 256) + st * 256 + kq * 16),
                            kk4 = *(const f32x4*)(buf + 2 * (SC_STEPS * 256) + st * 256 + kq * 16), ka4 = *(const f32x4*)(buf + 3 * (SC_STEPS * 256) + st * 256 + kq * 16),
                            r4 = *(const f32x4*)(buf + 4 * (SC_STEPS * 256) + st * 256 + kq * 16);
                const float v = *(const float*)(buf + 5 * SC_STEPS * 256 + st * 64 + ri * 4);
                float sa = S0 * kk4[0] + S1 * kk4[1] + S2 * kk4[2] + S3 * kk4[3];
                sa = row16_sum(sa);
                S0 = S0 * w4[0] + v * kd4[0] - sa * ka4[0]; S1 = S1 * w4[1] + v * kd4[1] - sa * ka4[1];
                S2 = S2 * w4[2] + v * kd4[2] - sa * ka4[2]; S3 = S3 * w4[3] + v * kd4[3] - sa * ka4[3];
                float yv = S0 * r4[0] + S1 * r4[1] + S2 * r4[2] + S3 * r4[3];
                yv = row16_sum(yv);
                if (kq == 0) { const size_t row = (size_t)scan_row(b, d, ck * SC_STEPS + st); YS[(row * 2 + d) * 256 + h * 64 + rgp * 16 + ri] = yv; }
            }
        }
        __syncthreads();
    }
}

__device__ __forceinline__ void rwkv_out(const Args& a, int l) {
    const int tid = threadIdx.x, c = tid & 255;
    unsigned char* prep = a.ws + WS_PREP;
    const float* PKD = (const float*)(prep + PREP_KD); const float* PR = (const float*)(prep + PREP_R); const float* PV = (const float*)(prep + PREP_V); const float* PG = (const float*)(prep + PREP_G);
    const float* YS = (const float*)(a.ws + WS_YS); bf16_t* hbuf = (bf16_t*)(a.ws + WS_HBUF);
    const float lg = a.in[I_LNXG][l * 256 + c], lb = a.in[I_LNXB][l * 256 + c], rk = a.in[I_RK][l * 256 + c];
    for (size_t row = (size_t)blockIdx.x * 2 + (tid >> 8); row < MT; row += (size_t)gridDim.x * 2) {
        const float y = YS[(row * 2 + 0) * 256 + c] + YS[(row * 2 + 1) * 256 + c];
        const float mean = wave_sum(y) * (1.f / 64.f); const float dv = y - mean; const float var = wave_sum(dv * dv) * (1.f / 64.f);
        const float yn = dv * rsqrtf(var + 64e-5f) * lg + lb;
        const float bonus = wave_sum(PR[row * 256 + c] * (PKD[(row * 2 + 0) * 256 + c] + PKD[(row * 2 + 1) * 256 + c]) * rk);
        const float o = (yn + bonus * PV[row * 256 + c]) * PG[row * 256 + c];
        hbuf[row * DM + 768 + c] = f2bf(o);
    }
}

__device__ __forceinline__ bf16x8 load_rope8(const bf16_t* base, int sgm, bool rope, const float* rc, const float* rs, float scale) {
    const u32x4 own = *(const u32x4*)(base + sgm * 8);
    float o[8];
#pragma unroll
    for (int i = 0; i < 4; ++i) { o[2 * i] = __builtin_bit_cast(float, own[i] << 16); o[2 * i + 1] = __builtin_bit_cast(float, own[i] & 0xffff0000u); }
    if (rope) {
        const u32x4 par = *(const u32x4*)(base + (sgm ^ 2) * 8);
        const int tb = (sgm >> 2) * 16 + (sgm & 1) * 8; const float sgn = (sgm & 2) ? 1.f : -1.f;
#pragma unroll
        for (int i = 0; i < 4; ++i) { const float p0 = __builtin_bit_cast(float, par[i] << 16), p1 = __builtin_bit_cast(float, par[i] & 0xffff0000u);
            o[2 * i] = o[2 * i] * rc[tb + 2 * i] + sgn * p0 * rs[tb + 2 * i]; o[2 * i + 1] = o[2 * i + 1] * rc[tb + 2 * i + 1] + sgn * p1 * rs[tb + 2 * i + 1]; }
    }
    u32x4 w; w.x = cvt_pk_bf16(o[0] * scale, o[1] * scale); w.y = cvt_pk_bf16(o[2] * scale, o[3] * scale); w.z = cvt_pk_bf16(o[4] * scale, o[5] * scale); w.w = cvt_pk_bf16(o[6] * scale, o[7] * scale);
    return __builtin_bit_cast(bf16x8, w);
}
constexpr int KS_PITCH = 72, VT_PITCH = 136, VT_OFF = 128 * KS_PITCH * 2;
__device__ __forceinline__ void attn_unit(const Args& a, int l, int unit, unsigned char* lds) {
    const int tid = threadIdx.x, lane = tid & 63, wave = tid >> 6, fr = lane & 15, quad = lane >> 4;
    bf16_t* Ks = (bf16_t*)lds; bf16_t* Vt = (bf16_t*)(lds + VT_OFF);
    const bf16_t* pxa = (const bf16_t*)(a.ws + WS_PXA); bf16_t* hbuf = (bf16_t*)(a.ws + WS_HBUF);
    const float* rc = (const float*)(a.ws + WS_ROPE); const float* rs = rc + TL * 32;
    const bool isctx = unit >= 256; int b, nblk, kvh, qrow0;
    if (!isctx) { b = unit >> 6; nblk = (unit >> 1) & 31; kvh = unit & 1; qrow0 = b * TL + nblk * 128; }
    else { const int u2 = unit - 256; b = u2 >> 2; nblk = (u2 >> 1) & 1; kvh = u2 & 1; qrow0 = ML + b * CL + nblk * 128; }
    const int qi = wave * 16 + fr; const size_t qrow = (size_t)qrow0 + qi; const int tq = nblk * 128 + qi;
    bf16x8 bq[4][2]; float mrun[4], lsum[4]; f32x4 O[4][4];
#pragma unroll
    for (int g = 0; g < 4; ++g) { const int head = kvh * 4 + g;
#pragma unroll
        for (int ks = 0; ks < 2; ++ks) bq[g][ks] = load_rope8(pxa + qrow * NPXA + 512 + head * 64, 4 * ks + quad, !isctx, rc + tq * 32, rs + tq * 32, 0.125f);
        mrun[g] = a.in[I_SINK][l * 8 + head]; lsum[g] = quad == 0 ? 1.f : 0.f;
#pragma unroll
        for (int dt = 0; dt < 4; ++dt) O[g][dt] = (f32x4){0.f, 0.f, 0.f, 0.f}; }
    const int nchunk = isctx ? 2 : 5;
    for (int ch = 0; ch < nchunk; ++ch) {
        const bool cchunk = ch < 2; const int lc = ch - 2; const int blk = nblk - 1 + lc;
        if (!cchunk && (blk < 0 || blk > 31)) continue;
        __syncthreads();
#pragma unroll
        for (int it = 0; it < 2; ++it) { const int item = tid + NTHR * it; const int key = item >> 3, sgm = item & 7;
            const size_t krow = cchunk ? (size_t)ML + b * CL + ch * 128 + key : (size_t)b * TL + blk * 128 + key; const int tk = blk * 128 + key;
            const bf16x8 kf = load_rope8(pxa + krow * NPXA + 1024 + kvh * 64, sgm, !cchunk, rc + (cchunk ? 0 : tk) * 32, rs + (cchunk ? 0 : tk) * 32, 1.f);
            *(bf16x8*)(Ks + key * KS_PITCH + sgm * 8) = kf;
            const bf16x8 vf = *(const bf16x8*)(pxa + krow * NPXA + 1152 + kvh * 64 + sgm * 8);
#pragma unroll
            for (int i = 0; i < 8; ++i) Vt[(sgm * 8 + i) * VT_PITCH + key] = (bf16_t)vf[i]; }
        __syncthreads();
#pragma unroll 1
        for (int kt = 0; kt < 4; ++kt) {
            bf16x8 ak[2][2], av[4];
#pragma unroll
            for (int sub = 0; sub < 2; ++sub)
#pragma unroll
                for (int ks = 0; ks < 2; ++ks) ak[sub][ks] = *(const bf16x8*)(Ks + (kt * 32 + sub * 16 + fr) * KS_PITCH + ks * 32 + quad * 8);
#pragma unroll
            for (int dt = 0; dt < 4; ++dt) { const bf16_t* vp = Vt + (dt * 16 + fr) * VT_PITCH + kt * 32 + quad * 4;
                const u32x2 lo = *(const u32x2*)vp, hi = *(const u32x2*)(vp + 16); u32x4 w; w.x = lo.x; w.y = lo.y; w.z = hi.x; w.w = hi.y; av[dt] = __builtin_bit_cast(bf16x8, w); }
#pragma unroll
            for (int g = 0; g < 4; ++g) {
                f32x4 s0 = {0.f, 0.f, 0.f, 0.f}, s1 = {0.f, 0.f, 0.f, 0.f};
                s0 = __builtin_amdgcn_mfma_f32_16x16x32_bf16(ak[0][0], bq[g][0], s0, 0, 0, 0); s0 = __builtin_amdgcn_mfma_f32_16x16x32_bf16(ak[0][1], bq[g][1], s0, 0, 0, 0);
                s1 = __builtin_amdgcn_mfma_f32_16x16x32_bf16(ak[1][0], bq[g][0], s1, 0, 0, 0); s1 = __builtin_amdgcn_mfma_f32_16x16x32_bf16(ak[1][1], bq[g][1], s1, 0, 0, 0);
                if (!cchunk && lc != 1) {
#pragma unroll
                    for (int j = 0; j < 4; ++j) { const int k0 = kt * 32 + quad * 4 + j, k1 = k0 + 16;
                        const bool v0 = lc == 0 ? (k0 >= qi) : (k0 <= qi), v1 = lc == 0 ? (k1 >= qi) : (k1 <= qi);
                        s0[j] = v0 ? s0[j] : -1e30f; s1[j] = v1 ? s1[j] : -1e30f; } }
                float mx = fmaxf(fmaxf(fmaxf(s0[0], s0[1]), fmaxf(s0[2], s0[3])), fmaxf(fmaxf(s1[0], s1[1]), fmaxf(s1[2], s1[3])));
                mx = fmaxf(mx, __shfl_xor(mx, 16)); mx = fmaxf(mx, __shfl_xor(mx, 32));
                const float mn = fmaxf(mrun[g], mx); const float alpha = __expf(mrun[g] - mn); mrun[g] = mn;
                float p[8];
#pragma unroll
                for (int j = 0; j < 4; ++j) { p[j] = __expf(s0[j] - mn); p[4 + j] = __expf(s1[j] - mn); }
                lsum[g] = lsum[g] * alpha + ((p[0] + p[1]) + (p[2] + p[3])) + ((p[4] + p[5]) + (p[6] + p[7]));
                u32x4 w; w.x = cvt_pk_bf16(p[0], p[1]); w.y = cvt_pk_bf16(p[2], p[3]); w.z = cvt_pk_bf16(p[4], p[5]); w.w = cvt_pk_bf16(p[6], p[7]);
                const bf16x8 bp = __builtin_bit_cast(bf16x8, w);
#pragma unroll
                for (int dt = 0; dt < 4; ++dt) { O[g][dt] = O[g][dt] * alpha; O[g][dt] = __builtin_amdgcn_mfma_f32_16x16x32_bf16(av[dt], bp, O[g][dt], 0, 0, 0); }
            }
        }
    }
#pragma unroll
    for (int g = 0; g < 4; ++g) { const int head = kvh * 4 + g;
        float lt = lsum[g]; lt += __shfl_xor(lt, 16); lt += __shfl_xor(lt, 32); const float inv = 1.f / lt;
#pragma unroll
        for (int dt = 0; dt < 4; ++dt) { const f32x4 o = O[g][dt] * inv; u32x2 w; w.x = cvt_pk_bf16(o[0], o[1]); w.y = cvt_pk_bf16(o[2], o[3]);
            *(u32x2*)(hbuf + qrow * DM + 256 + head * 64 + dt * 16 + quad * 4) = w; } }
    __syncthreads();
}

__device__ __forceinline__ void gmlp_unit(const Args& a, int l, int chunk, unsigned char* lds) {
    const int tid = threadIdx.x, lane = tid & 63, wave = tid >> 6, fr = lane & 15, quad = lane >> 4;
    bf16_t* vT = (bf16_t*)lds;
    const bf16_t* pxa = (const bf16_t*)(a.ws + WS_PXA); bf16_t* hbuf = (bf16_t*)(a.ws + WS_HBUF);
    const size_t row0 = (size_t)chunk * 128;
    { const f32x4 lg = *(const f32x4*)(a.in[I_SGLNG] + l * 256 + lane * 4), lb = *(const f32x4*)(a.in[I_SGLNB] + l * 256 + lane * 4);
      for (int i = 0; i < 16; ++i) { const int tk = wave * 16 + i;
          const u32x2 raw = *(const u32x2*)(pxa + (row0 + tk) * NPXA + 256 + lane * 4);
          float x[4] = { gelu_tanh(__builtin_bit_cast(float, raw.x << 16)), gelu_tanh(__builtin_bit_cast(float, raw.x & 0xffff0000u)), gelu_tanh(__builtin_bit_cast(float, raw.y << 16)), gelu_tanh(__builtin_bit_cast(float, raw.y & 0xffff0000u)) };
          const float mean = wave_sum((x[0] + x[1]) + (x[2] + x[3])) * (1.f / 256.f);
          float q = 0.f;
#pragma unroll
          for (int j = 0; j < 4; ++j) { x[j] -= mean; q += x[j] * x[j]; }
          const float rstd = rsqrtf(wave_sum(q) * (1.f / 256.f) + 1e-5f);
#pragma unroll
          for (int j = 0; j < 4; ++j) vT[(lane * 4 + j) * VT_PITCH + tk] = f2bf(x[j] * rstd * lg[j] + lb[j]); } }
    __syncthreads();
    const int pt = wave;
#pragma unroll 1
    for (int g = 0; g < 4; ++g) {
        bf16x8 af[4];
        const float* wsrc = a.in[I_SGW] + ((size_t)(l * 4 + g) * 128 + pt * 16 + fr) * 128 + quad * 8;
#pragma unroll
        for (int ks = 0; ks < 4; ++ks) { const f32x4 w0 = *(const f32x4*)(wsrc + ks * 32), w1 = *(const f32x4*)(wsrc + ks * 32 + 4);
            u32x4 w; w.x = cvt_pk_bf16(w0[0], w0[1]); w.y = cvt_pk_bf16(w0[2], w0[3]); w.z = cvt_pk_bf16(w1[0], w1[1]); w.w = cvt_pk_bf16(w1[2], w1[3]); af[ks] = __builtin_bit_cast(bf16x8, w); }
        f32x4 bs;
#pragma unroll
        for (int j = 0; j < 4; ++j) bs[j] = a.in[I_SGB][(l * 4 + g) * 128 + pt * 16 + quad * 4 + j];
#pragma unroll
        for (int dt = 0; dt < 4; ++dt) { const int chn = g * 64 + dt * 16 + fr;
            f32x4 acc = {0.f, 0.f, 0.f, 0.f};
#pragma unroll
            for (int ks = 0; ks < 4; ++ks) { const bf16x8 bv = *(const bf16x8*)(vT + chn * VT_PITCH + ks * 32 + quad * 8); acc = __builtin_amdgcn_mfma_f32_16x16x32_bf16(af[ks], bv, acc, 0, 0, 0); }
#pragma unroll
            for (int j = 0; j < 4; ++j) { const size_t row = row0 + pt * 16 + quad * 4 + j;
                const float uu = gelu_tanh(bf2f(pxa[row * NPXA + chn]));
                hbuf[row * DM + chn] = f2bf(uu * (acc[j] + bs[j])); } }
    }
    __syncthreads();
}

constexpr int N_PHASES = 2 + 9 * NL;
template <int MASK> __device__ __forceinline__ void run_phase(const Args& a, int ph, unsigned char* lds) {
    const int G = gridDim.x, bid = blockIdx.x;
    bf16_t* HB = (bf16_t*)(a.ws + WS_HBUF); float* XC = (float*)(a.ws + WS_XC); float* YD = (float*)(a.ws + WS_YD);
    if (ph == 0) { if constexpr (MASK & 1) {
        for (int t = bid; t < 192; t += G) modv_task(a, t, lds);
        for (int t = bid; t < 256; t += G) rope_task(a, t);
        for (int t = bid; t < WCONV_TASKS; t += G) wconv_task(a, 0, t, lds); }
        return;
    }
    if (ph == 1) { if constexpr (MASK & 2) row_pass(a, nullptr, a.in[I_X], a.in[I_CTX], nullptr, nullptr, nullptr, 0, 0, true, a.in[I_NORMG] + 0, 0, 0, 1); return; }
    const int l = (ph - 2) / 9, s = (ph - 2) % 9;
    const float* ng = a.in[I_NORMG] + l * 4 * DM;
    const float* xl = l == 0 ? a.in[I_X] : a.out; const float* xc = l == 0 ? a.in[I_CTX] : XC;
    switch (s) {
    case 0: if constexpr (MASK & 4) { pg8::Gemm g{HB, (const bf16_t*)(a.ws + WS_WIN), MT, NIN, DM}; pg8::StaticOrder S; S.init(MT, NIN, G, bid);
              EpiIn E{(bf16_t*)(a.ws + WS_PXA), (float*)(a.ws + WS_PXR)};
              pg8::gemm_phase<EpiIn, pg8::StaticOrder, true, true>((PG8_LAS unsigned char*)lds, g, S, E); } break;
    case 1: if constexpr (MASK & 8) { for (int t = bid; t < MT / 16; t += G) rwkv_prep_tile(a, l, t, lds); } break;
    case 2: if constexpr (MASK & 16) { if (bid < 128) scan_task(a, bid, lds);
            else { const int w = bid - 128, nw = G - 128; const bool last = (l == NL - 1); const int natt = last ? 256 : 272, ngm = last ? 128 : 136;
                for (int u = w; u < natt + ngm; u += nw) { if (u < natt) attn_unit(a, l, u, lds); else gmlp_unit(a, l, u - natt, lds); } } } break;
    case 3: if constexpr (MASK & 32) rwkv_out(a, l); break;
    case 4: if constexpr (MASK & 64) { pg8::Gemm g{HB, (const bf16_t*)(a.ws + WS_WOUT), MT, DM, DM}; pg8::StaticOrder S; S.init(MT, DM, G, bid);
              EpiF32 E{YD}; pg8::gemm_phase<EpiF32, pg8::StaticOrder, true, true>((PG8_LAS unsigned char*)lds, g, S, E); } break;
    case 5: if constexpr (MASK & 2) row_pass(a, YD, xl, xc, a.out, XC, ng + 1 * DM, l, 2, true, ng + 2 * DM, l, 3, 4); break;
    case 6: if constexpr (MASK & 128) { pg8::Gemm g{HB, (const bf16_t*)(a.ws + WS_WGU), MT, 2 * DFF, DM}; pg8::StaticOrder S; S.init(MT, 2 * DFF, G, bid);
              EpiSwiglu E{(bf16_t*)(a.ws + WS_ACT)}; pg8::gemm_phase<EpiSwiglu, pg8::StaticOrder, true, true>((PG8_LAS unsigned char*)lds, g, S, E); } break;
    case 7: if constexpr (MASK & 512) { pg8::Gemm g{(const bf16_t*)(a.ws + WS_ACT), (const bf16_t*)(a.ws + WS_WDN), MT, DM, DFF}; pg8::StaticOrder S; S.init(MT, DM, G, bid);
              EpiF32 E{YD}; pg8::gemm_phase<EpiF32, pg8::StaticOrder, true, true>((PG8_LAS unsigned char*)lds, g, S, E); } break;
    case 8: if constexpr (MASK & 256) { const bool last = (l == NL - 1);
              if (!last) for (int t = bid; t < WCONV_TASKS; t += G) wconv_task(a, l + 1, t, lds);
              row_pass(a, YD, a.out, XC, a.out, XC, ng + 3 * DM, l, 5, !last, a.in[I_NORMG] + (last ? 0 : (l + 1) * 4 * DM), last ? 0 : l + 1, 0, 1); } break;
    }
}

template <int MASK> __global__ void __launch_bounds__(NTHR) trunk_fwd(Args args) {
    extern __shared__ __attribute__((aligned(16))) unsigned char lds[];
    cg::grid_group grid = cg::this_grid();
    for (int ph = args.ph_lo; ph < args.ph_hi; ++ph) {
        run_phase<MASK>(args, ph, lds);
        if (ph + 1 < args.ph_hi) grid.sync();
    }
}
__host__ inline int phase_mask(int ph) { if (ph == 0) return 1; if (ph == 1) return 2; const int s = (ph - 2) % 9; const int m[9] = {4, 8, 16, 32, 64, 2, 128, 512, 256}; return m[s]; }
__host__ inline const void* kernel_for(int mask) {
    switch (mask) { case 1: return (const void*)trunk_fwd<1>; case 2: return (const void*)trunk_fwd<2>; case 4: return (const void*)trunk_fwd<4>; case 8: return (const void*)trunk_fwd<8>; case 16: return (const void*)trunk_fwd<16>;
        case 32: return (const void*)trunk_fwd<32>; case 64: return (const void*)trunk_fwd<64>; case 128: return (const void*)trunk_fwd<128>; case 256: return (const void*)trunk_fwd<256>; case 512: return (const void*)trunk_fwd<512>;
#if MK_PER_PHASE
        default: return nullptr; }
#else
        default: return (const void*)trunk_fwd<1023>; }
#endif
}

extern "C" void kernel_launch(void* const* d_in, const int* in_sizes, int n_in, void* d_out, int out_size, void* d_ws, size_t ws_size, hipStream_t stream) {
    static int grid = 0;
    if (grid == 0) {
        if (n_in != N_IN || out_size != ML * DM || ws_size < WS_END) { fprintf(stderr, "kernel_launch: unexpected shapes: n_in %d out %d ws %zu (need %zu)\n", n_in, out_size, ws_size, (size_t)WS_END); grid = -1; return; }
        int dev = 0, cus = 0, per_cu = 0;
        (void)hipGetDevice(&dev); (void)hipDeviceGetAttribute(&cus, hipDeviceAttributeMultiprocessorCount, dev);
#if MK_PER_PHASE
        for (int mk = 1; mk <= 512; mk <<= 1) {
#else
        for (int mk = 1023; mk <= 1023; ++mk) {
#endif
            if (hipFuncSetAttribute(kernel_for(mk), hipFuncAttributeMaxDynamicSharedMemorySize, LDS_BYTES) != hipSuccess) { fprintf(stderr, "kernel_launch: hipFuncSetAttribute failed\n"); grid = -1; return; }
            if (hipOccupancyMaxActiveBlocksPerMultiprocessor(&per_cu, kernel_for(mk), NTHR, LDS_BYTES) != hipSuccess || per_cu < 1) { fprintf(stderr, "kernel_launch: occupancy query says %d blocks per CU\n", per_cu); grid = -1; return; }
        }
        grid = cus;
        if (grid != 256) fprintf(stderr, "kernel_launch: note: %d CUs (the phase split assumes 256)\n", grid);
    }
    if (grid < 0) return;
    Args a{};
    for (int i = 0; i < N_IN; ++i) a.in[i] = (const float*)d_in[i];
    a.out = (float*)d_out; a.ws = (unsigned char*)d_ws;
#if MK_PER_PHASE
    for (int ph = 0; ph < N_PHASES; ++ph) { a.ph_lo = ph; a.ph_hi = ph + 1; void* kargs[] = {&a};
        hipError_t e = hipLaunchCooperativeKernel(kernel_for(phase_mask(ph)), dim3(grid), dim3(NTHR), kargs, LDS_BYTES, stream);
        if (e != hipSuccess) { fprintf(stderr, "kernel_launch: launch of phase %d failed: %s\n", ph, hipGetErrorString(e)); break; } }
#else
    a.ph_lo = 0; a.ph_hi = N_PHASES; void* kargs[] = {&a};
    hipError_t e = hipLaunchCooperativeKernel(kernel_for(1023), dim3(grid), dim3(NTHR), kargs, LDS_BYTES, stream);
    if (e != hipSuccess) fprintf(stderr, "kernel_launch: cooperative launch failed: %s (grid %d)\n", hipGetErrorString(e), grid);
#endif
}
```

```cpp
#include <hip/hip_runtime.h>
#include <hip/hip_cooperative_groups.h>
#include <cstdio>
#include <cstdint>
namespace cg = cooperative_groups;
__device__ __forceinline__ int opaque_tid() { int t = threadIdx.x; asm volatile("" : "+v"(t)); return t; }
namespace pg8 {
#define PG8_LAS __attribute__((address_space(3)))
typedef unsigned short bf16_t;
typedef short bf16x8 __attribute__((ext_vector_type(8)));
typedef float f32x4 __attribute__((ext_vector_type(4)));
typedef unsigned u32x4 __attribute__((ext_vector_type(4)));
constexpr int BM = 256, BK = 64, HALF = 128, HTB = HALF * BK * 2  , STAGE_BYTES = 8 * HTB, NXCD = 8, WGM = 8;

__host__ __device__ __forceinline__ int lds_byte(int r, int c) { const int st = (r >> 4) * 2 + (c >> 5), rr = r & 15, cc = c & 31, ob = rr * 64 + cc * 2; return st * 1024 + (ob ^ (((ob >> 9) & 1) << 5)); }
__host__ __device__ __forceinline__ void stage_rc(int b, int& R, int& C) { const int st = b / 1024, sb = b % 1024, swz = sb ^ (((sb >> 9) & 1) << 5); R = (st >> 1) * 16 + swz / 64; C = (st & 1) * 32 + (swz % 64) / 2; }
__host__ __device__ __forceinline__ int perm32(int rho) { const int n = rho >> 4, i = rho & 15; return 8 * (i >> 2) + 4 * n + (i & 3); }

struct Unit { int pm, pn; };
struct Gemm { const bf16_t* A; const bf16_t* Bt; int M, N, K, ld; };

struct StaticOrder {
    int nM, nN, nwg, G, c;
    __host__ __device__ void init(int M, int N, int G_, int c_) { nM = M / BM; nN = N / BM; nwg = nM * nN; G = G_; c = c_; }
    __host__ __device__ bool next(int i, Unit& u) const {
        const long L = (long)i * G + c; if (L >= nwg) return false;
        int wgid = (int)L; { const int q = nwg / NXCD, r = nwg % NXCD, xcd = wgid % NXCD, off = wgid / NXCD; wgid = (xcd < r ? xcd * (q + 1) : r * (q + 1) + (xcd - r) * q) + off; }
        const int nig = WGM * nN, gid = wgid / nig, fm = gid * WGM, gsz = (nM - fm) < WGM ? (nM - fm) : WGM;
        u.pm = fm + ((wgid % nig) % gsz); u.pn = (wgid % nig) / gsz; return true;
    }
    __device__ __forceinline__ void a_ready(const Unit&) const {}
    __device__ __forceinline__ void done(const Unit&) const {}
};
__device__ __forceinline__ unsigned cvt_pk_bf16(float lo, float hi) { unsigned r; asm volatile("v_cvt_pk_bf16_f32 %0, %1, %2" : "=v"(r) : "v"(lo), "v"(hi)); return r; }
template <class Epi, class Sched, bool ALIGN_EPI = false, bool SP2 = false>
__device__ __forceinline__ void gemm_phase(PG8_LAS unsigned char* lds, const Gemm g, const Sched& S, const Epi& E) {
    const int tid = opaque_tid(), wid = __builtin_amdgcn_readfirstlane(tid >> 6), lane = tid & 63, wr = wid >> 2, wc = wid & 3, fr = lane & 15, fq = lane >> 4;
    const int K = g.ld, nt = g.K / BK;
    unsigned voffA[2], voffB[2];
#pragma unroll
    for (int i = 0; i < 2; ++i) { int R, C; stage_rc(tid * 16 + i * 8192, R, C); const int Rb = Epi::PERM ? ((R & ~31) + perm32(R & 31)) : R;
        voffA[i] = (unsigned)(R * K + C) * 2u; voffB[i] = (unsigned)(Rb * K + C) * 2u; }
    const size_t kstep = (size_t)(BK * 2);
    const size_t hstep = (size_t)HALF * K * 2;
    const size_t tstep = 2 * hstep;
    const unsigned ldsw = (unsigned)wid * 1024u;
    const int aoff = lds_byte(wr * 64 + fr, fq * 8), boff = lds_byte(wc * 32 + fr, fq * 8);
#define PG8_SA(b, h) (((b) * 2 + (h)) * HTB)
#define PG8_SB(b, h) ((4 + (b) * 2 + (h)) * HTB)
#define PG8_STAGE(bufoff, gbase, voff) do { _Pragma("unroll") for (int _i = 0; _i < 2; ++_i) \
        __builtin_amdgcn_global_load_lds((const unsigned*)((const char*)(gbase) + (voff)[_i]), (PG8_LAS unsigned*)(lds + (bufoff) + ldsw + _i * 8192), 16, 0, 0); } while (0)
#define PG8_LDA(dst, b, h) do { _Pragma("unroll") for (int m = 0; m < 4; ++m) _Pragma("unroll") for (int k = 0; k < 2; ++k) dst[m][k] = *(const PG8_LAS bf16x8*)(lds + PG8_SA(b, h) + aoff + m * 2048 + k * 1024); } while (0)
#define PG8_LDB(dst, b, h) do { _Pragma("unroll") for (int n = 0; n < 2; ++n) _Pragma("unroll") for (int k = 0; k < 2; ++k) dst[n][k] = *(const PG8_LAS bf16x8*)(lds + PG8_SB(b, h) + boff + n * 2048 + k * 1024); } while (0)
#define PG8_MMA(ai, bj, At, Bt) do { __builtin_amdgcn_s_setprio(1); _Pragma("unroll") for (int m = 0; m < 4; ++m) _Pragma("unroll") for (int n = 0; n < 2; ++n) _Pragma("unroll") for (int k = 0; k < 2; ++k) \
        acc[ai][bj][m][n] = __builtin_amdgcn_mfma_f32_16x16x32_bf16(Bt[n][k], At[m][k], acc[ai][bj][m][n], 0, 0, 0); __builtin_amdgcn_s_setprio(0); } while (0)
#define PG8_WAIT_V(n) asm volatile("s_waitcnt vmcnt(" #n ")" ::: "memory")
#define PG8_WAIT_L(n) asm volatile("s_waitcnt lgkmcnt(" #n ")" ::: "memory")
#define PG8_BAR __builtin_amdgcn_s_barrier()
#define PG8_SCHED __builtin_amdgcn_sched_barrier(0)
    Unit cur, nxt; int ui = 0;
    if (!S.next(0, cur)) return;
    f32x4 acc[2][2][4][2];
#pragma unroll
    for (int a = 0; a < 2; ++a)
#pragma unroll
        for (int b = 0; b < 2; ++b)
#pragma unroll
            for (int m = 0; m < 4; ++m)
#pragma unroll
                for (int n = 0; n < 2; ++n) acc[a][b][m][n] = (f32x4){0.f, 0.f, 0.f, 0.f};
    bf16x8 At[4][2], B0[2][2], B1[2][2];
    const char* cA = (const char*)g.A + (size_t)cur.pm * tstep; const char* cB = (const char*)g.Bt + (size_t)cur.pn * tstep;
    S.a_ready(cur);
    if constexpr (SP2) {
        PG8_STAGE(PG8_SB(0, 0), cB, voffB); PG8_STAGE(PG8_SB(0, 1), cB + hstep, voffB); PG8_STAGE(PG8_SA(0, 0), cA, voffA); PG8_STAGE(PG8_SA(0, 1), cA + hstep, voffA);
        if (wr == 1) PG8_BAR;
        PG8_WAIT_V(2); PG8_BAR;
        PG8_STAGE(PG8_SB(1, 0), cB + kstep, voffB); PG8_STAGE(PG8_SA(1, 0), cA + kstep, voffA); PG8_STAGE(PG8_SB(1, 1), cB + hstep + kstep, voffB);
        PG8_WAIT_V(6); PG8_BAR;
    } else {
        PG8_STAGE(PG8_SB(0, 0), cB, voffB); PG8_STAGE(PG8_SA(0, 0), cA, voffA); PG8_STAGE(PG8_SB(0, 1), cB + hstep, voffB); PG8_STAGE(PG8_SA(0, 1), cA + hstep, voffA);
        if (wr == 1) PG8_BAR;
        PG8_WAIT_V(4); PG8_BAR;
        PG8_STAGE(PG8_SB(1, 0), cB + kstep, voffB); PG8_STAGE(PG8_SA(1, 0), cA + kstep, voffA); PG8_STAGE(PG8_SB(1, 1), cB + hstep + kstep, voffB);
        PG8_WAIT_V(6); PG8_BAR;
    }
    for (;;) {
        const bool has_next = S.next(ui + 1, nxt);
        const char* nA = has_next ? (const char*)g.A + (size_t)nxt.pm * tstep : cA; const char* nB = has_next ? (const char*)g.Bt + (size_t)nxt.pn * tstep : cB;
        for (int t = 0; t < nt; t += 2) {
            const bool last = (t == nt - 2);
            const char* a1 = cA + (size_t)(t + 1) * kstep;
            const char* a2 = last ? nA : cA + (size_t)(t + 2) * kstep; const char* b2 = last ? nB : cB + (size_t)(t + 2) * kstep;
            const char* a3 = a2 + kstep; const char* b3 = b2 + kstep;
            if (last && has_next) S.a_ready(nxt);
            if constexpr (SP2) {
            PG8_LDB(B0, 0, 0); PG8_LDB(B1, 0, 1); PG8_SCHED; PG8_LDA(At, 0, 0); PG8_STAGE(PG8_SA(1, 1), a1 + hstep, voffA);
            PG8_WAIT_V(8); PG8_WAIT_L(0); PG8_BAR; PG8_MMA(0, 0, At, B0); PG8_MMA(0, 1, At, B1); PG8_BAR; PG8_SCHED;
            PG8_LDA(At, 0, 1); PG8_STAGE(PG8_SB(0, 0), b2, voffB); PG8_STAGE(PG8_SB(0, 1), b2 + hstep, voffB); PG8_STAGE(PG8_SA(0, 0), a2, voffA);
            PG8_WAIT_V(8); PG8_WAIT_L(0); PG8_BAR; PG8_MMA(1, 0, At, B0); PG8_MMA(1, 1, At, B1); PG8_BAR; PG8_SCHED;
            PG8_LDB(B0, 1, 0); PG8_LDB(B1, 1, 1); PG8_SCHED; PG8_LDA(At, 1, 0); PG8_STAGE(PG8_SA(0, 1), a2 + hstep, voffA);
            PG8_WAIT_V(8); PG8_WAIT_L(0); PG8_BAR; PG8_MMA(0, 0, At, B0); PG8_MMA(0, 1, At, B1); PG8_BAR; PG8_SCHED;
            PG8_LDA(At, 1, 1); PG8_STAGE(PG8_SB(1, 0), b3, voffB); PG8_STAGE(PG8_SB(1, 1), b3 + hstep, voffB); PG8_STAGE(PG8_SA(1, 0), a3, voffA);
            PG8_WAIT_V(8); PG8_WAIT_L(0); PG8_BAR; PG8_MMA(1, 0, At, B0); PG8_MMA(1, 1, At, B1); PG8_BAR; PG8_SCHED;
            } else {
            PG8_LDB(B0, 0, 0); PG8_SCHED; PG8_LDA(At, 0, 0); PG8_STAGE(PG8_SA(1, 1), a1 + hstep, voffA);
            PG8_WAIT_L(8); PG8_BAR; PG8_WAIT_L(0); PG8_MMA(0, 0, At, B0); PG8_BAR; PG8_SCHED;
            PG8_LDB(B1, 0, 1); PG8_STAGE(PG8_SB(0, 0), b2, voffB);
            PG8_BAR; PG8_WAIT_L(0); PG8_MMA(0, 1, At, B1); PG8_BAR;
            PG8_LDA(At, 0, 1); PG8_STAGE(PG8_SA(0, 0), a2, voffA);
            PG8_BAR; PG8_WAIT_L(0); PG8_MMA(1, 0, At, B0); PG8_BAR; PG8_SCHED;
            PG8_STAGE(PG8_SB(0, 1), b2 + hstep, voffB);
            PG8_WAIT_V(6); PG8_BAR; PG8_MMA(1, 1, At, B1); PG8_BAR;
            PG8_LDB(B0, 1, 0); PG8_SCHED; PG8_LDA(At, 1, 0); PG8_STAGE(PG8_SA(0, 1), a2 + hstep, voffA);
            PG8_WAIT_L(8); PG8_BAR; PG8_WAIT_L(0); PG8_MMA(0, 0, At, B0); PG8_BAR; PG8_SCHED;
            PG8_LDB(B1, 1, 1); PG8_STAGE(PG8_SB(1, 0), b3, voffB);
            PG8_BAR; PG8_WAIT_L(0); PG8_MMA(0, 1, At, B1); PG8_BAR;
            PG8_LDA(At, 1, 1); PG8_STAGE(PG8_SA(1, 0), a3, voffA);
            PG8_BAR; PG8_WAIT_L(0); PG8_MMA(1, 0, At, B0); PG8_BAR; PG8_SCHED;
            PG8_STAGE(PG8_SB(1, 1), b3 + hstep, voffB);
            PG8_WAIT_V(6); PG8_BAR; PG8_MMA(1, 1, At, B1); PG8_BAR;
            }
        }
        if constexpr (ALIGN_EPI) { if (wr == 0) PG8_BAR; }
        if constexpr (!Epi::AFTER_DRAIN) { E(acc, cur, wr, wc, fr, fq); S.done(cur); }
        if (!has_next) break;
#pragma unroll
        for (int a = 0; a < 2; ++a)
#pragma unroll
            for (int b = 0; b < 2; ++b)
#pragma unroll
                for (int m = 0; m < 4; ++m)
#pragma unroll
                    for (int n = 0; n < 2; ++n) acc[a][b][m][n] = (f32x4){0.f, 0.f, 0.f, 0.f};
        cur = nxt; cA = nA; cB = nB; ++ui;
        if constexpr (ALIGN_EPI) { if (wr == 1) PG8_BAR; }
    }
    PG8_WAIT_V(0);
    if constexpr (!ALIGN_EPI) { if (wr == 0) PG8_BAR; }
    PG8_BAR;
    if constexpr (Epi::AFTER_DRAIN) { E.fused(acc, cur, wr, wc, fr, fq, lds, wid, lane); S.done(cur); }
#undef PG8_SA
#undef PG8_SB
#undef PG8_STAGE
#undef PG8_LDA
#undef PG8_LDB
#undef PG8_MMA
#undef PG8_WAIT_V
#undef PG8_WAIT_L
#undef PG8_BAR
#undef PG8_SCHED
}
}

#ifndef PROBE_DUP
#define PROBE_DUP 0
#endif
#ifndef PROBE_PH
#define PROBE_PH -1
#endif
#ifndef PROBE_SYNC
#define PROBE_SYNC 0
#endif
#ifndef PROBE_SCANC
#define PROBE_SCANC 0
#endif
#ifndef PROBE_SCAN
#define PROBE_SCAN 0
#endif
#ifndef PROBE_ATT
#define PROBE_ATT 0
#endif
#ifndef MK_PER_PHASE
#define MK_PER_PHASE 0
#endif
using pg8::bf16_t; using pg8::bf16x8; using pg8::f32x4; using pg8::u32x4;
typedef __bf16 bf16x2v __attribute__((ext_vector_type(2)));
typedef float f32x2c __attribute__((ext_vector_type(2)));
__device__ __forceinline__ unsigned cvt_pk_bf16(float lo, float hi) { const f32x2c v = {lo, hi}; return __builtin_bit_cast(unsigned, __builtin_convertvector(v, bf16x2v)); }
typedef unsigned u32x2 __attribute__((ext_vector_type(2)));
typedef short bf16x4 __attribute__((ext_vector_type(4)));

constexpr int DM = 1024, NB = 4, TL = 4096, CL = 256, NL = 4;
constexpr int ML = NB * TL, MC = NB * CL, MT = ML + MC;
constexpr int NIN = 2560, NPXA = 1280, NPXR = 1152, DFF = 2816, INC = 2432;
constexpr int NTHR = 512;
constexpr int LDS_BYTES = 147456;
constexpr size_t MiB = 1u << 20;
constexpr size_t WS_MODV = 0, WS_ROPE = 1 * MiB, WS_XC = 2 * MiB, WS_WIN = 6 * MiB, WS_WOUT = 11 * MiB, WS_WGU = 13 * MiB, WS_WDN = 24 * MiB;
constexpr size_t WS_HBUF = 30 * MiB, WS_PXA = 64 * MiB, WS_PXR = 107 * MiB, WS_PREP = 184 * MiB, WS_END = 354 * MiB;
constexpr size_t WS_WB1 = 146 * MiB;
constexpr size_t WS_LW = 512 * 1024, WS_LW1 = 832 * 1024;
__device__ __forceinline__ size_t wbase(int l) { return (l & 1) ? WS_WB1 : WS_WIN; }
__device__ __forceinline__ size_t lwbase(int l) { return (l & 1) ? WS_LW1 : WS_LW; }
constexpr size_t WO_OUT = 5 * MiB, WO_GU = 7 * MiB, WO_DN = 18 * MiB;
constexpr size_t WS_YS = 312 * MiB;
constexpr size_t WS_ACT = WS_PREP, WS_YD = 278 * MiB, WS_YP = 346 * MiB, WS_END2 = 374 * MiB;
constexpr size_t PREP_W = 0, PREP_KA = (size_t)MT * 512 * 4, PREP_KD = 2 * PREP_KA, PREP_KK = PREP_KD + (size_t)MT * 512 * 2, PREP_R = PREP_KK + (size_t)MT * 256 * 4,
                 PREP_V = PREP_R + (size_t)MT * 256 * 2, PREP_G = PREP_V + (size_t)MT * 256 * 2;
static_assert(WS_HBUF + (size_t)MT * 1024 * 2 <= WS_PXA && WS_PXA + (size_t)MT * NPXA * 2 <= WS_PXR && WS_PXR + (size_t)MT * NPXR * 4 <= WS_PREP, "ws map 1");
static_assert(WS_PREP + PREP_G + (size_t)MT * 256 * 2 <= WS_YS && WS_YS + (size_t)MT * 512 * 4 <= WS_YP && WS_ACT + (size_t)MT * DFF * 2 <= WS_YD && WS_YD + (size_t)MT * 1024 * 4 <= WS_END, "ws map 2");

enum { I_X = 0, I_C, I_CTX, I_CCTX, I_WMOD, I_BMOD, I_NORMG, I_WIN, I_WOUT, I_SGLNG, I_SGLNB, I_SGW, I_SGB, I_SINK, I_MU, I_W0, I_W2, I_A0, I_A2, I_KK, I_KA, I_RK, I_G2, I_LNXG, I_LNXB, I_WGU, I_WDN, N_IN };
struct Args { const float* in[N_IN]; float* out; unsigned char* ws; int ph_lo, ph_hi; };

__device__ __forceinline__ float bf2f(unsigned short h) { return __builtin_bit_cast(float, (unsigned)h << 16); }
__device__ __forceinline__ unsigned cvt_pk_bf16(float lo, float hi);
__device__ __forceinline__ unsigned short f2bf(float f) { return (unsigned short)(cvt_pk_bf16(f, 0.f) & 0xffffu); }
__device__ __forceinline__ f32x4 bf4_to_f32(u32x2 r) { f32x4 o; o[0] = __builtin_bit_cast(float, r.x << 16); o[1] = __builtin_bit_cast(float, r.x & 0xffff0000u); o[2] = __builtin_bit_cast(float, r.y << 16); o[3] = __builtin_bit_cast(float, r.y & 0xffff0000u); return o; }
__device__ __forceinline__ u32x2 f32_to_bf4(f32x4 v) { u32x2 w; w.x = cvt_pk_bf16(v[0], v[1]); w.y = cvt_pk_bf16(v[2], v[3]); return w; }
template <int CTRL> __device__ __forceinline__ float dppf(float x) { return __builtin_bit_cast(float, __builtin_amdgcn_mov_dpp(__builtin_bit_cast(int, x), CTRL, 0xf, 0xf, true)); }
__device__ __forceinline__ float row16_sum(float x) { x += dppf<0xB1>(x); x += dppf<0x4E>(x); x += dppf<0x141>(x); x += dppf<0x128>(x); return x; }
__device__ __forceinline__ float wave_sum(float v) {
    v = row16_sum(v);
    const float r0 = __builtin_bit_cast(float, __builtin_amdgcn_readlane(__builtin_bit_cast(int, v), 0)), r1 = __builtin_bit_cast(float, __builtin_amdgcn_readlane(__builtin_bit_cast(int, v), 16)),
                r2 = __builtin_bit_cast(float, __builtin_amdgcn_readlane(__builtin_bit_cast(int, v), 32)), r3 = __builtin_bit_cast(float, __builtin_amdgcn_readlane(__builtin_bit_cast(int, v), 48));
    return (r0 + r1) + (r2 + r3);
}
__device__ __forceinline__ float gelu_tanh(float x) { const float u = 0.7978845608028654f * (x + 0.044715f * x * x * x); const float t = 1.f - 2.f * __builtin_amdgcn_rcpf(1.f + __expf(2.f * u)); return 0.5f * x * (1.f + t); }
__device__ __forceinline__ float sigmoidf_(float x) { return 1.f / (1.f + __expf(-x)); }

struct EpiIn {
    static constexpr bool PERM = true, AFTER_DRAIN = false;
    bf16_t* pxa; bf16_t* pxr;
    __device__ __forceinline__ void operator()(const f32x4 (&acc)[2][2][4][2], const pg8::Unit& u, int wr, int wc, int fr, int fq) const {
        const int row0 = u.pm * 256 + wr * 64 + fr, colt = u.pn * 256 + wc * 32 + 8 * fq;
#pragma unroll
        for (int ai = 0; ai < 2; ++ai)
#pragma unroll
            for (int m = 0; m < 4; ++m) { const size_t row = (size_t)(row0 + ai * 128 + m * 16);
#pragma unroll
                for (int bj = 0; bj < 2; ++bj) { const int col = colt + bj * 128; const f32x4 v0 = acc[ai][bj][m][0], v1 = acc[ai][bj][m][1];
                    u32x4 w; w.x = cvt_pk_bf16(v0[0], v0[1]); w.y = cvt_pk_bf16(v0[2], v0[3]); w.z = cvt_pk_bf16(v1[0], v1[1]); w.w = cvt_pk_bf16(v1[2], v1[3]);
                    if (u.pn < 5) *(u32x4*)(pxa + row * NPXA + col) = w;
                    else { const int cc = col - NPXA; if (cc < NPXR) *(u32x4*)(pxr + row * NPXR + cc) = w; } } }
    }
};
struct EpiF32 {
    static constexpr bool PERM = true, AFTER_DRAIN = false;
    float* O; static constexpr int ldc = DM;
    __device__ __forceinline__ void operator()(const f32x4 (&acc)[2][2][4][2], const pg8::Unit& u, int wr, int wc, int fr, int fq) const {
        const int row0 = u.pm * 256 + wr * 64 + fr, colt = u.pn * 256 + wc * 32 + 8 * fq;
#pragma unroll
        for (int ai = 0; ai < 2; ++ai)
#pragma unroll
            for (int m = 0; m < 4; ++m) { float* rp = O + (size_t)(row0 + ai * 128 + m * 16) * ldc + colt;
#pragma unroll
                for (int bj = 0; bj < 2; ++bj) { *(f32x4*)(rp + bj * 128) = acc[ai][bj][m][0]; *(f32x4*)(rp + bj * 128 + 4) = acc[ai][bj][m][1]; } }
    }
};
struct EpiBf16Out {
    static constexpr bool PERM = true, AFTER_DRAIN = false;
    bf16_t* O;
    __device__ __forceinline__ void operator()(const f32x4 (&acc)[2][2][4][2], const pg8::Unit& u, int wr, int wc, int fr, int fq) const {
        const int row0 = u.pm * 256 + wr * 64 + fr, colt = u.pn * 256 + wc * 32 + 8 * fq;
#pragma unroll
        for (int ai = 0; ai < 2; ++ai)
#pragma unroll
            for (int m = 0; m < 4; ++m) { bf16_t* rp = O + (size_t)(row0 + ai * 128 + m * 16) * DM + colt;
#pragma unroll
                for (int bj = 0; bj < 2; ++bj) { const f32x4 v0 = acc[ai][bj][m][0], v1 = acc[ai][bj][m][1];
                    u32x4 w; w.x = cvt_pk_bf16(v0[0], v0[1]); w.y = cvt_pk_bf16(v0[2], v0[3]); w.z = cvt_pk_bf16(v1[0], v1[1]); w.w = cvt_pk_bf16(v1[2], v1[3]);
                    *(u32x4*)(rp + bj * 128) = w; } }
    }
};
struct EpiSwiglu {
    static constexpr bool PERM = true, AFTER_DRAIN = false;
    bf16_t* O;
    __device__ __forceinline__ void operator()(const f32x4 (&acc)[2][2][4][2], const pg8::Unit& u, int wr, int wc, int fr, int fq) const {
        const int row0 = u.pm * 256 + wr * 64 + fr, col = u.pn * 128 + wc * 32 + 8 * fq;
#pragma unroll
        for (int ai = 0; ai < 2; ++ai)
#pragma unroll
            for (int m = 0; m < 4; ++m) { float r[8];
#pragma unroll
                for (int n = 0; n < 2; ++n)
#pragma unroll
                    for (int j = 0; j < 4; ++j) { const float g = acc[ai][0][m][n][j], up = acc[ai][1][m][n][j]; r[n * 4 + j] = g * __builtin_amdgcn_rcpf(1.f + __expf(-g)) * up; }
                u32x4 w; w.x = cvt_pk_bf16(r[0], r[1]); w.y = cvt_pk_bf16(r[2], r[3]); w.z = cvt_pk_bf16(r[4], r[5]); w.w = cvt_pk_bf16(r[6], r[7]);
                *(u32x4*)(O + (size_t)(row0 + ai * 128 + m * 16) * DFF + col) = w; }
    }
};

__device__ __forceinline__ void modv_task(const Args& a, int task, unsigned char* lds) {
    float* act = (float*)lds; float* red = act + 5 * 1024;
    const int tid = opaque_tid();
    for (int i = tid; i < 5 * 1024; i += NTHR) { const int r = i >> 10, k = i & 1023; const float v = r < 4 ? a.in[I_C][r * 1024 + k] : a.in[I_CCTX][k]; act[i] = v / (1.f + expf(-v)); }
    __syncthreads();
    const int l = task / 48, cb = task % 48, cl = tid & 127, kq = tid >> 7;
    const float* W = a.in[I_WMOD] + (size_t)l * 1024 * 6144 + cb * 128 + cl;
    float a0 = 0.f, a1 = 0.f, a2 = 0.f, a3 = 0.f, a4 = 0.f;
    for (int k0 = kq * 256; k0 < kq * 256 + 256; k0 += 16) { float wv[16];
#pragma unroll
        for (int u = 0; u < 16; ++u) wv[u] = W[(size_t)(k0 + u) * 6144];
#pragma unroll
        for (int u = 0; u < 16; ++u) { const int k = k0 + u; const float w = wv[u]; a0 += act[k] * w; a1 += act[1024 + k] * w; a2 += act[2048 + k] * w; a3 += act[3072 + k] * w; a4 += act[4096 + k] * w; } }
    red[(kq * 5 + 0) * 128 + cl] = a0; red[(kq * 5 + 1) * 128 + cl] = a1; red[(kq * 5 + 2) * 128 + cl] = a2; red[(kq * 5 + 3) * 128 + cl] = a3; red[(kq * 5 + 4) * 128 + cl] = a4;
    __syncthreads();
    float* modv = (float*)(a.ws + WS_MODV);
    for (int i = tid; i < 640; i += NTHR) { const int r = i >> 7, c2 = i & 127;
        const float s = red[(0 * 5 + r) * 128 + c2] + red[(1 * 5 + r) * 128 + c2] + red[(2 * 5 + r) * 128 + c2] + red[(3 * 5 + r) * 128 + c2];
        modv[(size_t)(l * 5 + r) * 6144 + cb * 128 + c2] = s + a.in[I_BMOD][l * 6144 + cb * 128 + c2]; }
    __syncthreads();
}
__device__ __forceinline__ void rope_task(const Args& a, int task) {
    const int idx = task * NTHR + opaque_tid(); const int t = idx >> 5, j = idx & 31, axis = j >> 4, f = j & 15;
    const float pos = (float)(axis == 0 ? (t >> 6) : (t & 63));
    const float inv = powf(10000.0f, -(float)f / 16.0f);
    const float ang = pos * inv;
    float* rc = (float*)(a.ws + WS_ROPE); float* rs = rc + TL * 32;
    rc[idx] = cosf(ang); rs[idx] = sinf(ang);
}
constexpr int WCONV_TASKS = 640 + 256 + 1408 + 704;
struct WconvDesc { const float* src; bf16_t* dst; int Ksz, Nsrc, kt, n0, sc0; bool zero; };
__device__ __forceinline__ WconvDesc wconv_decode(const Args& a, int l, int task) {
    WconvDesc D; D.zero = false;
    if (task < 640) { const int nt = task >> 4; D.kt = task & 15; D.Ksz = 1024; D.Nsrc = INC; D.src = a.in[I_WIN] + (size_t)l * 1024 * INC; D.dst = (bf16_t*)(a.ws + wbase(l)); D.n0 = nt * 64; const int n0 = D.n0;
        if (n0 < 1024) D.sc0 = n0; else if (n0 < 1280) D.sc0 = 1408 + (n0 - 1024); else if (n0 < 1664) D.sc0 = 1024 + (n0 - 1280); else if (n0 < 2432) D.sc0 = n0; else { D.sc0 = 0; D.zero = true; } }
    else if (task < 896) { const int t = task - 640; const int nt = t >> 4; D.kt = t & 15; D.Ksz = 1024; D.Nsrc = 1024; D.src = a.in[I_WOUT] + (size_t)l * 1024 * 1024; D.dst = (bf16_t*)(a.ws + wbase(l) + WO_OUT); D.n0 = nt * 64; D.sc0 = D.n0; }
    else if (task < 2304) { const int t = task - 896; const int nt = t >> 4; D.kt = t & 15; D.Ksz = 1024; D.Nsrc = 2 * DFF; D.src = a.in[I_WGU] + (size_t)l * 1024 * 2 * DFF; D.dst = (bf16_t*)(a.ws + wbase(l) + WO_GU); D.n0 = nt * 64;
        const int tt = D.n0 >> 8, bj = (D.n0 >> 7) & 1, jj = D.n0 & 127; D.sc0 = bj * DFF + tt * 128 + jj; }
    else { const int t = task - 2304; const int nt = t / 44; D.kt = t % 44; D.Ksz = DFF; D.Nsrc = 1024; D.src = a.in[I_WDN] + (size_t)l * DFF * 1024; D.dst = (bf16_t*)(a.ws + wbase(l) + WO_DN); D.n0 = nt * 64; D.sc0 = D.n0; }
    return D;
}
__device__ __forceinline__ void wconv_issue(f32x4 (&v)[2], const WconvDesc& D, int tid) {
    const int c4 = tid & 15;
#pragma unroll
    for (int h = 0; h < 2; ++h) { const int kr = (tid >> 4) + 32 * h; v[h] = (f32x4){0.f, 0.f, 0.f, 0.f};
        if (!D.zero) v[h] = *(const f32x4*)(D.src + (size_t)(D.kt * 64 + kr) * D.Nsrc + D.sc0 + c4 * 4); }
}
__device__ __forceinline__ void wconv_loop(const Args& a, int l, int first, int stride, unsigned char* lds) {
    if (first >= WCONV_TASKS) return;
    const int tid = opaque_tid();
    float* tile = (float*)lds;
    f32x4 v[2]; WconvDesc D = wconv_decode(a, l, first); wconv_issue(v, D, tid);
    for (int task = first; task < WCONV_TASKS; task += stride) {
        { const int c4 = tid & 15;
#pragma unroll
          for (int h = 0; h < 2; ++h) { const int kr = (tid >> 4) + 32 * h;
              tile[kr * 65 + c4 * 4 + 0] = v[h][0]; tile[kr * 65 + c4 * 4 + 1] = v[h][1]; tile[kr * 65 + c4 * 4 + 2] = v[h][2]; tile[kr * 65 + c4 * 4 + 3] = v[h][3]; } }
        __syncthreads();
        const WconvDesc C = D;
        if (task + stride < WCONV_TASKS) { D = wconv_decode(a, l, task + stride); wconv_issue(v, D, tid); }
        { const int n = tid >> 3, k8 = tid & 7; float r[8];
#pragma unroll
          for (int i = 0; i < 8; ++i) r[i] = tile[(k8 * 8 + i) * 65 + n];
          u32x4 w; w.x = cvt_pk_bf16(r[0], r[1]); w.y = cvt_pk_bf16(r[2], r[3]); w.z = cvt_pk_bf16(r[4], r[5]); w.w = cvt_pk_bf16(r[6], r[7]);
          *(u32x4*)(C.dst + (size_t)(C.n0 + n) * C.Ksz + C.kt * 64 + k8 * 8) = w; }
        __syncthreads();
    }
}

#define RCOL(j) ((((j) >> 1) << 9) + lane * 8 + (((j) & 1) << 2))
struct RowRegs { f32x4 xv[4], yv[4]; };
__device__ __forceinline__ void row_load(RowRegs& R, int row, int lane, const bf16_t* y, const float* ypart, int nsl, const void* xl_src, const void* xc_src, bool xbf) {
    if (xbf) { const bf16_t* xs = row < ML ? (const bf16_t*)xl_src + (size_t)row * DM : (const bf16_t*)xc_src + (size_t)(row - ML) * DM;
#pragma unroll
        for (int j = 0; j < 4; ++j) R.xv[j] = bf4_to_f32(*(const u32x2*)(xs + RCOL(j))); }
    else { const float* xs = row < ML ? (const float*)xl_src + (size_t)row * DM : (const float*)xc_src + (size_t)(row - ML) * DM;
#pragma unroll
        for (int j = 0; j < 4; ++j) R.xv[j] = *(const f32x4*)(xs + RCOL(j)); }
    if (y) {
        if (row < ML) {
#pragma unroll
            for (int j = 0; j < 4; ++j) R.yv[j] = bf4_to_f32(*(const u32x2*)(y + (size_t)row * DM + RCOL(j)));
        } else {
#pragma unroll
            for (int j = 0; j < 4; ++j) R.yv[j] = (f32x4){0.f, 0.f, 0.f, 0.f};
#pragma unroll
            for (int sl = 0; sl < 7; ++sl) if (sl < nsl) {
#pragma unroll
                for (int j = 0; j < 4; ++j) R.yv[j] += *(const f32x4*)(ypart + ((size_t)sl * MC + (row - ML)) * DM + RCOL(j)); }
        }
    }
}
__device__ __forceinline__ void row_process(const Args& a, RowRegs& C, int row, int lane, bool has_y, void* xl_dst, void* xc_dst, bool obf,
                         const f32x4 (&gyv)[4], int l_gate, int gate_idx, bool do_h, const f32x4 (&ghv)[4], int l_h, int shift_idx, int scale_idx, f32x4 (&gtv)[4], f32x4 (&s1v)[4], f32x4 (&s2v)[4], int& cur) {
    const float* modv = (const float*)(a.ws + WS_MODV); bf16_t* hbuf = (bf16_t*)(a.ws + WS_HBUF);
    const int mrow = row < ML ? (row >> 12) : 4;
    if (mrow != cur) { cur = mrow;
    if (has_y) { const float* gate = modv + (size_t)(l_gate * 5 + mrow) * 6144 + gate_idx * 1024;
#pragma unroll
        for (int j = 0; j < 4; ++j) gtv[j] = *(const f32x4*)(gate + RCOL(j)); }
    if (do_h) { const float* sh = modv + (size_t)(l_h * 5 + mrow) * 6144 + shift_idx * 1024; const float* sc = modv + (size_t)(l_h * 5 + mrow) * 6144 + scale_idx * 1024;
#pragma unroll
        for (int j = 0; j < 4; ++j) { s1v[j] = *(const f32x4*)(sh + RCOL(j)); s2v[j] = *(const f32x4*)(sc + RCOL(j)); } } }
    if (has_y) {
        float ss = 0.f;
#pragma unroll
        for (int j = 0; j < 4; ++j) ss += C.yv[j][0] * C.yv[j][0] + C.yv[j][1] * C.yv[j][1] + C.yv[j][2] * C.yv[j][2] + C.yv[j][3] * C.yv[j][3];
        ss = wave_sum(ss); const float rstd = rsqrtf(ss * (1.f / 1024.f) + 1e-6f);
#pragma unroll
        for (int j = 0; j < 4; ++j) C.xv[j] = C.xv[j] + gtv[j] * (C.yv[j] * rstd * gyv[j]);
        if (obf) { bf16_t* xd = row < ML ? (bf16_t*)xl_dst + (size_t)row * DM : (bf16_t*)xc_dst + (size_t)(row - ML) * DM;
#pragma unroll
            for (int j = 0; j < 4; ++j) { const u32x2 w = f32_to_bf4(C.xv[j]); *(u32x2*)(xd + RCOL(j)) = w; C.xv[j] = bf4_to_f32(w); } }
        else { float* xd = row < ML ? (float*)xl_dst + (size_t)row * DM : (float*)xc_dst + (size_t)(row - ML) * DM;
#pragma unroll
            for (int j = 0; j < 4; ++j) *(f32x4*)(xd + RCOL(j)) = C.xv[j]; }
    }
    if (do_h) {
        float ss = 0.f;
#pragma unroll
        for (int j = 0; j < 4; ++j) ss += C.xv[j][0] * C.xv[j][0] + C.xv[j][1] * C.xv[j][1] + C.xv[j][2] * C.xv[j][2] + C.xv[j][3] * C.xv[j][3];
        ss = wave_sum(ss); const float rstd = rsqrtf(ss * (1.f / 1024.f) + 1e-6f);
#pragma unroll
        for (int j = 0; j < 4; ++j) { const f32x4 h = (C.xv[j] * rstd * ghv[j]) * (1.f + s2v[j]) + s1v[j];
            u32x2 w; w.x = cvt_pk_bf16(h[0], h[1]); w.y = cvt_pk_bf16(h[2], h[3]);
            *(u32x2*)(hbuf + (size_t)row * DM + RCOL(j)) = w; }
    }
}
__device__ __forceinline__ void row_pass(const Args& a, int mrows, const bf16_t* y, const float* ypart, int nsl, const void* xl_src, const void* xc_src, bool xbf, void* xl_dst, void* xc_dst, bool obf,
                         const float* gy, int l_gate, int gate_idx, bool do_h, const float* gh, int l_h, int shift_idx, int scale_idx) {
    const int tid = opaque_tid(); const int lane = tid & 63, wave = tid >> 6;
    const int stride = gridDim.x * 8;
    int row = blockIdx.x * 8 + wave;
    f32x4 gyv[4], ghv[4];
#pragma unroll
    for (int j = 0; j < 4; ++j) { gyv[j] = y ? *(const f32x4*)(gy + RCOL(j)) : (f32x4){0.f, 0.f, 0.f, 0.f}; ghv[j] = do_h ? *(const f32x4*)(gh + RCOL(j)) : (f32x4){0.f, 0.f, 0.f, 0.f}; }
    f32x4 gtv[4], s1v[4], s2v[4]; int cur = -1;
#pragma unroll
    for (int j = 0; j < 4; ++j) { gtv[j] = (f32x4){0.f, 0.f, 0.f, 0.f}; s1v[j] = gtv[j]; s2v[j] = gtv[j]; }
    RowRegs N0, N1;
    if (row < mrows) row_load(N0, row, lane, y, ypart, nsl, xl_src, xc_src, xbf);
    if (row + stride < mrows) row_load(N1, row + stride, lane, y, ypart, nsl, xl_src, xc_src, xbf);
    for (; row < mrows; row += 2 * stride) {
        RowRegs C0 = N0, C1 = N1;
        const bool two = row + stride < mrows;
        if (row + 2 * stride < mrows) row_load(N0, row + 2 * stride, lane, y, ypart, nsl, xl_src, xc_src, xbf);
        if (row + 3 * stride < mrows) row_load(N1, row + 3 * stride, lane, y, ypart, nsl, xl_src, xc_src, xbf);
        row_process(a, C0, row, lane, y != nullptr, xl_dst, xc_dst, obf, gyv, l_gate, gate_idx, do_h, ghv, l_h, shift_idx, scale_idx, gtv, s1v, s2v, cur);
        if (two) row_process(a, C1, row + stride, lane, y != nullptr, xl_dst, xc_dst, obf, gyv, l_gate, gate_idx, do_h, ghv, l_h, shift_idx, scale_idx, gtv, s1v, s2v, cur);
    }
}

#undef RCOL

__device__ __forceinline__ void lwconv_task(const Args& a, int l, int frag) {
    const int tid = opaque_tid(); const int lane = tid >> 3, j = tid & 7;
    const float* W; int ct, ks;
    if (frag < 128) { const int m = frag >> 6, rem = frag & 63, d = rem >> 5; ct = (rem >> 1) & 15; ks = rem & 1; W = (m == 0 ? a.in[I_W2] : a.in[I_A2]) + (size_t)(l * 2 + d) * 64 * 256; }
    else { const int rem = frag - 128; ct = rem >> 2; ks = rem & 3; W = a.in[I_G2] + (size_t)l * 128 * 256; }
    const int r = ks * 32 + (lane >> 4) * 8 + j, c = ct * 16 + (lane & 15);
    ((bf16_t*)(a.ws + lwbase(l)))[(size_t)frag * 512 + lane * 8 + j] = f2bf(W[r * 256 + c]);
}
__device__ __forceinline__ bf16x8 lds_afrag(const float* p) {
    const f32x4 x0 = *(const f32x4*)p, x1 = *(const f32x4*)(p + 4);
    u32x4 w; w.x = cvt_pk_bf16(x0[0], x0[1]); w.y = cvt_pk_bf16(x0[2], x0[3]); w.z = cvt_pk_bf16(x1[0], x1[1]); w.w = cvt_pk_bf16(x1[2], x1[3]); return __builtin_bit_cast(bf16x8, w);
}
struct PrepRegs { u32x2 fraw[9], sraw[9]; };
__device__ __forceinline__ void prep_issue_loads(PrepRegs& R, const bf16_t* pxr, int tile, int tid) {
#pragma unroll
    for (int it = 0; it < 9; ++it) {
        const int i = tid + it * NTHR; const int tk = i / (NPXR / 4), j = (i - tk * (NPXR / 4)) * 4; const int row = tile * 16 + tk;
        R.fraw[it] = *(const u32x2*)(pxr + (size_t)row * NPXR + j);
        int nrow; bool valid;
        if (row < ML) { const int t = row & 4095; const int q = j < 384 ? j / 96 : (j - 384) / 192;
            if (q == 0) { valid = (t & 63) > 0; nrow = row - 1; } else if (q == 1) { valid = (t & 63) < 63; nrow = row + 1; }
            else if (q == 2) { valid = t >= 64; nrow = row - 64; } else { valid = t < TL - 64; nrow = row + 64; } }
        else { const int c = (row - ML) & 255; const int hf = j < 384 ? j / 192 : (j - 384) / 384;
            if (hf == 0) { valid = c > 0; nrow = row - 1; } else { valid = c < 255; nrow = row + 1; } }
        R.sraw[it] = (u32x2){0u, 0u}; if (valid) R.sraw[it] = *(const u32x2*)(pxr + (size_t)nrow * NPXR + j);
    }
}
__device__ __forceinline__ void rwkv_prep_tile(const Args& a, int l, int tile, int tile_next, PrepRegs& R, unsigned char* lds) {
    float* mx = (float*)lds; float* rinv = mx + 16 * NPXR;
    const int tid = opaque_tid(), lane = tid & 63, wave = tid >> 6, fr = lane & 15, quad = lane >> 4;
    const bf16_t* pxr = (const bf16_t*)(a.ws + WS_PXR);
    const float* mu = a.in[I_MU] + l * NPXR;
    unsigned char* prep = a.ws + WS_PREP;
    float* PW = (float*)(prep + PREP_W); float* PKA = (float*)(prep + PREP_KA); bf16_t* PKD = (bf16_t*)(prep + PREP_KD); float* PKK = (float*)(prep + PREP_KK);
    bf16_t* PR = (bf16_t*)(prep + PREP_R); bf16_t* PV = (bf16_t*)(prep + PREP_V); bf16_t* PG = (bf16_t*)(prep + PREP_G);
    const size_t row0 = (size_t)tile * 16;
    {
#pragma unroll
        for (int it = 0; it < 9; ++it) {
            const int i = tid + it * NTHR; const int tk = i / (NPXR / 4), j = (i - tk * (NPXR / 4)) * 4; const int row = tile * 16 + tk;
            const f32x4 f = bf4_to_f32(R.fraw[it]), sv = bf4_to_f32(R.sraw[it]);
            const f32x4 muv = *(const f32x4*)(mu + j);
            f32x4 m = f + (sv - f) * muv;
            if (j >= 256 && j < 384) { for (int e = 0; e < 4; ++e) m[e] = __builtin_amdgcn_rcpf(1.f + __expf(-m[e])); }
            else if (j >= 896 && j < 1024) { for (int e = 0; e < 4; ++e) m[e] = 1.f - 2.f * __builtin_amdgcn_rcpf(1.f + __expf(2.f * m[e])); }
            *(f32x4*)(mx + tk * NPXR + j) = m;
            if (j < 256) *(u32x2*)(PR + (size_t)row * 256 + j) = f32_to_bf4(m);
            else if (j >= 640 && j < 896) *(u32x2*)(PV + (size_t)row * 256 + (j - 640)) = f32_to_bf4(m);
        }
    }
    __syncthreads();
    {
#pragma unroll
        for (int tt = 0; tt < 2; ++tt) { const int tk = wave * 2 + tt;
#pragma unroll
            for (int hh = 0; hh < 4; ++hh) { const float x = mx[tk * NPXR + 384 + hh * 64 + lane] * a.in[I_KK][l * 256 + hh * 64 + lane];
                const float ss = wave_sum(x * x); const float ri = fminf(__builtin_amdgcn_rsqf(ss), 1e12f);
                PKK[(row0 + tk) * 256 + hh * 64 + lane] = x * ri; if (lane == 0) rinv[tk * 4 + hh] = ri; } }
    }
    __syncthreads();
    if (tile_next >= 0) prep_issue_loads(R, pxr, tile_next, tid);
    const bf16_t* lw = (const bf16_t*)(a.ws + lwbase(l));
    const size_t orow = row0 + fr;
#pragma unroll 1
    for (int cc = 0; cc < 2; ++cc) {
        const int ct = wave * 2 + cc; const int c0 = ct * 16 + quad * 4; const int hh = ct >> 2;
        const f32x4 kx = *(const f32x4*)(mx + fr * NPXR + 384 + c0);
        const f32x4 kkp = *(const f32x4*)(a.in[I_KK] + l * 256 + c0), kap = *(const f32x4*)(a.in[I_KA] + l * 256 + c0);
        const float ri = rinv[fr * 4 + hh];
        bf16x8 wg[4], ww[2][2], wa[2][2]; f32x4 w0p2[2], a0p2[2];
#pragma unroll
        for (int ks = 0; ks < 4; ++ks) wg[ks] = *(const bf16x8*)(lw + (size_t)(128 + ct * 4 + ks) * 512 + lane * 8);
#pragma unroll
        for (int d = 0; d < 2; ++d) {
#pragma unroll
            for (int ks = 0; ks < 2; ++ks) { ww[d][ks] = *(const bf16x8*)(lw + (size_t)((d * 16 + ct) * 2 + ks) * 512 + lane * 8); wa[d][ks] = *(const bf16x8*)(lw + (size_t)(64 + (d * 16 + ct) * 2 + ks) * 512 + lane * 8); }
            w0p2[d] = *(const f32x4*)(a.in[I_W0] + (l * 2 + d) * 256 + c0); a0p2[d] = *(const f32x4*)(a.in[I_A0] + (l * 2 + d) * 256 + c0); }
        {
            f32x4 acc = {0.f, 0.f, 0.f, 0.f};
#pragma unroll
            for (int ks = 0; ks < 4; ++ks) { const bf16x8 wf = wg[ks]; const bf16x8 af = lds_afrag(mx + fr * NPXR + 256 + ks * 32 + quad * 8);
                acc = __builtin_amdgcn_mfma_f32_16x16x32_bf16(wf, af, acc, 0, 0, 0); }
            *(u32x2*)(PG + orow * 256 + c0) = f32_to_bf4(acc);
        }
#pragma unroll
        for (int d = 0; d < 2; ++d) {
            f32x4 accw = {0.f, 0.f, 0.f, 0.f}, acca = {0.f, 0.f, 0.f, 0.f};
#pragma unroll
            for (int ks = 0; ks < 2; ++ks) {
                const bf16x8 wf = ww[d][ks]; const bf16x8 af = lds_afrag(mx + fr * NPXR + 896 + d * 64 + ks * 32 + quad * 8);
                accw = __builtin_amdgcn_mfma_f32_16x16x32_bf16(wf, af, accw, 0, 0, 0);
                const bf16x8 wf2 = wa[d][ks]; const bf16x8 af2 = lds_afrag(mx + fr * NPXR + 1024 + d * 64 + ks * 32 + quad * 8);
                acca = __builtin_amdgcn_mfma_f32_16x16x32_bf16(wf2, af2, acca, 0, 0, 0); }
            const f32x4 w0p = w0p2[d], a0p = a0p2[d];
            f32x4 wv, kav, kdv;
#pragma unroll
            for (int e = 0; e < 4; ++e) { const float z = w0p[e] + accw[e];
                wv[e] = __expf(-0.6065306597126334f * __builtin_amdgcn_rcpf(1.f + __expf(-z)));
                const float av = __builtin_amdgcn_rcpf(1.f + __expf(-(a0p[e] + acca[e])));
                kav[e] = kx[e] * kkp[e] * ri * av; kdv[e] = kx[e] * (1.f + (av - 1.f) * kap[e]); }
            *(f32x4*)(PW + (orow * 2 + d) * 256 + c0) = wv; *(f32x4*)(PKA + (orow * 2 + d) * 256 + c0) = kav; *(u32x2*)(PKD + (orow * 2 + d) * 256 + c0) = f32_to_bf4(kdv);
        }
    }
    __syncthreads();
}

__device__ __forceinline__ unsigned gl_ld(const unsigned* p) { return __hip_atomic_load(p, __ATOMIC_RELAXED, __HIP_MEMORY_SCOPE_AGENT); }
__device__ __forceinline__ void gl_add(unsigned* p, unsigned v) { (void)__hip_atomic_fetch_add(p, v, __ATOMIC_RELAXED, __HIP_MEMORY_SCOPE_AGENT); }
#ifndef PREP_EARLY_TILES
#define PREP_EARLY_TILES 512
#endif
constexpr int PREP_TILES = MT / 16, PREP_EARLY = PREP_EARLY_TILES, PREP_LATE_ROUNDS = (PREP_TILES - PREP_EARLY + 127) / 128;
constexpr int CW_PREP = 4096;
static_assert(PREP_LATE_ROUNDS <= 8 && PREP_EARLY % 256 == 0 && PREP_EARLY >= 64, "prep split");
__device__ __forceinline__ int prep_tile_of(int o) {
    if (o < 64) return ML / 16 + o;
    const int q = o - 64, b = q & 3, p = q >> 2, i = p >> 1; return b * 256 + ((p & 1) ? 255 - i : i);
}
__device__ __forceinline__ void prep_publish(unsigned* cnt) {
    asm volatile("s_waitcnt vmcnt(0)" ::: "memory");
    __syncthreads();
    if (threadIdx.x == 0) { __builtin_amdgcn_fence(__ATOMIC_RELEASE, "agent"); asm volatile("s_waitcnt vmcnt(0)" ::: "memory"); gl_add(cnt, 1u); }
}
__device__ __forceinline__ void prep_wait_for_chunk(const unsigned* cnt_layer, int ck, int& rd) {
    if (ck < 16 || rd >= PREP_LATE_ROUNDS) return;
    const int ft = ck - 16; const int i = ft < 128 ? ft : 255 - ft; const int oneed = 64 + 8 * i + 7;
    if (oneed < PREP_EARLY) return;
    const int r = (oneed - PREP_EARLY) >> 7;
    if (rd > r) return;
    while (rd <= r) {
        const unsigned expect = (unsigned)((PREP_TILES - PREP_EARLY - rd * 128) < 128 ? (PREP_TILES - PREP_EARLY - rd * 128) : 128);
        unsigned sp = 0; while (gl_ld(cnt_layer + 64 * rd) < expect) { __builtin_amdgcn_s_sleep(2); if (++sp > (1u << 22)) break; }
        ++rd;
    }
    __builtin_amdgcn_fence(__ATOMIC_ACQUIRE, "agent"); asm volatile("s_waitcnt vmcnt(0)" ::: "memory");
}
constexpr int SC_STEPS = 16, SC_NCH = (CL + TL) / SC_STEPS, SC_OPB = 5 * SC_STEPS * 256 + SC_STEPS * 64, SC_PB = SC_STEPS * 16 * 64;
__device__ __forceinline__ int scan_row(int b, int d, int s) {
    if (d == 0) return s < CL ? ML + b * CL + s : b * TL + (s - CL);
    return s < CL ? ML + b * CL + (CL - 1 - s) : b * TL + (TL - 1 - (s - CL));
}
typedef float f32x2 __attribute__((ext_vector_type(2)));
struct ScanStage { f32x4 w, kk, ka; u32x2 kd, r, v; };
struct ScanPtrs { const float *PW, *PKA, *PKK; const bf16_t *PKD, *PR, *PV; float* YS; int b, h, d, rgp; };
__device__ __forceinline__ void scan_issue_loads(ScanStage& R, const ScanPtrs& P, int ck, int lt) {
    const int st = lt >> 4, q4 = lt & 15; const size_t row = (size_t)scan_row(P.b, P.d, ck * SC_STEPS + st); const int co = P.h * 64 + q4 * 4;
    R.w = *(const f32x4*)(P.PW + (row * 2 + P.d) * 256 + co); R.kd = *(const u32x2*)(P.PKD + (row * 2 + P.d) * 256 + co); R.kk = *(const f32x4*)(P.PKK + row * 256 + co);
    R.ka = *(const f32x4*)(P.PKA + (row * 2 + P.d) * 256 + co); R.r = *(const u32x2*)(P.PR + row * 256 + co);
    { const int lv = lt & 63; const size_t rowV = (size_t)scan_row(P.b, P.d, ck * SC_STEPS + (lv >> 2)); R.v = *(const u32x2*)(P.PV + rowV * 256 + P.h * 64 + P.rgp * 16 + (lv & 3) * 4); }
}
__device__ __forceinline__ void scan_store_lds(const ScanStage& R, unsigned char* buf, int lt) {
    const int st = lt >> 4, q4 = lt & 15;
    unsigned char* p = buf + st * 256 + q4 * 16;
    *(f32x4*)(p) = R.w; *(f32x4*)(p + SC_STEPS * 256) = bf4_to_f32(R.kd); *(f32x4*)(p + 2 * SC_STEPS * 256) = R.kk; *(f32x4*)(p + 3 * SC_STEPS * 256) = R.ka; *(f32x4*)(p + 4 * SC_STEPS * 256) = bf4_to_f32(R.r);
    if (lt < 64) *(f32x4*)(buf + 5 * SC_STEPS * 256 + (lt >> 2) * 64 + (lt & 3) * 16) = bf4_to_f32(R.v);
}
__device__ __forceinline__ void scan_reduce_y(const ScanPtrs& P, const unsigned char* pb, int ck, int lt) {
    const int st = lt >> 4, row = lt & 15; const float* p = (const float*)(pb + (st * 16 + row) * 64);
    const f32x4 p0 = *(const f32x4*)p, p1 = *(const f32x4*)(p + 4), p2 = *(const f32x4*)(p + 8), p3 = *(const f32x4*)(p + 12);
    const f32x4 q = (p0 + p1) + (p2 + p3);
    const size_t grow = (size_t)scan_row(P.b, P.d, ck * SC_STEPS + st);
    P.YS[(grow * 2 + P.d) * 256 + P.h * 64 + P.rgp * 16 + row] = (q[0] + q[1]) + (q[2] + q[3]);
}
struct ScanOps { f32x4 w4, kd4, kk4, ka4, r4; float va; };
__device__ __forceinline__ void scan_ld_ops(ScanOps& o, const unsigned char* bp, const unsigned char* vp, int st) {
    o.w4 = *(const f32x4*)(bp + st * 256); o.kd4 = *(const f32x4*)(bp + SC_STEPS * 256 + st * 256); o.kk4 = *(const f32x4*)(bp + 2 * SC_STEPS * 256 + st * 256);
    o.ka4 = *(const f32x4*)(bp + 3 * SC_STEPS * 256 + st * 256); o.r4 = *(const f32x4*)(bp + 4 * SC_STEPS * 256 + st * 256);
    o.va = *(const float*)(vp + st * 64);
}
#define SCAN_BAR() asm volatile("s_waitcnt lgkmcnt(0)\n\ts_barrier" ::: "memory")
__device__ __forceinline__ void scan_task(const Args& a, int task, const unsigned* prep_cnt, unsigned char* lds) {
    const int tid = opaque_tid(), lane = tid & 63, wave = tid >> 6;
    const int xcd = task & 7, kx = task >> 3; const int chain = xcd * 4 + (kx >> 2); ScanPtrs P;
    P.rgp = kx & 3; P.b = chain >> 3; P.h = (chain >> 1) & 3; P.d = chain & 1;
    unsigned char* prep = a.ws + WS_PREP;
    P.PW = (const float*)(prep + PREP_W); P.PKA = (const float*)(prep + PREP_KA); P.PKD = (const bf16_t*)(prep + PREP_KD); P.PKK = (const float*)(prep + PREP_KK);
    P.PR = (const bf16_t*)(prep + PREP_R); P.PV = (const bf16_t*)(prep + PREP_V); P.YS = (float*)(a.ws + WS_YS);
    unsigned char* pbase = lds + 2 * SC_OPB;
    __syncthreads();
    if (wave >= 4) {
        const int lt = tid - 256; ScanStage R0, R1, R2;
        int rd = 0;
        scan_issue_loads(R0, P, 0, lt); scan_store_lds(R0, lds, lt);
        scan_issue_loads(R1, P, 1, lt); scan_issue_loads(R2, P, 2, lt); scan_issue_loads(R0, P, 3, lt);
        SCAN_BAR();
#define SCAN_LOADER_IT(CK, RS) do { const int ck_ = (CK); if (ck_ < SC_NCH) { \
            if (ck_ + 1 < SC_NCH) scan_store_lds(RS, lds + ((ck_ + 1) & 1) * SC_OPB, lt); \
            if (ck_ + 4 < SC_NCH) { prep_wait_for_chunk(prep_cnt, ck_ + 4, rd); scan_issue_loads(RS, P, ck_ + 4, lt); } \
            if (ck_ >= 1) scan_reduce_y(P, pbase + ((ck_ - 1) & 1) * SC_PB, ck_ - 1, lt); \
            SCAN_BAR(); } } while (0)
        for (int ck = 0; ck < SC_NCH; ck += 3) { SCAN_LOADER_IT(ck, R1); SCAN_LOADER_IT(ck + 1, R2); SCAN_LOADER_IT(ck + 2, R0); }
#undef SCAN_LOADER_IT
        scan_reduce_y(P, pbase + ((SC_NCH - 1) & 1) * SC_PB, SC_NCH - 1, lt);
    } else {
        const int rw = lane >> 4, kq = lane & 15, rowA = wave * 4 + rw;
        f32x2 SL = {0.f, 0.f}, SH = {0.f, 0.f};
        SCAN_BAR();
        for (int ck = 0; ck < SC_NCH; ++ck) {
            const unsigned char* bp = lds + (ck & 1) * SC_OPB + kq * 16;
            const unsigned char* vp = lds + (ck & 1) * SC_OPB + 5 * SC_STEPS * 256 + rowA * 4;
            float* pw = (float*)(pbase + (ck & 1) * SC_PB) + rowA * 16 + kq;
            ScanOps o0, o1, o2;
            scan_ld_ops(o0, bp, vp, 0); scan_ld_ops(o1, bp, vp, 1);
#pragma unroll
            for (int st = 0; st < SC_STEPS; ++st) {
                scan_ld_ops(o2, bp, vp, st + 2 < SC_STEPS ? st + 2 : SC_STEPS - 1);
                const f32x2 wlo = {o0.w4[0], o0.w4[1]}, whi = {o0.w4[2], o0.w4[3]}, kdlo = {o0.kd4[0], o0.kd4[1]}, kdhi = {o0.kd4[2], o0.kd4[3]}, kklo = {o0.kk4[0], o0.kk4[1]}, kkhi = {o0.kk4[2], o0.kk4[3]},
                            kalo = {o0.ka4[0], o0.ka4[1]}, kahi = {o0.ka4[2], o0.ka4[3]}, rlo = {o0.r4[0], o0.r4[1]}, rhi = {o0.r4[2], o0.r4[3]};
                const f32x2 dp = SL * kklo + SH * kkhi;
                const float sa = row16_sum(dp[0] + dp[1]);
                const f32x2 TL = SL * wlo + kdlo * o0.va, TH = SH * whi + kdhi * o0.va;
                SL = TL - kalo * sa; SH = TH - kahi * sa;
                const f32x2 yy = SL * rlo + SH * rhi;
                pw[st * 256] = yy[0] + yy[1];
                o0 = o1; o1 = o2;
            }
            SCAN_BAR();
        }
    }
}

struct RoRegs { float y0, y1; unsigned short r, kd0, kd1, v, g; };
__device__ __forceinline__ void ro_load(RoRegs& R, size_t row, int c, const float* YS, const bf16_t* PR, const bf16_t* PKD, const bf16_t* PV, const bf16_t* PG) {
    R.y0 = YS[(row * 2 + 0) * 256 + c]; R.y1 = YS[(row * 2 + 1) * 256 + c]; R.r = PR[row * 256 + c]; R.kd0 = PKD[(row * 2 + 0) * 256 + c]; R.kd1 = PKD[(row * 2 + 1) * 256 + c];
    R.v = PV[row * 256 + c]; R.g = PG[row * 256 + c];
}
__device__ __forceinline__ void rwkv_out(const Args& a, int l, int mrows) {
    const int tid = opaque_tid(), c = tid & 255;
    unsigned char* prep = a.ws + WS_PREP;
    const bf16_t* PKD = (const bf16_t*)(prep + PREP_KD); const bf16_t* PR = (const bf16_t*)(prep + PREP_R); const bf16_t* PV = (const bf16_t*)(prep + PREP_V); const bf16_t* PG = (const bf16_t*)(prep + PREP_G);
    const float* YS = (const float*)(a.ws + WS_YS); bf16_t* hbuf = (bf16_t*)(a.ws + WS_HBUF);
    const float lg = a.in[I_LNXG][l * 256 + c], lb = a.in[I_LNXB][l * 256 + c], rk = a.in[I_RK][l * 256 + c];
    const size_t stride = (size_t)gridDim.x * 2;
    size_t row = (size_t)blockIdx.x * 2 + (tid >> 8);
    RoRegs N;
    if (row < (size_t)mrows) ro_load(N, row, c, YS, PR, PKD, PV, PG);
    for (; row < (size_t)mrows; row += stride) {
        const RoRegs C = N;
        if (row + stride < (size_t)mrows) ro_load(N, row + stride, c, YS, PR, PKD, PV, PG);
        const float y = C.y0 + C.y1;
        const float mean = wave_sum(y) * (1.f / 64.f); const float dv = y - mean; const float var = wave_sum(dv * dv) * (1.f / 64.f);
        const float yn = dv * rsqrtf(var + 64e-5f) * lg + lb;
        const float bonus = wave_sum(bf2f(C.r) * (bf2f(C.kd0) + bf2f(C.kd1)) * rk);
        const float o = (yn + bonus * bf2f(C.v)) * bf2f(C.g);
        hbuf[row * DM + 768 + c] = f2bf(o);
    }
}

__device__ __forceinline__ bf16x8 load_rope8(const bf16_t* base, int sgm, bool rope, const float* rc, const float* rs, float scale) {
    const u32x4 own = *(const u32x4*)(base + sgm * 8);
    float o[8];
#pragma unroll
    for (int i = 0; i < 4; ++i) { o[2 * i] = __builtin_bit_cast(float, own[i] << 16); o[2 * i + 1] = __builtin_bit_cast(float, own[i] & 0xffff0000u); }
    if (rope) {
        const u32x4 par = *(const u32x4*)(base + (sgm ^ 2) * 8);
        const int tb = (sgm >> 2) * 16 + (sgm & 1) * 8; const float sgn = (sgm & 2) ? 1.f : -1.f;
#pragma unroll
        for (int i = 0; i < 4; ++i) { const float p0 = __builtin_bit_cast(float, par[i] << 16), p1 = __builtin_bit_cast(float, par[i] & 0xffff0000u);
            o[2 * i] = o[2 * i] * rc[tb + 2 * i] + sgn * p0 * rs[tb + 2 * i]; o[2 * i + 1] = o[2 * i + 1] * rc[tb + 2 * i + 1] + sgn * p1 * rs[tb + 2 * i + 1]; }
    }
    u32x4 w; w.x = cvt_pk_bf16(o[0] * scale, o[1] * scale); w.y = cvt_pk_bf16(o[2] * scale, o[3] * scale); w.z = cvt_pk_bf16(o[4] * scale, o[5] * scale); w.w = cvt_pk_bf16(o[6] * scale, o[7] * scale);
    return __builtin_bit_cast(bf16x8, w);
}
constexpr int KS_PITCH = 72, VT_PITCH = 136, VT_OFF = 128 * KS_PITCH * 2;
__device__ __forceinline__ void attn_unit(const Args& a, int l, int unit, unsigned char* lds) {
    const int tid = opaque_tid(), lane = tid & 63, wave = tid >> 6, fr = lane & 15, quad = lane >> 4;
    bf16_t* Ks = (bf16_t*)lds; bf16_t* Vt = (bf16_t*)(lds + VT_OFF);
    const bf16_t* pxa = (const bf16_t*)(a.ws + WS_PXA); bf16_t* hbuf = (bf16_t*)(a.ws + WS_HBUF);
    const float* rc = (const float*)(a.ws + WS_ROPE); const float* rs = rc + TL * 32;
    const bool isctx = unit >= 256; int b, nblk, kvh, qrow0;
    if (!isctx) { b = unit >> 6; nblk = (unit >> 1) & 31; kvh = unit & 1; qrow0 = b * TL + nblk * 128; }
    else { const int u2 = unit - 256; b = u2 >> 2; nblk = (u2 >> 1) & 1; kvh = u2 & 1; qrow0 = ML + b * CL + nblk * 128; }
    const int qi = wave * 16 + fr; const size_t qrow = (size_t)qrow0 + qi; const int tq = nblk * 128 + qi;
    bf16x8 bq[4][2]; float mrun[4], lsum[4]; f32x4 O[4][4];
#pragma unroll
    for (int g = 0; g < 4; ++g) { const int head = kvh * 4 + g;
#pragma unroll
        for (int ks = 0; ks < 2; ++ks) bq[g][ks] = load_rope8(pxa + qrow * NPXA + 512 + head * 64, 4 * ks + quad, !isctx, rc + tq * 32, rs + tq * 32, 0.18033688011112042f);
        mrun[g] = a.in[I_SINK][l * 8 + head] * 1.4426950408889634f; lsum[g] = quad == 0 ? 1.f : 0.f;
#pragma unroll
        for (int dt = 0; dt < 4; ++dt) O[g][dt] = (f32x4){0.f, 0.f, 0.f, 0.f}; }
    const int nchunk = isctx ? 2 : 5;
    for (int ch = 0; ch < nchunk; ++ch) {
        const bool cchunk = ch < 2; const int lc = ch - 2; const int blk = nblk - 1 + lc;
        if (!cchunk && (blk < 0 || blk > 31)) continue;
        __syncthreads();
#pragma unroll
        for (int it = 0; it < 2; ++it) { const int item = tid + NTHR * it; const int key = item >> 3, sgm = item & 7;
            const size_t krow = cchunk ? (size_t)ML + b * CL + ch * 128 + key : (size_t)b * TL + blk * 128 + key; const int tk = blk * 128 + key;
            const bf16x8 kf = load_rope8(pxa + krow * NPXA + 1024 + kvh * 64, sgm, !cchunk, rc + (cchunk ? 0 : tk) * 32, rs + (cchunk ? 0 : tk) * 32, 1.f);
            *(bf16x8*)(Ks + key * KS_PITCH + sgm * 8) = kf;
            const bf16x8 vf = *(const bf16x8*)(pxa + krow * NPXA + 1152 + kvh * 64 + sgm * 8);
#pragma unroll
            for (int i = 0; i < 8; ++i) Vt[(sgm * 8 + i) * VT_PITCH + key] = (bf16_t)vf[i]; }
        __syncthreads();
#pragma unroll 1
        for (int kt = 0; kt < 4; ++kt) {
            bf16x8 ak[2][2], av[4];
#pragma unroll
            for (int sub = 0; sub < 2; ++sub)
#pragma unroll
                for (int ks = 0; ks < 2; ++ks) ak[sub][ks] = *(const bf16x8*)(Ks + (kt * 32 + sub * 16 + fr) * KS_PITCH + ks * 32 + quad * 8);
#pragma unroll
            for (int dt = 0; dt < 4; ++dt) { const bf16_t* vp = Vt + (dt * 16 + fr) * VT_PITCH + kt * 32 + quad * 4;
                const u32x2 lo = *(const u32x2*)vp, hi = *(const u32x2*)(vp + 16); u32x4 w; w.x = lo.x; w.y = lo.y; w.z = hi.x; w.w = hi.y; av[dt] = __builtin_bit_cast(bf16x8, w); }
#pragma unroll
            for (int g = 0; g < 4; ++g) {
                f32x4 s0 = {0.f, 0.f, 0.f, 0.f}, s1 = {0.f, 0.f, 0.f, 0.f};
                s0 = __builtin_amdgcn_mfma_f32_16x16x32_bf16(ak[0][0], bq[g][0], s0, 0, 0, 0); s0 = __builtin_amdgcn_mfma_f32_16x16x32_bf16(ak[0][1], bq[g][1], s0, 0, 0, 0);
                s1 = __builtin_amdgcn_mfma_f32_16x16x32_bf16(ak[1][0], bq[g][0], s1, 0, 0, 0); s1 = __builtin_amdgcn_mfma_f32_16x16x32_bf16(ak[1][1], bq[g][1], s1, 0, 0, 0);
                if (!cchunk && lc != 1) {
#pragma unroll
                    for (int j = 0; j < 4; ++j) { const int k0 = kt * 32 + quad * 4 + j, k1 = k0 + 16;
                        const bool v0 = lc == 0 ? (k0 >= qi) : (k0 <= qi), v1 = lc == 0 ? (k1 >= qi) : (k1 <= qi);
                        s0[j] = v0 ? s0[j] : -1e30f; s1[j] = v1 ? s1[j] : -1e30f; } }
                float mx = fmaxf(fmaxf(fmaxf(s0[0], s0[1]), fmaxf(s0[2], s0[3])), fmaxf(fmaxf(s1[0], s1[1]), fmaxf(s1[2], s1[3])));
                mx = fmaxf(mx, __shfl_xor(mx, 16)); mx = fmaxf(mx, __shfl_xor(mx, 32));
                const float mold = mrun[g]; const float mn = fmaxf(mold, mx); mrun[g] = mn;
                float p[8];
#pragma unroll
                for (int j = 0; j < 4; ++j) { p[j] = __builtin_amdgcn_exp2f(s0[j] - mn); p[4 + j] = __builtin_amdgcn_exp2f(s1[j] - mn); }
                const float psum = ((p[0] + p[1]) + (p[2] + p[3])) + ((p[4] + p[5]) + (p[6] + p[7]));
                const bool grew = __builtin_amdgcn_ballot_w64(mn != mold) != 0ull;
                if (grew) { const float alpha = __builtin_amdgcn_exp2f(mold - mn); lsum[g] = lsum[g] * alpha + psum;
#pragma unroll
                    for (int dt = 0; dt < 4; ++dt) O[g][dt] = O[g][dt] * alpha; }
                else lsum[g] += psum;
                u32x4 w; w.x = cvt_pk_bf16(p[0], p[1]); w.y = cvt_pk_bf16(p[2], p[3]); w.z = cvt_pk_bf16(p[4], p[5]); w.w = cvt_pk_bf16(p[6], p[7]);
                const bf16x8 bp = __builtin_bit_cast(bf16x8, w);
#pragma unroll
                for (int dt = 0; dt < 4; ++dt) O[g][dt] = __builtin_amdgcn_mfma_f32_16x16x32_bf16(av[dt], bp, O[g][dt], 0, 0, 0);
            }
        }
    }
#pragma unroll
    for (int g = 0; g < 4; ++g) { const int head = kvh * 4 + g;
        float lt = lsum[g]; lt += __shfl_xor(lt, 16); lt += __shfl_xor(lt, 32); const float inv = 1.f / lt;
#pragma unroll
        for (int dt = 0; dt < 4; ++dt) { const f32x4 o = O[g][dt] * inv; u32x2 w; w.x = cvt_pk_bf16(o[0], o[1]); w.y = cvt_pk_bf16(o[2], o[3]);
            *(u32x2*)(hbuf + qrow * DM + 256 + head * 64 + dt * 16 + quad * 4) = w; } }
    __syncthreads();
}

__device__ __forceinline__ void gmlp_unit(const Args& a, int l, int chunk, unsigned char* lds) {
    const int tid = opaque_tid(), lane = tid & 63, wave = tid >> 6, fr = lane & 15, quad = lane >> 4;
    bf16_t* vT = (bf16_t*)lds;
    const bf16_t* pxa = (const bf16_t*)(a.ws + WS_PXA); bf16_t* hbuf = (bf16_t*)(a.ws + WS_HBUF);
    const size_t row0 = (size_t)chunk * 128;
    { const f32x4 lg = *(const f32x4*)(a.in[I_SGLNG] + l * 256 + lane * 4), lb = *(const f32x4*)(a.in[I_SGLNB] + l * 256 + lane * 4);
      u32x2 raws[16];
#pragma unroll
      for (int i = 0; i < 16; ++i) raws[i] = *(const u32x2*)(pxa + (row0 + wave * 16 + i) * NPXA + 256 + lane * 4);
#pragma unroll
      for (int hf = 0; hf < 2; ++hf) {
          unsigned pk[4][4];
#pragma unroll
          for (int i2 = 0; i2 < 4; ++i2) {
              float xn[2][4];
#pragma unroll
              for (int s2 = 0; s2 < 2; ++s2) {
                  const u32x2 raw = raws[hf * 8 + i2 * 2 + s2];
                  float x[4] = { gelu_tanh(__builtin_bit_cast(float, raw.x << 16)), gelu_tanh(__builtin_bit_cast(float, raw.x & 0xffff0000u)), gelu_tanh(__builtin_bit_cast(float, raw.y << 16)), gelu_tanh(__builtin_bit_cast(float, raw.y & 0xffff0000u)) };
                  const float mean = wave_sum((x[0] + x[1]) + (x[2] + x[3])) * (1.f / 256.f);
                  float q = 0.f;
#pragma unroll
                  for (int j = 0; j < 4; ++j) { x[j] -= mean; q += x[j] * x[j]; }
                  const float rstd = rsqrtf(wave_sum(q) * (1.f / 256.f) + 1e-5f);
#pragma unroll
                  for (int j = 0; j < 4; ++j) xn[s2][j] = x[j] * rstd * lg[j] + lb[j]; }
#pragma unroll
              for (int j = 0; j < 4; ++j) pk[j][i2] = cvt_pk_bf16(xn[0][j], xn[1][j]);
          }
#pragma unroll
          for (int j = 0; j < 4; ++j) { u32x4 w; w.x = pk[j][0]; w.y = pk[j][1]; w.z = pk[j][2]; w.w = pk[j][3];
              *(u32x4*)(vT + (lane * 4 + j) * VT_PITCH + wave * 16 + hf * 8) = w; }
      } }
    __syncthreads();
    const int pt = wave;
#pragma unroll 1
    for (int g = 0; g < 4; ++g) {
        bf16x8 af[4];
        const float* wsrc = a.in[I_SGW] + ((size_t)(l * 4 + g) * 128 + pt * 16 + fr) * 128 + quad * 8;
#pragma unroll
        for (int ks = 0; ks < 4; ++ks) { const f32x4 w0 = *(const f32x4*)(wsrc + ks * 32), w1 = *(const f32x4*)(wsrc + ks * 32 + 4);
            u32x4 w; w.x = cvt_pk_bf16(w0[0], w0[1]); w.y = cvt_pk_bf16(w0[2], w0[3]); w.z = cvt_pk_bf16(w1[0], w1[1]); w.w = cvt_pk_bf16(w1[2], w1[3]); af[ks] = __builtin_bit_cast(bf16x8, w); }
        f32x4 bs;
#pragma unroll
        for (int j = 0; j < 4; ++j) bs[j] = a.in[I_SGB][(l * 4 + g) * 128 + pt * 16 + quad * 4 + j];
        unsigned short uraw[4][4];
#pragma unroll
        for (int dt = 0; dt < 4; ++dt)
#pragma unroll
            for (int j = 0; j < 4; ++j) uraw[dt][j] = pxa[(row0 + pt * 16 + quad * 4 + j) * NPXA + g * 64 + dt * 16 + fr];
#pragma unroll
        for (int dt = 0; dt < 4; ++dt) { const int chn = g * 64 + dt * 16 + fr;
            f32x4 acc = {0.f, 0.f, 0.f, 0.f};
#pragma unroll
            for (int ks = 0; ks < 4; ++ks) { const bf16x8 bv = *(const bf16x8*)(vT + chn * VT_PITCH + ks * 32 + quad * 8); acc = __builtin_amdgcn_mfma_f32_16x16x32_bf16(af[ks], bv, acc, 0, 0, 0); }
#pragma unroll
            for (int j = 0; j < 4; ++j) { const size_t row = row0 + pt * 16 + quad * 4 + j;
                const float uu = gelu_tanh(bf2f(uraw[dt][j]));
                hbuf[row * DM + chn] = f2bf(uu * (acc[j] + bs[j])); } }
    }
    __syncthreads();
}

struct PieceOrder { int unit; bool has;
    __device__ __forceinline__ bool next(int i, pg8::Unit& u) const { if (i != 0 || !has) return false; u.pm = unit >> 2; u.pn = unit & 3; return true; }
    __device__ __forceinline__ void a_ready(const pg8::Unit&) const {}
    __device__ __forceinline__ void done(const pg8::Unit&) const {}
};
#define LAS __attribute__((address_space(3)))
constexpr size_t WS_CTL = 768 * 1024, CTL_BYTES = 32768;
constexpr int LDS_BARST_OFF = 131072 + 64;
#define XB_TMO      128
#define XB_XCNT(j)  (256  + 64 * (j))
#define XB_XSUB(j)  (1280 + 64 * (j))
#define XB_XGEN(j)  (2304 + 64 * (j))
#define XB_TOP      3328
#define XB_TOPGEN   3392
#define XCD_BAR_WORDS 3456
#define XB_SPIN_CAP (1u << 18)

__device__ __forceinline__ unsigned xb_ld(unsigned* p)              { return __hip_atomic_load(p, __ATOMIC_RELAXED, __HIP_MEMORY_SCOPE_AGENT); }
__device__ __forceinline__ unsigned xb_add(unsigned* p, unsigned v) { return __hip_atomic_fetch_add(p, v, __ATOMIC_RELAXED, __HIP_MEMORY_SCOPE_AGENT); }
__device__ __forceinline__ unsigned xb_xcc_id() { return (unsigned)__builtin_amdgcn_s_getreg((3 << 11) | 20) & 0xFu; }
#define XB_SPIN(cond, bar) do { unsigned _sp = 0; while (cond) { __builtin_amdgcn_s_sleep(1); \
    if ((++_sp & 255u) == 0u) { if (xb_ld(&(bar)[XB_TMO])) break; if (_sp > XB_SPIN_CAP) { atomicAdd(&(bar)[XB_TMO], 1u); break; } } } } while (0)

struct XcdBarrier {
    unsigned* bar; unsigned x;
    volatile LAS unsigned* st;
};

__device__ __forceinline__ XcdBarrier xcd_barrier_post(unsigned* bar, volatile LAS unsigned* st) {
    XcdBarrier b; b.bar = bar; b.x = xb_xcc_id(); b.st = st;
    if (threadIdx.x == 0) (void)xb_add(&bar[XB_XCNT(b.x)], 1u);
    return b;
}
__device__ __forceinline__ void xcd_barrier_complete(unsigned* bar, unsigned x, unsigned& nloc, unsigned& nx) {
    const unsigned G = gridDim.x * gridDim.y * gridDim.z;
    unsigned sum, cnt, mine, sp = 0u;
    for (;;) {
        sum = 0u; cnt = 0u; mine = 0u;
#pragma unroll
        for (unsigned j = 0; j < 16; ++j) { const unsigned c = xb_ld(&bar[XB_XCNT(j)]); sum += c; cnt += (c > 0u) ? 1u : 0u; mine = (j == x) ? c : mine; }
        if (sum == G) break;
        __builtin_amdgcn_s_sleep(1);
        if ((++sp & 255u) == 0u) { if (xb_ld(&bar[XB_TMO])) break; if (sp > XB_SPIN_CAP) { atomicAdd(&bar[XB_TMO], 1u); break; } }
    }
    nloc = mine > 0u ? mine : 1u; nx = cnt > 0u ? cnt : 1u;
}

__device__ __forceinline__ void xcd_barrier(const XcdBarrier& b) {
    asm volatile("s_waitcnt vmcnt(0)" ::: "memory");
    __syncthreads();
    if (threadIdx.x == 0) {
        unsigned* bar = b.bar;
        __builtin_amdgcn_s_waitcnt(0);
        unsigned nloc = b.st[0], nx = b.st[1];
        if (nloc == 0u) { xcd_barrier_complete(bar, b.x, nloc, nx); b.st[0] = nloc; b.st[1] = nx; }
        const unsigned old = xb_add(&bar[XB_XSUB(b.x)], 1u);
        const unsigned gen = old / nloc;
        if (old + 1u == (gen + 1u) * nloc) {
            __builtin_amdgcn_fence(__ATOMIC_RELEASE, "agent");
            asm volatile("s_waitcnt vmcnt(0)" ::: "memory");
            const unsigned og = xb_add(&bar[XB_TOP], 1u);
            const unsigned tg = og / nx;
            if (og + 1u == (tg + 1u) * nx) xb_add(&bar[XB_TOPGEN], 1u);
            else XB_SPIN(xb_ld(&bar[XB_TOPGEN]) == tg, bar);
            __builtin_amdgcn_fence(__ATOMIC_ACQUIRE, "agent");
            xb_add(&bar[XB_XGEN(b.x)], 1u);
            asm volatile("s_waitcnt vmcnt(0)" ::: "memory");
        } else {
            XB_SPIN(xb_ld(&bar[XB_XGEN(b.x)]) == gen, bar);
            __builtin_amdgcn_fence(__ATOMIC_ACQUIRE, "agent");
            asm volatile("s_waitcnt vmcnt(0)" ::: "memory");
        }
    }
    __syncthreads();
}

constexpr int N_PHASES = 2 + 9 * NL;
template <int MASK> __device__ __forceinline__ void run_phase(const Args& a, int ph, unsigned char* lds) {
    int G = gridDim.x, bid = blockIdx.x; asm volatile("" : "+s"(G), "+s"(bid));
    bf16_t* HB = (bf16_t*)(a.ws + WS_HBUF); float* XC = (float*)(a.ws + WS_XC); bf16_t* YD = (bf16_t*)(a.ws + WS_YD);
    if (ph == 0) { if constexpr (MASK & 1) {
        for (int t = bid; t < 192; t += G) modv_task(a, t, lds);
        for (int t = bid; t < 256; t += G) rope_task(a, t);
        wconv_loop(a, 0, bid, G, lds);
        for (int t = bid; t < 192; t += G) lwconv_task(a, 0, t); }
        return;
    }
    if (ph == 1) { if constexpr (MASK & 2) row_pass(a, MT, nullptr, nullptr, 0, a.in[I_X], a.in[I_CTX], false, nullptr, nullptr, false, nullptr, 0, 0, true, a.in[I_NORMG] + 0, 0, 0, 1); return; }
    const int l = (ph - 2) / 9, s = (ph - 2) % 9;
    const bool last = (l == NL - 1);
    const float* ng = a.in[I_NORMG] + l * 4 * DM;
    const void* xl = l == 0 ? (const void*)a.in[I_X] : (const void*)a.out; const void* xc = l == 0 ? (const void*)a.in[I_CTX] : (const void*)XC;
    void* xmid = last ? (void*)(a.ws + WS_PXA) : (void*)a.out;
    float* YP = (float*)(a.ws + WS_YP);
    const int mpost = last ? ML : MT;
    switch (s) {
    case 0: if constexpr (MASK & 4) { pg8::Gemm g{HB, (const bf16_t*)(a.ws + wbase(l)), MT, NIN, DM, DM}; pg8::StaticOrder S; S.init(MT, NIN, G, bid);
              EpiIn E{(bf16_t*)(a.ws + WS_PXA), (bf16_t*)(a.ws + WS_PXR)};
              pg8::gemm_phase<EpiIn, pg8::StaticOrder, true, true>((PG8_LAS unsigned char*)lds, g, S, E); } break;
    case 1: if constexpr (MASK & 8) { if (bid < PREP_EARLY) { PrepRegs R; prep_issue_loads(R, (const bf16_t*)(a.ws + WS_PXR), prep_tile_of(bid), opaque_tid());
              for (int o = bid; o < PREP_EARLY; o += G) rwkv_prep_tile(a, l, prep_tile_of(o), o + G < PREP_EARLY ? prep_tile_of(o + G) : -1, R, lds); } } break;
    case 2: if constexpr (MASK & 16) { unsigned* pcnt = (unsigned*)(a.ws + WS_CTL) + CW_PREP + 64 * (l * 8);
            if (bid < 128) { for (int rep = 0; rep <= PROBE_SCAN; ++rep) scan_task(a, bid, pcnt, lds); }
            else { { const int w = bid - 128, nw = G - 128;
                if (PREP_EARLY + w < PREP_TILES) { PrepRegs R; prep_issue_loads(R, (const bf16_t*)(a.ws + WS_PXR), prep_tile_of(PREP_EARLY + w), opaque_tid());
                  for (int o = PREP_EARLY + w; o < PREP_TILES; o += nw) { rwkv_prep_tile(a, l, prep_tile_of(o), o + nw < PREP_TILES ? prep_tile_of(o + nw) : -1, R, lds); prep_publish(pcnt + 64 * ((o - PREP_EARLY) / nw)); } } }
            for (int rep = 0; rep <= PROBE_ATT; ++rep) { const int w = bid - 128, nw = G - 128; const int natt = last ? 256 : 272, ngm = last ? 128 : 136;
                for (int u = w; u < natt + ngm; u += nw) { if (u < natt) attn_unit(a, l, u, lds); else gmlp_unit(a, l, u - natt, lds); }
                if (!last && rep == 0) { wconv_loop(a, l + 1, w, nw, lds); for (int t = w; t < 192; t += nw) lwconv_task(a, l + 1, t); } } } } break;
    case 3: if constexpr (MASK & 32) rwkv_out(a, l, mpost); break;
    case 4: if constexpr (MASK & 64) {
              { pg8::Gemm g{HB, (const bf16_t*)(a.ws + wbase(l) + WO_OUT), ML, DM, DM, DM}; pg8::StaticOrder S; S.init(ML, DM, G, bid);
                EpiBf16Out E{YD}; pg8::gemm_phase<EpiBf16Out, pg8::StaticOrder, true, true>((PG8_LAS unsigned char*)lds, g, S, E); }
              if (!last) { const int piece = bid, sl = piece >> 4; PieceOrder S{piece & 15, piece < 64};
                pg8::Gemm g{HB + (size_t)ML * DM + (sl & 3) * 256, (const bf16_t*)(a.ws + wbase(l) + WO_OUT) + (sl & 3) * 256, MC, DM, 256, DM};
                EpiF32 E{YP + (size_t)(sl & 3) * MC * DM}; pg8::gemm_phase<EpiF32, PieceOrder, true, true>((PG8_LAS unsigned char*)lds, g, S, E); } } break;
    case 5: if constexpr (MASK & 2) row_pass(a, mpost, YD, YP, 4, xl, xc, l != 0, xmid, XC, true, ng + 1 * DM, l, 2, true, ng + 2 * DM, l, 3, 4); break;
    case 6: if constexpr (MASK & 128) { pg8::Gemm g{HB, (const bf16_t*)(a.ws + wbase(l) + WO_GU), mpost, 2 * DFF, DM, DM}; pg8::StaticOrder S; S.init(mpost, 2 * DFF, G, bid);
              EpiSwiglu E{(bf16_t*)(a.ws + WS_ACT)}; pg8::gemm_phase<EpiSwiglu, pg8::StaticOrder, true, true>((PG8_LAS unsigned char*)lds, g, S, E); } break;
    case 7: if constexpr (MASK & 512) {
              { pg8::Gemm g{(const bf16_t*)(a.ws + WS_ACT), (const bf16_t*)(a.ws + wbase(l) + WO_DN), ML, DM, DFF, DFF}; pg8::StaticOrder S; S.init(ML, DM, G, bid);
                EpiBf16Out E{YD}; pg8::gemm_phase<EpiBf16Out, pg8::StaticOrder, true, true>((PG8_LAS unsigned char*)lds, g, S, E); }
              if (!last) { const int piece = bid; int sl = piece >> 4; if (sl > 6) sl = 6; PieceOrder S{piece & 15, piece < 112};
                pg8::Gemm g{(const bf16_t*)(a.ws + WS_ACT) + (size_t)ML * DFF + sl * 384, (const bf16_t*)(a.ws + wbase(l) + WO_DN) + sl * 384, MC, DM, sl == 6 ? 512 : 384, DFF};
                EpiF32 E{YP + (size_t)sl * MC * DM}; pg8::gemm_phase<EpiF32, PieceOrder, true, true>((PG8_LAS unsigned char*)lds, g, S, E); } } break;
    case 8: if constexpr (MASK & 256) {
              row_pass(a, mpost, YD, YP, 7, xmid, XC, true, a.out, XC, !last, ng + 3 * DM, l, 5, !last, a.in[I_NORMG] + (last ? 0 : (l + 1) * 4 * DM), last ? 0 : l + 1, 0, 1); } break;
    }
}

template <int MASK> __global__ void __launch_bounds__(NTHR) trunk_fwd(Args args) {
    extern __shared__ __attribute__((aligned(16))) unsigned char lds[];
    cg::grid_group grid = cg::this_grid();
    if (args.ph_lo > args.ph_hi) grid.sync();
    if (threadIdx.x < 4) ((LAS unsigned*)((LAS unsigned char*)lds + LDS_BARST_OFF))[threadIdx.x] = 0u;
    __syncthreads();
    XcdBarrier bar = xcd_barrier_post((unsigned*)(args.ws + WS_CTL), (volatile LAS unsigned*)((LAS unsigned char*)lds + LDS_BARST_OFF));
#define GRID_SYNC() xcd_barrier(bar)
    for (int ph = args.ph_lo; ph < args.ph_hi; ++ph) {
        const int nrep = (ph == PROBE_PH) ? 2 : (PROBE_DUP && ph >= 2) ? 1 + ((PROBE_DUP >> ((ph - 2) % 9)) & 1) : 1;
        for (int rep = 0; rep < nrep; ++rep) {
            run_phase<MASK>(args, ph, lds);
            if (ph + 1 < args.ph_hi || rep + 1 < nrep) GRID_SYNC();
            for (int es = 0; es < PROBE_SYNC; ++es) GRID_SYNC();
        }
    }
}
__host__ inline int phase_mask(int ph) { if (ph == 0) return 1; if (ph == 1) return 2; const int s = (ph - 2) % 9; const int m[9] = {4, 8, 16, 32, 64, 2, 128, 512, 256}; return m[s]; }
__host__ inline const void* kernel_for(int mask) {
#if MK_PER_PHASE
    switch (mask) { case 1: return (const void*)trunk_fwd<1>; case 2: return (const void*)trunk_fwd<2>; case 4: return (const void*)trunk_fwd<4>; case 8: return (const void*)trunk_fwd<8>; case 16: return (const void*)trunk_fwd<16>;
        case 32: return (const void*)trunk_fwd<32>; case 64: return (const void*)trunk_fwd<64>; case 128: return (const void*)trunk_fwd<128>; case 256: return (const void*)trunk_fwd<256>; case 512: return (const void*)trunk_fwd<512>;
        default: return nullptr; }
#else
    (void)mask; return (const void*)trunk_fwd<1023>;
#endif
}

extern "C" void kernel_launch(void* const* d_in, const int* in_sizes, int n_in, void* d_out, int out_size, void* d_ws, size_t ws_size, hipStream_t stream) {
    static int grid = 0;
    if (grid == 0) {
        if (n_in != N_IN || out_size != ML * DM || ws_size < WS_END2) { fprintf(stderr, "kernel_launch: unexpected shapes: n_in %d out %d ws %zu (need %zu)\n", n_in, out_size, ws_size, (size_t)WS_END2); grid = -1; return; }
        int dev = 0, cus = 0, per_cu = 0;
        (void)hipGetDevice(&dev); (void)hipDeviceGetAttribute(&cus, hipDeviceAttributeMultiprocessorCount, dev);
#if MK_PER_PHASE
        for (int mk = 1; mk <= 512; mk <<= 1) {
#else
        for (int mk = 1023; mk <= 1023; ++mk) {
#endif
            if (hipFuncSetAttribute(kernel_for(mk), hipFuncAttributeMaxDynamicSharedMemorySize, LDS_BYTES) != hipSuccess) { fprintf(stderr, "kernel_launch: hipFuncSetAttribute failed\n"); grid = -1; return; }
            if (hipOccupancyMaxActiveBlocksPerMultiprocessor(&per_cu, kernel_for(mk), NTHR, LDS_BYTES) != hipSuccess || per_cu < 1) { fprintf(stderr, "kernel_launch: occupancy query says %d blocks per CU\n", per_cu); grid = -1; return; }
        }
        grid = cus;
        if (grid != 256) fprintf(stderr, "kernel_launch: note: %d CUs (the phase split assumes 256)\n", grid);
    }
    if (grid < 0) return;
    if (hipMemsetAsync((char*)d_ws + WS_CTL, 0, CTL_BYTES, stream) != hipSuccess) { fprintf(stderr, "kernel_launch: memset of the barrier words failed\n"); return; }
    Args a{};
    for (int i = 0; i < N_IN; ++i) a.in[i] = (const float*)d_in[i];
    a.out = (float*)d_out; a.ws = (unsigned char*)d_ws;
#if MK_PER_PHASE
    for (int ph = 0; ph < N_PHASES; ++ph) { a.ph_lo = ph; a.ph_hi = ph + 1; void* kargs[] = {&a};
        hipError_t e = hipLaunchCooperativeKernel(kernel_for(phase_mask(ph)), dim3(grid), dim3(NTHR), kargs, LDS_BYTES, stream);
        if (e != hipSuccess) { fprintf(stderr, "kernel_launch: launch of phase %d failed: %s\n", ph, hipGetErrorString(e)); break; } }
#else
    a.ph_lo = 0; a.ph_hi = N_PHASES; void* kargs[] = {&a};
    hipError_t e = hipLaunchCooperativeKernel(kernel_for(1023), dim3(grid), dim3(NTHR), kargs, LDS_BYTES, stream);
    if (e != hipSuccess) fprintf(stderr, "kernel_launch: cooperative launch failed: %s (grid %d)\n", hipGetErrorString(e), grid);
#endif
}
```

```cpp
#include <hip/hip_runtime.h>
#include <hip/hip_cooperative_groups.h>
#include <cstdio>
#include <cstdint>
namespace cg = cooperative_groups;
__device__ __forceinline__ int opaque_tid() { int t = threadIdx.x; asm volatile("" : "+v"(t)); return t; }
namespace pg8 {
#define PG8_LAS __attribute__((address_space(3)))
typedef unsigned short bf16_t;
typedef short bf16x8 __attribute__((ext_vector_type(8)));
typedef float f32x4 __attribute__((ext_vector_type(4)));
typedef unsigned u32x4 __attribute__((ext_vector_type(4)));
constexpr int BM = 256, BK = 64, HALF = 128, HTB = HALF * BK * 2  , STAGE_BYTES = 8 * HTB, NXCD = 8, WGM = 8;

__host__ __device__ __forceinline__ int lds_byte(int r, int c) { const int st = (r >> 4) * 2 + (c >> 5), rr = r & 15, cc = c & 31, ob = rr * 64 + cc * 2; return st * 1024 + (ob ^ (((ob >> 9) & 1) << 5)); }
__host__ __device__ __forceinline__ void stage_rc(int b, int& R, int& C) { const int st = b / 1024, sb = b % 1024, swz = sb ^ (((sb >> 9) & 1) << 5); R = (st >> 1) * 16 + swz / 64; C = (st & 1) * 32 + (swz % 64) / 2; }
__host__ __device__ __forceinline__ int perm32(int rho) { const int n = rho >> 4, i = rho & 15; return 8 * (i >> 2) + 4 * n + (i & 3); }

struct Unit { int pm, pn; };
struct Gemm { const bf16_t* A; const bf16_t* Bt; int M, N, K, ld; };

struct StaticOrder {
    int nM, nN, nwg, G, c;
    __host__ __device__ void init(int M, int N, int G_, int c_) { nM = M / BM; nN = N / BM; nwg = nM * nN; G = G_; c = c_; }
    __host__ __device__ bool next(int i, Unit& u) const {
        const long L = (long)i * G + c; if (L >= nwg) return false;
        int wgid = (int)L; { const int q = nwg / NXCD, r = nwg % NXCD, xcd = wgid % NXCD, off = wgid / NXCD; wgid = (xcd < r ? xcd * (q + 1) : r * (q + 1) + (xcd - r) * q) + off; }
        const int nig = WGM * nN, gid = wgid / nig, fm = gid * WGM, gsz = (nM - fm) < WGM ? (nM - fm) : WGM;
        u.pm = fm + ((wgid % nig) % gsz); u.pn = (wgid % nig) / gsz; return true;
    }
    __device__ __forceinline__ void a_ready(const Unit&) const {}
    __device__ __forceinline__ void done(const Unit&) const {}
};
__device__ __forceinline__ unsigned cvt_pk_bf16(float lo, float hi) { unsigned r; asm volatile("v_cvt_pk_bf16_f32 %0, %1, %2" : "=v"(r) : "v"(lo), "v"(hi)); return r; }
template <class Epi, class Sched, bool ALIGN_EPI = false, bool SP2 = false>
__device__ __forceinline__ void gemm_phase(PG8_LAS unsigned char* lds, const Gemm g, const Sched& S, const Epi& E) {
    const int tid = opaque_tid(), wid = __builtin_amdgcn_readfirstlane(tid >> 6), lane = tid & 63, wr = wid >> 2, wc = wid & 3, fr = lane & 15, fq = lane >> 4;
    const int K = g.ld, nt = g.K / BK;
    unsigned voffA[2], voffB[2];
#pragma unroll
    for (int i = 0; i < 2; ++i) { int R, C; stage_rc(tid * 16 + i * 8192, R, C); const int Rb = Epi::PERM ? ((R & ~31) + perm32(R & 31)) : R;
        voffA[i] = (unsigned)(R * K + C) * 2u; voffB[i] = (unsigned)(Rb * K + C) * 2u; }
    const size_t kstep = (size_t)(BK * 2);
    const size_t hstep = (size_t)HALF * K * 2;
    const size_t tstep = 2 * hstep;
    const unsigned ldsw = (unsigned)wid * 1024u;
    const int aoff = lds_byte(wr * 64 + fr, fq * 8), boff = lds_byte(wc * 32 + fr, fq * 8);
#define PG8_SA(b, h) (((b) * 2 + (h)) * HTB)
#define PG8_SB(b, h) ((4 + (b) * 2 + (h)) * HTB)
#define PG8_STAGE(bufoff, gbase, voff) do { _Pragma("unroll") for (int _i = 0; _i < 2; ++_i) \
        __builtin_amdgcn_global_load_lds((const unsigned*)((const char*)(gbase) + (voff)[_i]), (PG8_LAS unsigned*)(lds + (bufoff) + ldsw + _i * 8192), 16, 0, 0); } while (0)
#define PG8_LDA(dst, b, h) do { _Pragma("unroll") for (int m = 0; m < 4; ++m) _Pragma("unroll") for (int k = 0; k < 2; ++k) dst[m][k] = *(const PG8_LAS bf16x8*)(lds + PG8_SA(b, h) + aoff + m * 2048 + k * 1024); } while (0)
#define PG8_LDB(dst, b, h) do { _Pragma("unroll") for (int n = 0; n < 2; ++n) _Pragma("unroll") for (int k = 0; k < 2; ++k) dst[n][k] = *(const PG8_LAS bf16x8*)(lds + PG8_SB(b, h) + boff + n * 2048 + k * 1024); } while (0)
#define PG8_MMA(ai, bj, At, Bt) do { __builtin_amdgcn_s_setprio(1); _Pragma("unroll") for (int m = 0; m < 4; ++m) _Pragma("unroll") for (int n = 0; n < 2; ++n) _Pragma("unroll") for (int k = 0; k < 2; ++k) \
        acc[ai][bj][m][n] = __builtin_amdgcn_mfma_f32_16x16x32_bf16(Bt[n][k], At[m][k], acc[ai][bj][m][n], 0, 0, 0); __builtin_amdgcn_s_setprio(0); } while (0)
#define PG8_WAIT_V(n) asm volatile("s_waitcnt vmcnt(" #n ")" ::: "memory")
#define PG8_WAIT_L(n) asm volatile("s_waitcnt lgkmcnt(" #n ")" ::: "memory")
#define PG8_BAR __builtin_amdgcn_s_barrier()
#define PG8_SCHED __builtin_amdgcn_sched_barrier(0)
    Unit cur, nxt; int ui = 0;
    if (!S.next(0, cur)) return;
    f32x4 acc[2][2][4][2];
#pragma unroll
    for (int a = 0; a < 2; ++a)
#pragma unroll
        for (int b = 0; b < 2; ++b)
#pragma unroll
            for (int m = 0; m < 4; ++m)
#pragma unroll
                for (int n = 0; n < 2; ++n) acc[a][b][m][n] = (f32x4){0.f, 0.f, 0.f, 0.f};
    bf16x8 At[4][2], B0[2][2], B1[2][2];
    const char* cA = (const char*)g.A + (size_t)cur.pm * tstep; const char* cB = (const char*)g.Bt + (size_t)cur.pn * tstep;
    S.a_ready(cur);
    if constexpr (SP2) {
        PG8_STAGE(PG8_SB(0, 0), cB, voffB); PG8_STAGE(PG8_SB(0, 1), cB + hstep, voffB); PG8_STAGE(PG8_SA(0, 0), cA, voffA); PG8_STAGE(PG8_SA(0, 1), cA + hstep, voffA);
        if (wr == 1) PG8_BAR;
        PG8_WAIT_V(2); PG8_BAR;
        PG8_STAGE(PG8_SB(1, 0), cB + kstep, voffB); PG8_STAGE(PG8_SA(1, 0), cA + kstep, voffA); PG8_STAGE(PG8_SB(1, 1), cB + hstep + kstep, voffB);
        PG8_WAIT_V(6); PG8_BAR;
    } else {
        PG8_STAGE(PG8_SB(0, 0), cB, voffB); PG8_STAGE(PG8_SA(0, 0), cA, voffA); PG8_STAGE(PG8_SB(0, 1), cB + hstep, voffB); PG8_STAGE(PG8_SA(0, 1), cA + hstep, voffA);
        if (wr == 1) PG8_BAR;
        PG8_WAIT_V(4); PG8_BAR;
        PG8_STAGE(PG8_SB(1, 0), cB + kstep, voffB); PG8_STAGE(PG8_SA(1, 0), cA + kstep, voffA); PG8_STAGE(PG8_SB(1, 1), cB + hstep + kstep, voffB);
        PG8_WAIT_V(6); PG8_BAR;
    }
    for (;;) {
        const bool has_next = S.next(ui + 1, nxt);
        const char* nA = has_next ? (const char*)g.A + (size_t)nxt.pm * tstep : cA; const char* nB = has_next ? (const char*)g.Bt + (size_t)nxt.pn * tstep : cB;
        for (int t = 0; t < nt; t += 2) {
            const bool last = (t == nt - 2);
            const char* a1 = cA + (size_t)(t + 1) * kstep;
            const char* a2 = last ? nA : cA + (size_t)(t + 2) * kstep; const char* b2 = last ? nB : cB + (size_t)(t + 2) * kstep;
            const char* a3 = a2 + kstep; const char* b3 = b2 + kstep;
            if (last && has_next) S.a_ready(nxt);
            if constexpr (SP2) {
            PG8_LDB(B0, 0, 0); PG8_LDB(B1, 0, 1); PG8_SCHED; PG8_LDA(At, 0, 0); PG8_STAGE(PG8_SA(1, 1), a1 + hstep, voffA);
            PG8_WAIT_V(8); PG8_WAIT_L(0); PG8_BAR; PG8_MMA(0, 0, At, B0); PG8_MMA(0, 1, At, B1); PG8_BAR; PG8_SCHED;
            PG8_LDA(At, 0, 1); PG8_STAGE(PG8_SB(0, 0), b2, voffB); PG8_STAGE(PG8_SB(0, 1), b2 + hstep, voffB); PG8_STAGE(PG8_SA(0, 0), a2, voffA);
            PG8_WAIT_V(8); PG8_WAIT_L(0); PG8_BAR; PG8_MMA(1, 0, At, B0); PG8_MMA(1, 1, At, B1); PG8_BAR; PG8_SCHED;
            PG8_LDB(B0, 1, 0); PG8_LDB(B1, 1, 1); PG8_SCHED; PG8_LDA(At, 1, 0); PG8_STAGE(PG8_SA(0, 1), a2 + hstep, voffA);
            PG8_WAIT_V(8); PG8_WAIT_L(0); PG8_BAR; PG8_MMA(0, 0, At, B0); PG8_MMA(0, 1, At, B1); PG8_BAR; PG8_SCHED;
            PG8_LDA(At, 1, 1); PG8_STAGE(PG8_SB(1, 0), b3, voffB); PG8_STAGE(PG8_SB(1, 1), b3 + hstep, voffB); PG8_STAGE(PG8_SA(1, 0), a3, voffA);
            PG8_WAIT_V(8); PG8_WAIT_L(0); PG8_BAR; PG8_MMA(1, 0, At, B0); PG8_MMA(1, 1, At, B1); PG8_BAR; PG8_SCHED;
            } else {
            PG8_LDB(B0, 0, 0); PG8_SCHED; PG8_LDA(At, 0, 0); PG8_STAGE(PG8_SA(1, 1), a1 + hstep, voffA);
            PG8_WAIT_L(8); PG8_BAR; PG8_WAIT_L(0); PG8_MMA(0, 0, At, B0); PG8_BAR; PG8_SCHED;
            PG8_LDB(B1, 0, 1); PG8_STAGE(PG8_SB(0, 0), b2, voffB);
            PG8_BAR; PG8_WAIT_L(0); PG8_MMA(0, 1, At, B1); PG8_BAR;
            PG8_LDA(At, 0, 1); PG8_STAGE(PG8_SA(0, 0), a2, voffA);
            PG8_BAR; PG8_WAIT_L(0); PG8_MMA(1, 0, At, B0); PG8_BAR; PG8_SCHED;
            PG8_STAGE(PG8_SB(0, 1), b2 + hstep, voffB);
            PG8_WAIT_V(6); PG8_BAR; PG8_MMA(1, 1, At, B1); PG8_BAR;
            PG8_LDB(B0, 1, 0); PG8_SCHED; PG8_LDA(At, 1, 0); PG8_STAGE(PG8_SA(0, 1), a2 + hstep, voffA);
            PG8_WAIT_L(8); PG8_BAR; PG8_WAIT_L(0); PG8_MMA(0, 0, At, B0); PG8_BAR; PG8_SCHED;
            PG8_LDB(B1, 1, 1); PG8_STAGE(PG8_SB(1, 0), b3, voffB);
            PG8_BAR; PG8_WAIT_L(0); PG8_MMA(0, 1, At, B1); PG8_BAR;
            PG8_LDA(At, 1, 1); PG8_STAGE(PG8_SA(1, 0), a3, voffA);
            PG8_BAR; PG8_WAIT_L(0); PG8_MMA(1, 0, At, B0); PG8_BAR; PG8_SCHED;
            PG8_STAGE(PG8_SB(1, 1), b3 + hstep, voffB);
            PG8_WAIT_V(6); PG8_BAR; PG8_MMA(1, 1, At, B1); PG8_BAR;
            }
        }
        if constexpr (ALIGN_EPI) { if (wr == 0) PG8_BAR; }
        if constexpr (!Epi::AFTER_DRAIN) { E(acc, cur, wr, wc, fr, fq); S.done(cur); }
        if (!has_next) break;
#pragma unroll
        for (int a = 0; a < 2; ++a)
#pragma unroll
            for (int b = 0; b < 2; ++b)
#pragma unroll
                for (int m = 0; m < 4; ++m)
#pragma unroll
                    for (int n = 0; n < 2; ++n) acc[a][b][m][n] = (f32x4){0.f, 0.f, 0.f, 0.f};
        cur = nxt; cA = nA; cB = nB; ++ui;
        if constexpr (ALIGN_EPI) { if (wr == 1) PG8_BAR; }
    }
    PG8_WAIT_V(0);
    if constexpr (!ALIGN_EPI) { if (wr == 0) PG8_BAR; }
    PG8_BAR;
    if constexpr (Epi::AFTER_DRAIN) { E.fused(acc, cur, wr, wc, fr, fq, lds, wid, lane); S.done(cur); }
#undef PG8_SA
#undef PG8_SB
#undef PG8_STAGE
#undef PG8_LDA
#undef PG8_LDB
#undef PG8_MMA
#undef PG8_WAIT_V
#undef PG8_WAIT_L
#undef PG8_BAR
#undef PG8_SCHED
}
}

#ifndef PROBE_DUP
#define PROBE_DUP 0
#endif
#ifndef PROBE_PH
#define PROBE_PH -1
#endif
#ifndef PROBE_SYNC
#define PROBE_SYNC 0
#endif
#ifndef PROBE_SCANC
#define PROBE_SCANC 0
#endif
#ifndef PROBE_SCAN
#define PROBE_SCAN 0
#endif
#ifndef PROBE_ATT
#define PROBE_ATT 0
#endif
#ifndef MK_PER_PHASE
#define MK_PER_PHASE 0
#endif
using pg8::bf16_t; using pg8::bf16x8; using pg8::f32x4; using pg8::u32x4;
typedef __bf16 bf16x2v __attribute__((ext_vector_type(2)));
typedef float f32x2c __attribute__((ext_vector_type(2)));
__device__ __forceinline__ unsigned cvt_pk_bf16(float lo, float hi) { const f32x2c v = {lo, hi}; return __builtin_bit_cast(unsigned, __builtin_convertvector(v, bf16x2v)); }
typedef unsigned u32x2 __attribute__((ext_vector_type(2)));
typedef short bf16x4 __attribute__((ext_vector_type(4)));

constexpr int DM = 1024, NB = 4, TL = 4096, CL = 256, NL = 4;
constexpr int ML = NB * TL, MC = NB * CL, MT = ML + MC;
constexpr int NIN = 2560, NPXA = 1280, NPXR = 1152, DFF = 2816, INC = 2432;
constexpr int NTHR = 512;
constexpr int LDS_BYTES = 147456;
constexpr size_t MiB = 1u << 20;
constexpr size_t WS_MODV = 0, WS_ROPE = 1 * MiB, WS_XC = 2 * MiB, WS_WIN = 6 * MiB, WS_WOUT = 11 * MiB, WS_WGU = 13 * MiB, WS_WDN = 24 * MiB;
constexpr size_t WS_HBUF = 30 * MiB, WS_PXA = 64 * MiB, WS_PXR = 107 * MiB, WS_PREP = 184 * MiB, WS_END = 354 * MiB;
constexpr size_t WS_WB1 = 146 * MiB;
constexpr size_t WS_LW = 512 * 1024, WS_LW1 = 832 * 1024;
__device__ __forceinline__ size_t wbase(int l) { return (l & 1) ? WS_WB1 : WS_WIN; }
__device__ __forceinline__ size_t lwbase(int l) { return (l & 1) ? WS_LW1 : WS_LW; }
constexpr size_t WO_OUT = 5 * MiB, WO_GU = 7 * MiB, WO_DN = 18 * MiB;
constexpr size_t WS_YS = 312 * MiB;
constexpr size_t WS_ACT = WS_PREP, WS_YD = 278 * MiB, WS_YP = 346 * MiB, WS_END2 = 374 * MiB;
constexpr size_t PREP_W = 0, PREP_KA = (size_t)MT * 512 * 4, PREP_KD = 2 * PREP_KA, PREP_KK = PREP_KD + (size_t)MT * 512 * 2, PREP_R = PREP_KK + (size_t)MT * 256 * 4,
                 PREP_V = PREP_R + (size_t)MT * 256 * 2, PREP_G = PREP_V + (size_t)MT * 256 * 2;
static_assert(WS_HBUF + (size_t)MT * 1024 * 2 <= WS_PXA && WS_PXA + (size_t)MT * NPXA * 2 <= WS_PXR && WS_PXR + (size_t)MT * NPXR * 4 <= WS_PREP, "ws map 1");
static_assert(WS_PREP + PREP_G + (size_t)MT * 256 * 2 <= WS_YS && WS_YS + (size_t)MT * 512 * 4 <= WS_YP && WS_ACT + (size_t)MT * DFF * 2 <= WS_YD && WS_YD + (size_t)MT * 1024 * 4 <= WS_END, "ws map 2");

enum { I_X = 0, I_C, I_CTX, I_CCTX, I_WMOD, I_BMOD, I_NORMG, I_WIN, I_WOUT, I_SGLNG, I_SGLNB, I_SGW, I_SGB, I_SINK, I_MU, I_W0, I_W2, I_A0, I_A2, I_KK, I_KA, I_RK, I_G2, I_LNXG, I_LNXB, I_WGU, I_WDN, N_IN };
struct Args { const float* in[N_IN]; float* out; unsigned char* ws; int ph_lo, ph_hi; };

__device__ __forceinline__ float bf2f(unsigned short h) { return __builtin_bit_cast(float, (unsigned)h << 16); }
__device__ __forceinline__ unsigned cvt_pk_bf16(float lo, float hi);
__device__ __forceinline__ unsigned short f2bf(float f) { return (unsigned short)(cvt_pk_bf16(f, 0.f) & 0xffffu); }
__device__ __forceinline__ f32x4 bf4_to_f32(u32x2 r) { f32x4 o; o[0] = __builtin_bit_cast(float, r.x << 16); o[1] = __builtin_bit_cast(float, r.x & 0xffff0000u); o[2] = __builtin_bit_cast(float, r.y << 16); o[3] = __builtin_bit_cast(float, r.y & 0xffff0000u); return o; }
__device__ __forceinline__ u32x2 f32_to_bf4(f32x4 v) { u32x2 w; w.x = cvt_pk_bf16(v[0], v[1]); w.y = cvt_pk_bf16(v[2], v[3]); return w; }
template <int CTRL> __device__ __forceinline__ float dppf(float x) { return __builtin_bit_cast(float, __builtin_amdgcn_mov_dpp(__builtin_bit_cast(int, x), CTRL, 0xf, 0xf, true)); }
__device__ __forceinline__ float row16_sum(float x) { x += dppf<0xB1>(x); x += dppf<0x4E>(x); x += dppf<0x141>(x); x += dppf<0x128>(x); return x; }
__device__ __forceinline__ float wave_sum(float v) {
    v = row16_sum(v);
    const float r0 = __builtin_bit_cast(float, __builtin_amdgcn_readlane(__builtin_bit_cast(int, v), 0)), r1 = __builtin_bit_cast(float, __builtin_amdgcn_readlane(__builtin_bit_cast(int, v), 16)),
                r2 = __builtin_bit_cast(float, __builtin_amdgcn_readlane(__builtin_bit_cast(int, v), 32)), r3 = __builtin_bit_cast(float, __builtin_amdgcn_readlane(__builtin_bit_cast(int, v), 48));
    return (r0 + r1) + (r2 + r3);
}
__device__ __forceinline__ float gelu_tanh(float x) { const float u = 0.7978845608028654f * (x + 0.044715f * x * x * x); const float t = 1.f - 2.f * __builtin_amdgcn_rcpf(1.f + __expf(2.f * u)); return 0.5f * x * (1.f + t); }
__device__ __forceinline__ float sigmoidf_(float x) { return 1.f / (1.f + __expf(-x)); }

struct EpiIn {
    static constexpr bool PERM = true, AFTER_DRAIN = false;
    bf16_t* pxa; bf16_t* pxr;
    __device__ __forceinline__ void operator()(const f32x4 (&acc)[2][2][4][2], const pg8::Unit& u, int wr, int wc, int fr, int fq) const {
        const int row0 = u.pm * 256 + wr * 64 + fr, colt = u.pn * 256 + wc * 32 + 8 * fq;
#pragma unroll
        for (int ai = 0; ai < 2; ++ai)
#pragma unroll
            for (int m = 0; m < 4; ++m) { const size_t row = (size_t)(row0 + ai * 128 + m * 16);
#pragma unroll
                for (int bj = 0; bj < 2; ++bj) { const int col = colt + bj * 128; const f32x4 v0 = acc[ai][bj][m][0], v1 = acc[ai][bj][m][1];
                    u32x4 w; w.x = cvt_pk_bf16(v0[0], v0[1]); w.y = cvt_pk_bf16(v0[2], v0[3]); w.z = cvt_pk_bf16(v1[0], v1[1]); w.w = cvt_pk_bf16(v1[2], v1[3]);
                    if (u.pn < 5) *(u32x4*)(pxa + row * NPXA + col) = w;
                    else { const int cc = col - NPXA; if (cc < NPXR) *(u32x4*)(pxr + row * NPXR + cc) = w; } } }
    }
};
struct EpiF32 {
    static constexpr bool PERM = true, AFTER_DRAIN = false;
    float* O; static constexpr int ldc = DM;
    __device__ __forceinline__ void operator()(const f32x4 (&acc)[2][2][4][2], const pg8::Unit& u, int wr, int wc, int fr, int fq) const {
        const int row0 = u.pm * 256 + wr * 64 + fr, colt = u.pn * 256 + wc * 32 + 8 * fq;
#pragma unroll
        for (int ai = 0; ai < 2; ++ai)
#pragma unroll
            for (int m = 0; m < 4; ++m) { float* rp = O + (size_t)(row0 + ai * 128 + m * 16) * ldc + colt;
#pragma unroll
                for (int bj = 0; bj < 2; ++bj) { *(f32x4*)(rp + bj * 128) = acc[ai][bj][m][0]; *(f32x4*)(rp + bj * 128 + 4) = acc[ai][bj][m][1]; } }
    }
};
struct EpiBf16Out {
    static constexpr bool PERM = true, AFTER_DRAIN = false;
    bf16_t* O;
    __device__ __forceinline__ void operator()(const f32x4 (&acc)[2][2][4][2], const pg8::Unit& u, int wr, int wc, int fr, int fq) const {
        const int row0 = u.pm * 256 + wr * 64 + fr, colt = u.pn * 256 + wc * 32 + 8 * fq;
#pragma unroll
        for (int ai = 0; ai < 2; ++ai)
#pragma unroll
            for (int m = 0; m < 4; ++m) { bf16_t* rp = O + (size_t)(row0 + ai * 128 + m * 16) * DM + colt;
#pragma unroll
                for (int bj = 0; bj < 2; ++bj) { const f32x4 v0 = acc[ai][bj][m][0], v1 = acc[ai][bj][m][1];
                    u32x4 w; w.x = cvt_pk_bf16(v0[0], v0[1]); w.y = cvt_pk_bf16(v0[2], v0[3]); w.z = cvt_pk_bf16(v1[0], v1[1]); w.w = cvt_pk_bf16(v1[2], v1[3]);
                    *(u32x4*)(rp + bj * 128) = w; } }
    }
};
struct EpiSwiglu {
    static constexpr bool PERM = true, AFTER_DRAIN = false;
    bf16_t* O;
    __device__ __forceinline__ void operator()(const f32x4 (&acc)[2][2][4][2], const pg8::Unit& u, int wr, int wc, int fr, int fq) const {
        const int row0 = u.pm * 256 + wr * 64 + fr, col = u.pn * 128 + wc * 32 + 8 * fq;
#pragma unroll
        for (int ai = 0; ai < 2; ++ai)
#pragma unroll
            for (int m = 0; m < 4; ++m) { float r[8];
#pragma unroll
                for (int n = 0; n < 2; ++n)
#pragma unroll
                    for (int j = 0; j < 4; ++j) { const float g = acc[ai][0][m][n][j], up = acc[ai][1][m][n][j]; r[n * 4 + j] = g * __builtin_amdgcn_rcpf(1.f + __expf(-g)) * up; }
                u32x4 w; w.x = cvt_pk_bf16(r[0], r[1]); w.y = cvt_pk_bf16(r[2], r[3]); w.z = cvt_pk_bf16(r[4], r[5]); w.w = cvt_pk_bf16(r[6], r[7]);
                *(u32x4*)(O + (size_t)(row0 + ai * 128 + m * 16) * DFF + col) = w; }
    }
};

__device__ __forceinline__ void modv_task(const Args& a, int task, unsigned char* lds) {
    float* act = (float*)lds; float* red = act + 5 * 1024;
    const int tid = opaque_tid();
    for (int i = tid; i < 5 * 1024; i += NTHR) { const int r = i >> 10, k = i & 1023; const float v = r < 4 ? a.in[I_C][r * 1024 + k] : a.in[I_CCTX][k]; act[i] = v / (1.f + expf(-v)); }
    __syncthreads();
    const int l = task / 48, cb = task % 48, cl = tid & 127, kq = tid >> 7;
    const float* W = a.in[I_WMOD] + (size_t)l * 1024 * 6144 + cb * 128 + cl;
    float a0 = 0.f, a1 = 0.f, a2 = 0.f, a3 = 0.f, a4 = 0.f;
    for (int k0 = kq * 256; k0 < kq * 256 + 256; k0 += 16) { float wv[16];
#pragma unroll
        for (int u = 0; u < 16; ++u) wv[u] = W[(size_t)(k0 + u) * 6144];
#pragma unroll
        for (int u = 0; u < 16; ++u) { const int k = k0 + u; const float w = wv[u]; a0 += act[k] * w; a1 += act[1024 + k] * w; a2 += act[2048 + k] * w; a3 += act[3072 + k] * w; a4 += act[4096 + k] * w; } }
    red[(kq * 5 + 0) * 128 + cl] = a0; red[(kq * 5 + 1) * 128 + cl] = a1; red[(kq * 5 + 2) * 128 + cl] = a2; red[(kq * 5 + 3) * 128 + cl] = a3; red[(kq * 5 + 4) * 128 + cl] = a4;
    __syncthreads();
    float* modv = (float*)(a.ws + WS_MODV);
    for (int i = tid; i < 640; i += NTHR) { const int r = i >> 7, c2 = i & 127;
        const float s = red[(0 * 5 + r) * 128 + c2] + red[(1 * 5 + r) * 128 + c2] + red[(2 * 5 + r) * 128 + c2] + red[(3 * 5 + r) * 128 + c2];
        modv[(size_t)(l * 5 + r) * 6144 + cb * 128 + c2] = s + a.in[I_BMOD][l * 6144 + cb * 128 + c2]; }
    __syncthreads();
}
__device__ __forceinline__ void rope_task(const Args& a, int task) {
    const int idx = task * NTHR + opaque_tid(); const int t = idx >> 5, j = idx & 31, axis = j >> 4, f = j & 15;
    const float pos = (float)(axis == 0 ? (t >> 6) : (t & 63));
    const float inv = powf(10000.0f, -(float)f / 16.0f);
    const float ang = pos * inv;
    float* rc = (float*)(a.ws + WS_ROPE); float* rs = rc + TL * 32;
    rc[idx] = cosf(ang); rs[idx] = sinf(ang);
}
constexpr int WCONV_TASKS = 640 + 256 + 1408 + 704;
struct WconvDesc { const float* src; bf16_t* dst; int Ksz, Nsrc, kt, n0, sc0; bool zero; };
__device__ __forceinline__ WconvDesc wconv_decode(const Args& a, int l, int task) {
    WconvDesc D; D.zero = false;
    if (task < 640) { const int nt = task >> 4; D.kt = task & 15; D.Ksz = 1024; D.Nsrc = INC; D.src = a.in[I_WIN] + (size_t)l * 1024 * INC; D.dst = (bf16_t*)(a.ws + wbase(l)); D.n0 = nt * 64; const int n0 = D.n0;
        if (n0 < 1024) D.sc0 = n0; else if (n0 < 1280) D.sc0 = 1408 + (n0 - 1024); else if (n0 < 1664) D.sc0 = 1024 + (n0 - 1280); else if (n0 < 2432) D.sc0 = n0; else { D.sc0 = 0; D.zero = true; } }
    else if (task < 896) { const int t = task - 640; const int nt = t >> 4; D.kt = t & 15; D.Ksz = 1024; D.Nsrc = 1024; D.src = a.in[I_WOUT] + (size_t)l * 1024 * 1024; D.dst = (bf16_t*)(a.ws + wbase(l) + WO_OUT); D.n0 = nt * 64; D.sc0 = D.n0; }
    else if (task < 2304) { const int t = task - 896; const int nt = t >> 4; D.kt = t & 15; D.Ksz = 1024; D.Nsrc = 2 * DFF; D.src = a.in[I_WGU] + (size_t)l * 1024 * 2 * DFF; D.dst = (bf16_t*)(a.ws + wbase(l) + WO_GU); D.n0 = nt * 64;
        const int tt = D.n0 >> 8, bj = (D.n0 >> 7) & 1, jj = D.n0 & 127; D.sc0 = bj * DFF + tt * 128 + jj; }
    else { const int t = task - 2304; const int nt = t / 44; D.kt = t % 44; D.Ksz = DFF; D.Nsrc = 1024; D.src = a.in[I_WDN] + (size_t)l * DFF * 1024; D.dst = (bf16_t*)(a.ws + wbase(l) + WO_DN); D.n0 = nt * 64; D.sc0 = D.n0; }
    return D;
}
__device__ __forceinline__ void wconv_issue(f32x4 (&v)[2], const WconvDesc& D, int tid) {
    const int c4 = tid & 15;
#pragma unroll
    for (int h = 0; h < 2; ++h) { const int kr = (tid >> 4) + 32 * h; v[h] = (f32x4){0.f, 0.f, 0.f, 0.f};
        if (!D.zero) v[h] = *(const f32x4*)(D.src + (size_t)(D.kt * 64 + kr) * D.Nsrc + D.sc0 + c4 * 4); }
}
__device__ __forceinline__ void wconv_loop(const Args& a, int l, int first, int stride, unsigned char* lds) {
    if (first >= WCONV_TASKS) return;
    const int tid = opaque_tid();
    float* tile = (float*)lds;
    f32x4 v[2]; WconvDesc D = wconv_decode(a, l, first); wconv_issue(v, D, tid);
    for (int task = first; task < WCONV_TASKS; task += stride) {
        { const int c4 = tid & 15;
#pragma unroll
          for (int h = 0; h < 2; ++h) { const int kr = (tid >> 4) + 32 * h;
              tile[kr * 65 + c4 * 4 + 0] = v[h][0]; tile[kr * 65 + c4 * 4 + 1] = v[h][1]; tile[kr * 65 + c4 * 4 + 2] = v[h][2]; tile[kr * 65 + c4 * 4 + 3] = v[h][3]; } }
        __syncthreads();
        const WconvDesc C = D;
        if (task + stride < WCONV_TASKS) { D = wconv_decode(a, l, task + stride); wconv_issue(v, D, tid); }
        { const int n = tid >> 3, k8 = tid & 7; float r[8];
#pragma unroll
          for (int i = 0; i < 8; ++i) r[i] = tile[(k8 * 8 + i) * 65 + n];
          u32x4 w; w.x = cvt_pk_bf16(r[0], r[1]); w.y = cvt_pk_bf16(r[2], r[3]); w.z = cvt_pk_bf16(r[4], r[5]); w.w = cvt_pk_bf16(r[6], r[7]);
          *(u32x4*)(C.dst + (size_t)(C.n0 + n) * C.Ksz + C.kt * 64 + k8 * 8) = w; }
        __syncthreads();
    }
}

struct RowRegs { f32x4 xv[4], yv[4]; };
__device__ __forceinline__ void row_load(RowRegs& R, int row, int lane, const bf16_t* y, const float* ypart, int nsl, const void* xl_src, const void* xc_src, bool xbf) {
    if (xbf) { const bf16_t* xs = row < ML ? (const bf16_t*)xl_src + (size_t)row * DM : (const bf16_t*)xc_src + (size_t)(row - ML) * DM;
#pragma unroll
        for (int j = 0; j < 4; ++j) R.xv[j] = bf4_to_f32(*(const u32x2*)(xs + j * 256 + lane * 4)); }
    else { const float* xs = row < ML ? (const float*)xl_src + (size_t)row * DM : (const float*)xc_src + (size_t)(row - ML) * DM;
#pragma unroll
        for (int j = 0; j < 4; ++j) R.xv[j] = *(const f32x4*)(xs + j * 256 + lane * 4); }
    if (y) {
        if (row < ML) {
#pragma unroll
            for (int j = 0; j < 4; ++j) R.yv[j] = bf4_to_f32(*(const u32x2*)(y + (size_t)row * DM + j * 256 + lane * 4));
        } else {
#pragma unroll
            for (int j = 0; j < 4; ++j) R.yv[j] = (f32x4){0.f, 0.f, 0.f, 0.f};
#pragma unroll
            for (int sl = 0; sl < 7; ++sl) if (sl < nsl) {
#pragma unroll
                for (int j = 0; j < 4; ++j) R.yv[j] += *(const f32x4*)(ypart + ((size_t)sl * MC + (row - ML)) * DM + j * 256 + lane * 4); }
        }
    }
}
__device__ __forceinline__ void row_process(const Args& a, RowRegs& C, int row, int lane, bool has_y, void* xl_dst, void* xc_dst, bool obf,
                         const f32x4 (&gyv)[4], int l_gate, int gate_idx, bool do_h, const f32x4 (&ghv)[4], int l_h, int shift_idx, int scale_idx, f32x4 (&gtv)[4], f32x4 (&s1v)[4], f32x4 (&s2v)[4], int& cur) {
    const float* modv = (const float*)(a.ws + WS_MODV); bf16_t* hbuf = (bf16_t*)(a.ws + WS_HBUF);
    const int mrow = row < ML ? (row >> 12) : 4;
    if (mrow != cur) { cur = mrow;
    if (has_y) { const float* gate = modv + (size_t)(l_gate * 5 + mrow) * 6144 + gate_idx * 1024;
#pragma unroll
        for (int j = 0; j < 4; ++j) gtv[j] = *(const f32x4*)(gate + j * 256 + lane * 4); }
    if (do_h) { const float* sh = modv + (size_t)(l_h * 5 + mrow) * 6144 + shift_idx * 1024; const float* sc = modv + (size_t)(l_h * 5 + mrow) * 6144 + scale_idx * 1024;
#pragma unroll
        for (int j = 0; j < 4; ++j) { s1v[j] = *(const f32x4*)(sh + j * 256 + lane * 4); s2v[j] = *(const f32x4*)(sc + j * 256 + lane * 4); } } }
    if (has_y) {
        float ss = 0.f;
#pragma unroll
        for (int j = 0; j < 4; ++j) ss += C.yv[j][0] * C.yv[j][0] + C.yv[j][1] * C.yv[j][1] + C.yv[j][2] * C.yv[j][2] + C.yv[j][3] * C.yv[j][3];
        ss = wave_sum(ss); const float rstd = rsqrtf(ss * (1.f / 1024.f) + 1e-6f);
#pragma unroll
        for (int j = 0; j < 4; ++j) C.xv[j] = C.xv[j] + gtv[j] * (C.yv[j] * rstd * gyv[j]);
        if (obf) { bf16_t* xd = row < ML ? (bf16_t*)xl_dst + (size_t)row * DM : (bf16_t*)xc_dst + (size_t)(row - ML) * DM;
#pragma unroll
            for (int j = 0; j < 4; ++j) { const u32x2 w = f32_to_bf4(C.xv[j]); *(u32x2*)(xd + j * 256 + lane * 4) = w; C.xv[j] = bf4_to_f32(w); } }
        else { float* xd = row < ML ? (float*)xl_dst + (size_t)row * DM : (float*)xc_dst + (size_t)(row - ML) * DM;
#pragma unroll
            for (int j = 0; j < 4; ++j) *(f32x4*)(xd + j * 256 + lane * 4) = C.xv[j]; }
    }
    if (do_h) {
        float ss = 0.f;
#pragma unroll
        for (int j = 0; j < 4; ++j) ss += C.xv[j][0] * C.xv[j][0] + C.xv[j][1] * C.xv[j][1] + C.xv[j][2] * C.xv[j][2] + C.xv[j][3] * C.xv[j][3];
        ss = wave_sum(ss); const float rstd = rsqrtf(ss * (1.f / 1024.f) + 1e-6f);
#pragma unroll
        for (int j = 0; j < 4; ++j) { const f32x4 h = (C.xv[j] * rstd * ghv[j]) * (1.f + s2v[j]) + s1v[j];
            u32x2 w; w.x = cvt_pk_bf16(h[0], h[1]); w.y = cvt_pk_bf16(h[2], h[3]);
            *(u32x2*)(hbuf + (size_t)row * DM + j * 256 + lane * 4) = w; }
    }
}
__device__ __forceinline__ void row_pass(const Args& a, int mrows, const bf16_t* y, const float* ypart, int nsl, const void* xl_src, const void* xc_src, bool xbf, void* xl_dst, void* xc_dst, bool obf,
                         const float* gy, int l_gate, int gate_idx, bool do_h, const float* gh, int l_h, int shift_idx, int scale_idx) {
    const int tid = opaque_tid(); const int lane = tid & 63, wave = tid >> 6;
    const int stride = gridDim.x * 8;
    int row = blockIdx.x * 8 + wave;
    f32x4 gyv[4], ghv[4];
#pragma unroll
    for (int j = 0; j < 4; ++j) { gyv[j] = y ? *(const f32x4*)(gy + j * 256 + lane * 4) : (f32x4){0.f, 0.f, 0.f, 0.f}; ghv[j] = do_h ? *(const f32x4*)(gh + j * 256 + lane * 4) : (f32x4){0.f, 0.f, 0.f, 0.f}; }
    f32x4 gtv[4], s1v[4], s2v[4]; int cur = -1;
#pragma unroll
    for (int j = 0; j < 4; ++j) { gtv[j] = (f32x4){0.f, 0.f, 0.f, 0.f}; s1v[j] = gtv[j]; s2v[j] = gtv[j]; }
    RowRegs N0, N1;
    if (row < mrows) row_load(N0, row, lane, y, ypart, nsl, xl_src, xc_src, xbf);
    if (row + stride < mrows) row_load(N1, row + stride, lane, y, ypart, nsl, xl_src, xc_src, xbf);
    for (; row < mrows; row += 2 * stride) {
        RowRegs C0 = N0, C1 = N1;
        const bool two = row + stride < mrows;
        if (row + 2 * stride < mrows) row_load(N0, row + 2 * stride, lane, y, ypart, nsl, xl_src, xc_src, xbf);
        if (row + 3 * stride < mrows) row_load(N1, row + 3 * stride, lane, y, ypart, nsl, xl_src, xc_src, xbf);
        row_process(a, C0, row, lane, y != nullptr, xl_dst, xc_dst, obf, gyv, l_gate, gate_idx, do_h, ghv, l_h, shift_idx, scale_idx, gtv, s1v, s2v, cur);
        if (two) row_process(a, C1, row + stride, lane, y != nullptr, xl_dst, xc_dst, obf, gyv, l_gate, gate_idx, do_h, ghv, l_h, shift_idx, scale_idx, gtv, s1v, s2v, cur);
    }
}


__device__ __forceinline__ void lwconv_task(const Args& a, int l, int frag) {
    const int tid = opaque_tid(); const int lane = tid >> 3, j = tid & 7;
    const float* W; int ct, ks;
    if (frag < 128) { const int m = frag >> 6, rem = frag & 63, d = rem >> 5; ct = (rem >> 1) & 15; ks = rem & 1; W = (m == 0 ? a.in[I_W2] : a.in[I_A2]) + (size_t)(l * 2 + d) * 64 * 256; }
    else { const int rem = frag - 128; ct = rem >> 2; ks = rem & 3; W = a.in[I_G2] + (size_t)l * 128 * 256; }
    const int r = ks * 32 + (lane >> 4) * 8 + j, c = ct * 16 + (lane & 15);
    ((bf16_t*)(a.ws + lwbase(l)))[(size_t)frag * 512 + lane * 8 + j] = f2bf(W[r * 256 + c]);
}
__device__ __forceinline__ bf16x8 lds_afrag(const float* p) {
    const f32x4 x0 = *(const f32x4*)p, x1 = *(const f32x4*)(p + 4);
    u32x4 w; w.x = cvt_pk_bf16(x0[0], x0[1]); w.y = cvt_pk_bf16(x0[2], x0[3]); w.z = cvt_pk_bf16(x1[0], x1[1]); w.w = cvt_pk_bf16(x1[2], x1[3]); return __builtin_bit_cast(bf16x8, w);
}
struct PrepRegs { u32x2 fraw[9], sraw[9]; };
__device__ __forceinline__ void prep_issue_loads(PrepRegs& R, const bf16_t* pxr, int tile, int tid) {
#pragma unroll
    for (int it = 0; it < 9; ++it) {
        const int i = tid + it * NTHR; const int tk = i / (NPXR / 4), j = (i - tk * (NPXR / 4)) * 4; const int row = tile * 16 + tk;
        R.fraw[it] = *(const u32x2*)(pxr + (size_t)row * NPXR + j);
        int nrow; bool valid;
        if (row < ML) { const int t = row & 4095; const int q = j < 384 ? j / 96 : (j - 384) / 192;
            if (q == 0) { valid = (t & 63) > 0; nrow = row - 1; } else if (q == 1) { valid = (t & 63) < 63; nrow = row + 1; }
            else if (q == 2) { valid = t >= 64; nrow = row - 64; } else { valid = t < TL - 64; nrow = row + 64; } }
        else { const int c = (row - ML) & 255; const int hf = j < 384 ? j / 192 : (j - 384) / 384;
            if (hf == 0) { valid = c > 0; nrow = row - 1; } else { valid = c < 255; nrow = row + 1; } }
        R.sraw[it] = (u32x2){0u, 0u}; if (valid) R.sraw[it] = *(const u32x2*)(pxr + (size_t)nrow * NPXR + j);
    }
}
__device__ __forceinline__ void rwkv_prep_tile(const Args& a, int l, int tile, int tile_next, PrepRegs& R, unsigned char* lds) {
    float* mx = (float*)lds; float* rinv = mx + 16 * NPXR;
    const int tid = opaque_tid(), lane = tid & 63, wave = tid >> 6, fr = lane & 15, quad = lane >> 4;
    const bf16_t* pxr = (const bf16_t*)(a.ws + WS_PXR);
    const float* mu = a.in[I_MU] + l * NPXR;
    unsigned char* prep = a.ws + WS_PREP;
    float* PW = (float*)(prep + PREP_W); float* PKA = (float*)(prep + PREP_KA); bf16_t* PKD = (bf16_t*)(prep + PREP_KD); float* PKK = (float*)(prep + PREP_KK);
    bf16_t* PR = (bf16_t*)(prep + PREP_R); bf16_t* PV = (bf16_t*)(prep + PREP_V); bf16_t* PG = (bf16_t*)(prep + PREP_G);
    const size_t row0 = (size_t)tile * 16;
    {
#pragma unroll
        for (int it = 0; it < 9; ++it) {
            const int i = tid + it * NTHR; const int tk = i / (NPXR / 4), j = (i - tk * (NPXR / 4)) * 4; const int row = tile * 16 + tk;
            const f32x4 f = bf4_to_f32(R.fraw[it]), sv = bf4_to_f32(R.sraw[it]);
            const f32x4 muv = *(const f32x4*)(mu + j);
            f32x4 m = f + (sv - f) * muv;
            if (j >= 256 && j < 384) { for (int e = 0; e < 4; ++e) m[e] = __builtin_amdgcn_rcpf(1.f + __expf(-m[e])); }
            else if (j >= 896 && j < 1024) { for (int e = 0; e < 4; ++e) m[e] = 1.f - 2.f * __builtin_amdgcn_rcpf(1.f + __expf(2.f * m[e])); }
            *(f32x4*)(mx + tk * NPXR + j) = m;
            if (j < 256) *(u32x2*)(PR + (size_t)row * 256 + j) = f32_to_bf4(m);
            else if (j >= 640 && j < 896) *(u32x2*)(PV + (size_t)row * 256 + (j - 640)) = f32_to_bf4(m);
        }
    }
    __syncthreads();
    {
#pragma unroll
        for (int tt = 0; tt < 2; ++tt) { const int tk = wave * 2 + tt;
#pragma unroll
            for (int hh = 0; hh < 4; ++hh) { const float x = mx[tk * NPXR + 384 + hh * 64 + lane] * a.in[I_KK][l * 256 + hh * 64 + lane];
                const float ss = wave_sum(x * x); const float ri = fminf(__builtin_amdgcn_rsqf(ss), 1e12f);
                PKK[(row0 + tk) * 256 + hh * 64 + lane] = x * ri; if (lane == 0) rinv[tk * 4 + hh] = ri; } }
    }
    __syncthreads();
    if (tile_next >= 0) prep_issue_loads(R, pxr, tile_next, tid);
    const bf16_t* lw = (const bf16_t*)(a.ws + lwbase(l));
    const size_t orow = row0 + fr;
#pragma unroll 1
    for (int cc = 0; cc < 2; ++cc) {
        const int ct = wave * 2 + cc; const int c0 = ct * 16 + quad * 4; const int hh = ct >> 2;
        const f32x4 kx = *(const f32x4*)(mx + fr * NPXR + 384 + c0);
        const f32x4 kkp = *(const f32x4*)(a.in[I_KK] + l * 256 + c0), kap = *(const f32x4*)(a.in[I_KA] + l * 256 + c0);
        const float ri = rinv[fr * 4 + hh];
        bf16x8 wg[4], ww[2][2], wa[2][2]; f32x4 w0p2[2], a0p2[2];
#pragma unroll
        for (int ks = 0; ks < 4; ++ks) wg[ks] = *(const bf16x8*)(lw + (size_t)(128 + ct * 4 + ks) * 512 + lane * 8);
#pragma unroll
        for (int d = 0; d < 2; ++d) {
#pragma unroll
            for (int ks = 0; ks < 2; ++ks) { ww[d][ks] = *(const bf16x8*)(lw + (size_t)((d * 16 + ct) * 2 + ks) * 512 + lane * 8); wa[d][ks] = *(const bf16x8*)(lw + (size_t)(64 + (d * 16 + ct) * 2 + ks) * 512 + lane * 8); }
            w0p2[d] = *(const f32x4*)(a.in[I_W0] + (l * 2 + d) * 256 + c0); a0p2[d] = *(const f32x4*)(a.in[I_A0] + (l * 2 + d) * 256 + c0); }
        {
            f32x4 acc = {0.f, 0.f, 0.f, 0.f};
#pragma unroll
            for (int ks = 0; ks < 4; ++ks) { const bf16x8 wf = wg[ks]; const bf16x8 af = lds_afrag(mx + fr * NPXR + 256 + ks * 32 + quad * 8);
                acc = __builtin_amdgcn_mfma_f32_16x16x32_bf16(wf, af, acc, 0, 0, 0); }
            *(u32x2*)(PG + orow * 256 + c0) = f32_to_bf4(acc);
        }
#pragma unroll
        for (int d = 0; d < 2; ++d) {
            f32x4 accw = {0.f, 0.f, 0.f, 0.f}, acca = {0.f, 0.f, 0.f, 0.f};
#pragma unroll
            for (int ks = 0; ks < 2; ++ks) {
                const bf16x8 wf = ww[d][ks]; const bf16x8 af = lds_afrag(mx + fr * NPXR + 896 + d * 64 + ks * 32 + quad * 8);
                accw = __builtin_amdgcn_mfma_f32_16x16x32_bf16(wf, af, accw, 0, 0, 0);
                const bf16x8 wf2 = wa[d][ks]; const bf16x8 af2 = lds_afrag(mx + fr * NPXR + 1024 + d * 64 + ks * 32 + quad * 8);
                acca = __builtin_amdgcn_mfma_f32_16x16x32_bf16(wf2, af2, acca, 0, 0, 0); }
            const f32x4 w0p = w0p2[d], a0p = a0p2[d];
            f32x4 wv, kav, kdv;
#pragma unroll
            for (int e = 0; e < 4; ++e) { const float z = w0p[e] + accw[e];
                wv[e] = __expf(-0.6065306597126334f * __builtin_amdgcn_rcpf(1.f + __expf(-z)));
                const float av = __builtin_amdgcn_rcpf(1.f + __expf(-(a0p[e] + acca[e])));
                kav[e] = kx[e] * kkp[e] * ri * av; kdv[e] = kx[e] * (1.f + (av - 1.f) * kap[e]); }
            *(f32x4*)(PW + (orow * 2 + d) * 256 + c0) = wv; *(f32x4*)(PKA + (orow * 2 + d) * 256 + c0) = kav; *(u32x2*)(PKD + (orow * 2 + d) * 256 + c0) = f32_to_bf4(kdv);
        }
    }
    __syncthreads();
}

__device__ __forceinline__ unsigned gl_ld(const unsigned* p) { return __hip_atomic_load(p, __ATOMIC_RELAXED, __HIP_MEMORY_SCOPE_AGENT); }
__device__ __forceinline__ void gl_add(unsigned* p, unsigned v) { (void)__hip_atomic_fetch_add(p, v, __ATOMIC_RELAXED, __HIP_MEMORY_SCOPE_AGENT); }
#ifndef PREP_EARLY_TILES
#define PREP_EARLY_TILES 512
#endif
constexpr int PREP_TILES = MT / 16, PREP_EARLY = PREP_EARLY_TILES, PREP_LATE_ROUNDS = (PREP_TILES - PREP_EARLY + 127) / 128;
constexpr int CW_PREP = 4096;
static_assert(PREP_LATE_ROUNDS <= 8 && PREP_EARLY % 256 == 0 && PREP_EARLY >= 64, "prep split");
__device__ __forceinline__ int prep_tile_of(int o) {
    if (o < 64) return ML / 16 + o;
    const int q = o - 64, b = q & 3, p = q >> 2, i = p >> 1; return b * 256 + ((p & 1) ? 255 - i : i);
}
__device__ __forceinline__ void prep_publish(unsigned* cnt) {
    asm volatile("s_waitcnt vmcnt(0)" ::: "memory");
    __syncthreads();
    if (threadIdx.x == 0) { __builtin_amdgcn_fence(__ATOMIC_RELEASE, "agent"); asm volatile("s_waitcnt vmcnt(0)" ::: "memory"); gl_add(cnt, 1u); }
}
__device__ __forceinline__ void prep_wait_for_chunk(const unsigned* cnt_layer, int ck, int& rd) {
    if (ck < 16 || rd >= PREP_LATE_ROUNDS) return;
    const int ft = ck - 16; const int i = ft < 128 ? ft : 255 - ft; const int oneed = 64 + 8 * i + 7;
    if (oneed < PREP_EARLY) return;
    const int r = (oneed - PREP_EARLY) >> 7;
    if (rd > r) return;
    while (rd <= r) {
        const unsigned expect = (unsigned)((PREP_TILES - PREP_EARLY - rd * 128) < 128 ? (PREP_TILES - PREP_EARLY - rd * 128) : 128);
        unsigned sp = 0; while (gl_ld(cnt_layer + 64 * rd) < expect) { __builtin_amdgcn_s_sleep(2); if (++sp > (1u << 22)) break; }
        ++rd;
    }
    __builtin_amdgcn_fence(__ATOMIC_ACQUIRE, "agent"); asm volatile("s_waitcnt vmcnt(0)" ::: "memory");
}
constexpr int SC_STEPS = 16, SC_NCH = (CL + TL) / SC_STEPS, SC_OPB = 5 * SC_STEPS * 256 + SC_STEPS * 64, SC_PB = SC_STEPS * 16 * 64;
__device__ __forceinline__ int scan_row(int b, int d, int s) {
    if (d == 0) return s < CL ? ML + b * CL + s : b * TL + (s - CL);
    return s < CL ? ML + b * CL + (CL - 1 - s) : b * TL + (TL - 1 - (s - CL));
}
typedef float f32x2 __attribute__((ext_vector_type(2)));
struct ScanStage { f32x4 w, kk, ka; u32x2 kd, r, v; };
struct ScanPtrs { const float *PW, *PKA, *PKK; const bf16_t *PKD, *PR, *PV; float* YS; int b, h, d, rgp; };
__device__ __forceinline__ void scan_issue_loads(ScanStage& R, const ScanPtrs& P, int ck, int lt) {
    const int st = lt >> 4, q4 = lt & 15; const size_t row = (size_t)scan_row(P.b, P.d, ck * SC_STEPS + st); const int co = P.h * 64 + q4 * 4;
    R.w = *(const f32x4*)(P.PW + (row * 2 + P.d) * 256 + co); R.kd = *(const u32x2*)(P.PKD + (row * 2 + P.d) * 256 + co); R.kk = *(const f32x4*)(P.PKK + row * 256 + co);
    R.ka = *(const f32x4*)(P.PKA + (row * 2 + P.d) * 256 + co); R.r = *(const u32x2*)(P.PR + row * 256 + co);
    { const int lv = lt & 63; const size_t rowV = (size_t)scan_row(P.b, P.d, ck * SC_STEPS + (lv >> 2)); R.v = *(const u32x2*)(P.PV + rowV * 256 + P.h * 64 + P.rgp * 16 + (lv & 3) * 4); }
}
__device__ __forceinline__ void scan_store_lds(const ScanStage& R, unsigned char* buf, int lt) {
    const int st = lt >> 4, q4 = lt & 15;
    unsigned char* p = buf + st * 256 + q4 * 16;
    *(f32x4*)(p) = R.w; *(f32x4*)(p + SC_STEPS * 256) = bf4_to_f32(R.kd); *(f32x4*)(p + 2 * SC_STEPS * 256) = R.kk; *(f32x4*)(p + 3 * SC_STEPS * 256) = R.ka; *(f32x4*)(p + 4 * SC_STEPS * 256) = bf4_to_f32(R.r);
    if (lt < 64) { const f32x4 vv = bf4_to_f32(R.v); float* vb = (float*)(buf + 5 * SC_STEPS * 256) + (lt & 3) * 4 * SC_STEPS + (lt >> 2);
        vb[0] = vv[0]; vb[SC_STEPS] = vv[1]; vb[2 * SC_STEPS] = vv[2]; vb[3 * SC_STEPS] = vv[3]; }
}
__device__ __forceinline__ void scan_reduce_y(const ScanPtrs& P, const unsigned char* pb, int ck, int lt) {
    const int st = lt >> 4, row = lt & 15; const float* p = (const float*)(pb + (st * 16 + row) * 64);
    const f32x4 p0 = *(const f32x4*)p, p1 = *(const f32x4*)(p + 4), p2 = *(const f32x4*)(p + 8), p3 = *(const f32x4*)(p + 12);
    const f32x4 q = (p0 + p1) + (p2 + p3);
    const size_t grow = (size_t)scan_row(P.b, P.d, ck * SC_STEPS + st);
    P.YS[(grow * 2 + P.d) * 256 + P.h * 64 + P.rgp * 16 + row] = (q[0] + q[1]) + (q[2] + q[3]);
}
struct ScanOps { f32x4 w4, kd4, kk4, ka4, r4; };
__device__ __forceinline__ void scan_ld_ops(ScanOps& o, const unsigned char* bp, const unsigned char* vp, int st) {
    o.w4 = *(const f32x4*)(bp + st * 256); o.kd4 = *(const f32x4*)(bp + SC_STEPS * 256 + st * 256); o.kk4 = *(const f32x4*)(bp + 2 * SC_STEPS * 256 + st * 256);
    o.ka4 = *(const f32x4*)(bp + 3 * SC_STEPS * 256 + st * 256); o.r4 = *(const f32x4*)(bp + 4 * SC_STEPS * 256 + st * 256);
    (void)vp;
}
#define SCAN_BAR() asm volatile("s_waitcnt lgkmcnt(0)\n\ts_barrier" ::: "memory")
__device__ __forceinline__ void scan_task(const Args& a, int task, const unsigned* prep_cnt, unsigned char* lds) {
    const int tid = opaque_tid(), lane = tid & 63, wave = tid >> 6;
    const int xcd = task & 7, kx = task >> 3; const int chain = xcd * 4 + (kx >> 2); ScanPtrs P;
    P.rgp = kx & 3; P.b = chain >> 3; P.h = (chain >> 1) & 3; P.d = chain & 1;
    unsigned char* prep = a.ws + WS_PREP;
    P.PW = (const float*)(prep + PREP_W); P.PKA = (const float*)(prep + PREP_KA); P.PKD = (const bf16_t*)(prep + PREP_KD); P.PKK = (const float*)(prep + PREP_KK);
    P.PR = (const bf16_t*)(prep + PREP_R); P.PV = (const bf16_t*)(prep + PREP_V); P.YS = (float*)(a.ws + WS_YS);
    unsigned char* pbase = lds + 2 * SC_OPB;
    __syncthreads();
    if (wave >= 4) {
        const int lt = tid - 256; ScanStage R0, R1, R2;
        int rd = 0;
        scan_issue_loads(R0, P, 0, lt); scan_store_lds(R0, lds, lt);
        scan_issue_loads(R1, P, 1, lt); scan_issue_loads(R2, P, 2, lt); scan_issue_loads(R0, P, 3, lt);
        SCAN_BAR();
#define SCAN_LOADER_IT(CK, RS) do { const int ck_ = (CK); if (ck_ < SC_NCH) { \
            if (ck_ + 1 < SC_NCH) scan_store_lds(RS, lds + ((ck_ + 1) & 1) * SC_OPB, lt); \
            if (ck_ + 4 < SC_NCH) { prep_wait_for_chunk(prep_cnt, ck_ + 4, rd); scan_issue_loads(RS, P, ck_ + 4, lt); } \
            if (ck_ >= 1) scan_reduce_y(P, pbase + ((ck_ - 1) & 1) * SC_PB, ck_ - 1, lt); \
            SCAN_BAR(); } } while (0)
        for (int ck = 0; ck < SC_NCH; ck += 3) { SCAN_LOADER_IT(ck, R1); SCAN_LOADER_IT(ck + 1, R2); SCAN_LOADER_IT(ck + 2, R0); }
#undef SCAN_LOADER_IT
        scan_reduce_y(P, pbase + ((SC_NCH - 1) & 1) * SC_PB, SC_NCH - 1, lt);
    } else {
        const int rw = lane >> 4, kq = lane & 15, rowA = wave * 4 + rw;
        f32x2 SL = {0.f, 0.f}, SH = {0.f, 0.f};
        SCAN_BAR();
        for (int ck = 0; ck < SC_NCH; ++ck) {
            const unsigned char* bp = lds + (ck & 1) * SC_OPB + kq * 16;
            const unsigned char* vp = lds + (ck & 1) * SC_OPB + 5 * SC_STEPS * 256 + rowA * (SC_STEPS * 4);
            f32x4 vq[4];
#pragma unroll
            for (int q = 0; q < 4; ++q) vq[q] = *(const f32x4*)(vp + q * 16);
            float* pw = (float*)(pbase + (ck & 1) * SC_PB) + rowA * 16 + kq;
            ScanOps o0, o1, o2;
            scan_ld_ops(o0, bp, vp, 0); scan_ld_ops(o1, bp, vp, 1);
#pragma unroll
            for (int st = 0; st < SC_STEPS; ++st) {
                scan_ld_ops(o2, bp, vp, st + 2 < SC_STEPS ? st + 2 : SC_STEPS - 1);
                const f32x2 wlo = {o0.w4[0], o0.w4[1]}, whi = {o0.w4[2], o0.w4[3]}, kdlo = {o0.kd4[0], o0.kd4[1]}, kdhi = {o0.kd4[2], o0.kd4[3]}, kklo = {o0.kk4[0], o0.kk4[1]}, kkhi = {o0.kk4[2], o0.kk4[3]},
                            kalo = {o0.ka4[0], o0.ka4[1]}, kahi = {o0.ka4[2], o0.ka4[3]}, rlo = {o0.r4[0], o0.r4[1]}, rhi = {o0.r4[2], o0.r4[3]};
                const f32x2 dp = SL * kklo + SH * kkhi;
                const float sa = row16_sum(dp[0] + dp[1]);
                const float va = vq[st >> 2][st & 3];
                const f32x2 TL = SL * wlo + kdlo * va, TH = SH * whi + kdhi * va;
                SL = TL - kalo * sa; SH = TH - kahi * sa;
                const f32x2 yy = SL * rlo + SH * rhi;
                pw[st * 256] = yy[0] + yy[1];
                o0 = o1; o1 = o2;
            }
            SCAN_BAR();
        }
    }
}

struct RoRegs { float y0, y1; unsigned short r, kd0, kd1, v, g; };
__device__ __forceinline__ void ro_load(RoRegs& R, size_t row, int c, const float* YS, const bf16_t* PR, const bf16_t* PKD, const bf16_t* PV, const bf16_t* PG) {
    R.y0 = YS[(row * 2 + 0) * 256 + c]; R.y1 = YS[(row * 2 + 1) * 256 + c]; R.r = PR[row * 256 + c]; R.kd0 = PKD[(row * 2 + 0) * 256 + c]; R.kd1 = PKD[(row * 2 + 1) * 256 + c];
    R.v = PV[row * 256 + c]; R.g = PG[row * 256 + c];
}
__device__ __forceinline__ void rwkv_out(const Args& a, int l, int mrows) {
    const int tid = opaque_tid(), c = tid & 255;
    unsigned char* prep = a.ws + WS_PREP;
    const bf16_t* PKD = (const bf16_t*)(prep + PREP_KD); const bf16_t* PR = (const bf16_t*)(prep + PREP_R); const bf16_t* PV = (const bf16_t*)(prep + PREP_V); const bf16_t* PG = (const bf16_t*)(prep + PREP_G);
    const float* YS = (const float*)(a.ws + WS_YS); bf16_t* hbuf = (bf16_t*)(a.ws + WS_HBUF);
    const float lg = a.in[I_LNXG][l * 256 + c], lb = a.in[I_LNXB][l * 256 + c], rk = a.in[I_RK][l * 256 + c];
    const size_t stride = (size_t)gridDim.x * 2;
    size_t row = (size_t)blockIdx.x * 2 + (tid >> 8);
    RoRegs N;
    if (row < (size_t)mrows) ro_load(N, row, c, YS, PR, PKD, PV, PG);
    for (; row < (size_t)mrows; row += stride) {
        const RoRegs C = N;
        if (row + stride < (size_t)mrows) ro_load(N, row + stride, c, YS, PR, PKD, PV, PG);
        const float y = C.y0 + C.y1;
        const float mean = wave_sum(y) * (1.f / 64.f); const float dv = y - mean; const float var = wave_sum(dv * dv) * (1.f / 64.f);
        const float yn = dv * rsqrtf(var + 64e-5f) * lg + lb;
        const float bonus = wave_sum(bf2f(C.r) * (bf2f(C.kd0) + bf2f(C.kd1)) * rk);
        const float o = (yn + bonus * bf2f(C.v)) * bf2f(C.g);
        hbuf[row * DM + 768 + c] = f2bf(o);
    }
}

__device__ __forceinline__ bf16x8 load_rope8(const bf16_t* base, int sgm, bool rope, const float* rc, const float* rs, float scale) {
    const u32x4 own = *(const u32x4*)(base + sgm * 8);
    float o[8];
#pragma unroll
    for (int i = 0; i < 4; ++i) { o[2 * i] = __builtin_bit_cast(float, own[i] << 16); o[2 * i + 1] = __builtin_bit_cast(float, own[i] & 0xffff0000u); }
    if (rope) {
        const u32x4 par = *(const u32x4*)(base + (sgm ^ 2) * 8);
        const int tb = (sgm >> 2) * 16 + (sgm & 1) * 8; const float sgn = (sgm & 2) ? 1.f : -1.f;
#pragma unroll
        for (int i = 0; i < 4; ++i) { const float p0 = __builtin_bit_cast(float, par[i] << 16), p1 = __builtin_bit_cast(float, par[i] & 0xffff0000u);
            o[2 * i] = o[2 * i] * rc[tb + 2 * i] + sgn * p0 * rs[tb + 2 * i]; o[2 * i + 1] = o[2 * i + 1] * rc[tb + 2 * i + 1] + sgn * p1 * rs[tb + 2 * i + 1]; }
    }
    u32x4 w; w.x = cvt_pk_bf16(o[0] * scale, o[1] * scale); w.y = cvt_pk_bf16(o[2] * scale, o[3] * scale); w.z = cvt_pk_bf16(o[4] * scale, o[5] * scale); w.w = cvt_pk_bf16(o[6] * scale, o[7] * scale);
    return __builtin_bit_cast(bf16x8, w);
}
constexpr int KS_PITCH = 72, VT_PITCH = 136, VT_OFF = 128 * KS_PITCH * 2;
__device__ __forceinline__ void attn_unit(const Args& a, int l, int unit, unsigned char* lds) {
    const int tid = opaque_tid(), lane = tid & 63, wave = tid >> 6, fr = lane & 15, quad = lane >> 4;
    bf16_t* Ks = (bf16_t*)lds; bf16_t* Vt = (bf16_t*)(lds + VT_OFF);
    const bf16_t* pxa = (const bf16_t*)(a.ws + WS_PXA); bf16_t* hbuf = (bf16_t*)(a.ws + WS_HBUF);
    const float* rc = (const float*)(a.ws + WS_ROPE); const float* rs = rc + TL * 32;
    const bool isctx = unit >= 256; int b, nblk, kvh, qrow0;
    if (!isctx) { b = unit >> 6; nblk = (unit >> 1) & 31; kvh = unit & 1; qrow0 = b * TL + nblk * 128; }
    else { const int u2 = unit - 256; b = u2 >> 2; nblk = (u2 >> 1) & 1; kvh = u2 & 1; qrow0 = ML + b * CL + nblk * 128; }
    const int qi = wave * 16 + fr; const size_t qrow = (size_t)qrow0 + qi; const int tq = nblk * 128 + qi;
    bf16x8 bq[4][2]; float mrun[4], lsum[4]; f32x4 O[4][4];
#pragma unroll
    for (int g = 0; g < 4; ++g) { const int head = kvh * 4 + g;
#pragma unroll
        for (int ks = 0; ks < 2; ++ks) bq[g][ks] = load_rope8(pxa + qrow * NPXA + 512 + head * 64, 4 * ks + quad, !isctx, rc + tq * 32, rs + tq * 32, 0.18033688011112042f);
        mrun[g] = a.in[I_SINK][l * 8 + head] * 1.4426950408889634f; lsum[g] = quad == 0 ? 1.f : 0.f;
#pragma unroll
        for (int dt = 0; dt < 4; ++dt) O[g][dt] = (f32x4){0.f, 0.f, 0.f, 0.f}; }
    const int nchunk = isctx ? 2 : 5;
    for (int ch = 0; ch < nchunk; ++ch) {
        const bool cchunk = ch < 2; const int lc = ch - 2; const int blk = nblk - 1 + lc;
        if (!cchunk && (blk < 0 || blk > 31)) continue;
        __syncthreads();
#pragma unroll
        for (int it = 0; it < 2; ++it) { const int item = tid + NTHR * it; const int key = item >> 3, sgm = item & 7;
            const size_t krow = cchunk ? (size_t)ML + b * CL + ch * 128 + key : (size_t)b * TL + blk * 128 + key; const int tk = blk * 128 + key;
            const bf16x8 kf = load_rope8(pxa + krow * NPXA + 1024 + kvh * 64, sgm, !cchunk, rc + (cchunk ? 0 : tk) * 32, rs + (cchunk ? 0 : tk) * 32, 1.f);
            *(bf16x8*)(Ks + key * KS_PITCH + sgm * 8) = kf;
            const bf16x8 vf = *(const bf16x8*)(pxa + krow * NPXA + 1152 + kvh * 64 + sgm * 8);
#pragma unroll
            for (int i = 0; i < 8; ++i) Vt[(sgm * 8 + i) * VT_PITCH + key] = (bf16_t)vf[i]; }
        __syncthreads();
#pragma unroll 1
        for (int kt = 0; kt < 4; ++kt) {
            bf16x8 ak[2][2], av[4];
#pragma unroll
            for (int sub = 0; sub < 2; ++sub)
#pragma unroll
                for (int ks = 0; ks < 2; ++ks) ak[sub][ks] = *(const bf16x8*)(Ks + (kt * 32 + sub * 16 + fr) * KS_PITCH + ks * 32 + quad * 8);
#pragma unroll
            for (int dt = 0; dt < 4; ++dt) { const bf16_t* vp = Vt + (dt * 16 + fr) * VT_PITCH + kt * 32 + quad * 4;
                const u32x2 lo = *(const u32x2*)vp, hi = *(const u32x2*)(vp + 16); u32x4 w; w.x = lo.x; w.y = lo.y; w.z = hi.x; w.w = hi.y; av[dt] = __builtin_bit_cast(bf16x8, w); }
#pragma unroll
            for (int g = 0; g < 4; ++g) {
                f32x4 s0 = {0.f, 0.f, 0.f, 0.f}, s1 = {0.f, 0.f, 0.f, 0.f};
                s0 = __builtin_amdgcn_mfma_f32_16x16x32_bf16(ak[0][0], bq[g][0], s0, 0, 0, 0); s0 = __builtin_amdgcn_mfma_f32_16x16x32_bf16(ak[0][1], bq[g][1], s0, 0, 0, 0);
                s1 = __builtin_amdgcn_mfma_f32_16x16x32_bf16(ak[1][0], bq[g][0], s1, 0, 0, 0); s1 = __builtin_amdgcn_mfma_f32_16x16x32_bf16(ak[1][1], bq[g][1], s1, 0, 0, 0);
                if (!cchunk && lc != 1) {
#pragma unroll
                    for (int j = 0; j < 4; ++j) { const int k0 = kt * 32 + quad * 4 + j, k1 = k0 + 16;
                        const bool v0 = lc == 0 ? (k0 >= qi) : (k0 <= qi), v1 = lc == 0 ? (k1 >= qi) : (k1 <= qi);
                        s0[j] = v0 ? s0[j] : -1e30f; s1[j] = v1 ? s1[j] : -1e30f; } }
                float mx = fmaxf(fmaxf(fmaxf(s0[0], s0[1]), fmaxf(s0[2], s0[3])), fmaxf(fmaxf(s1[0], s1[1]), fmaxf(s1[2], s1[3])));
                mx = fmaxf(mx, __shfl_xor(mx, 16)); mx = fmaxf(mx, __shfl_xor(mx, 32));
                const float mold = mrun[g]; const float mn = fmaxf(mold, mx); mrun[g] = mn;
                float p[8];
#pragma unroll
                for (int j = 0; j < 4; ++j) { p[j] = __builtin_amdgcn_exp2f(s0[j] - mn); p[4 + j] = __builtin_amdgcn_exp2f(s1[j] - mn); }
                const float psum = ((p[0] + p[1]) + (p[2] + p[3])) + ((p[4] + p[5]) + (p[6] + p[7]));
                const bool grew = __builtin_amdgcn_ballot_w64(mn != mold) != 0ull;
                if (grew) { const float alpha = __builtin_amdgcn_exp2f(mold - mn); lsum[g] = lsum[g] * alpha + psum;
#pragma unroll
                    for (int dt = 0; dt < 4; ++dt) O[g][dt] = O[g][dt] * alpha; }
                else lsum[g] += psum;
                u32x4 w; w.x = cvt_pk_bf16(p[0], p[1]); w.y = cvt_pk_bf16(p[2], p[3]); w.z = cvt_pk_bf16(p[4], p[5]); w.w = cvt_pk_bf16(p[6], p[7]);
                const bf16x8 bp = __builtin_bit_cast(bf16x8, w);
#pragma unroll
                for (int dt = 0; dt < 4; ++dt) O[g][dt] = __builtin_amdgcn_mfma_f32_16x16x32_bf16(av[dt], bp, O[g][dt], 0, 0, 0);
            }
        }
    }
#pragma unroll
    for (int g = 0; g < 4; ++g) { const int head = kvh * 4 + g;
        float lt = lsum[g]; lt += __shfl_xor(lt, 16); lt += __shfl_xor(lt, 32); const float inv = 1.f / lt;
#pragma unroll
        for (int dt = 0; dt < 4; ++dt) { const f32x4 o = O[g][dt] * inv; u32x2 w; w.x = cvt_pk_bf16(o[0], o[1]); w.y = cvt_pk_bf16(o[2], o[3]);
            *(u32x2*)(hbuf + qrow * DM + 256 + head * 64 + dt * 16 + quad * 4) = w; } }
    __syncthreads();
}

__device__ __forceinline__ void gmlp_unit(const Args& a, int l, int chunk, unsigned char* lds) {
    const int tid = opaque_tid(), lane = tid & 63, wave = tid >> 6, fr = lane & 15, quad = lane >> 4;
    bf16_t* vT = (bf16_t*)lds;
    const bf16_t* pxa = (const bf16_t*)(a.ws + WS_PXA); bf16_t* hbuf = (bf16_t*)(a.ws + WS_HBUF);
    const size_t row0 = (size_t)chunk * 128;
    { const f32x4 lg = *(const f32x4*)(a.in[I_SGLNG] + l * 256 + lane * 4), lb = *(const f32x4*)(a.in[I_SGLNB] + l * 256 + lane * 4);
      u32x2 raws[16];
#pragma unroll
      for (int i = 0; i < 16; ++i) raws[i] = *(const u32x2*)(pxa + (row0 + wave * 16 + i) * NPXA + 256 + lane * 4);
#pragma unroll
      for (int hf = 0; hf < 2; ++hf) {
          unsigned pk[4][4];
#pragma unroll
          for (int i2 = 0; i2 < 4; ++i2) {
              float xn[2][4];
#pragma unroll
              for (int s2 = 0; s2 < 2; ++s2) {
                  const u32x2 raw = raws[hf * 8 + i2 * 2 + s2];
                  float x[4] = { gelu_tanh(__builtin_bit_cast(float, raw.x << 16)), gelu_tanh(__builtin_bit_cast(float, raw.x & 0xffff0000u)), gelu_tanh(__builtin_bit_cast(float, raw.y << 16)), gelu_tanh(__builtin_bit_cast(float, raw.y & 0xffff0000u)) };
                  const float mean = wave_sum((x[0] + x[1]) + (x[2] + x[3])) * (1.f / 256.f);
                  float q = 0.f;
#pragma unroll
                  for (int j = 0; j < 4; ++j) { x[j] -= mean; q += x[j] * x[j]; }
                  const float rstd = rsqrtf(wave_sum(q) * (1.f / 256.f) + 1e-5f);
#pragma unroll
                  for (int j = 0; j < 4; ++j) xn[s2][j] = x[j] * rstd * lg[j] + lb[j]; }
#pragma unroll
              for (int j = 0; j < 4; ++j) pk[j][i2] = cvt_pk_bf16(xn[0][j], xn[1][j]);
          }
#pragma unroll
          for (int j = 0; j < 4; ++j) { u32x4 w; w.x = pk[j][0]; w.y = pk[j][1]; w.z = pk[j][2]; w.w = pk[j][3];
              *(u32x4*)(vT + (lane * 4 + j) * VT_PITCH + wave * 16 + hf * 8) = w; }
      } }
    __syncthreads();
    const int pt = wave;
#pragma unroll 1
    for (int g = 0; g < 4; ++g) {
        bf16x8 af[4];
        const float* wsrc = a.in[I_SGW] + ((size_t)(l * 4 + g) * 128 + pt * 16 + fr) * 128 + quad * 8;
#pragma unroll
        for (int ks = 0; ks < 4; ++ks) { const f32x4 w0 = *(const f32x4*)(wsrc + ks * 32), w1 = *(const f32x4*)(wsrc + ks * 32 + 4);
            u32x4 w; w.x = cvt_pk_bf16(w0[0], w0[1]); w.y = cvt_pk_bf16(w0[2], w0[3]); w.z = cvt_pk_bf16(w1[0], w1[1]); w.w = cvt_pk_bf16(w1[2], w1[3]); af[ks] = __builtin_bit_cast(bf16x8, w); }
        f32x4 bs;
#pragma unroll
        for (int j = 0; j < 4; ++j) bs[j] = a.in[I_SGB][(l * 4 + g) * 128 + pt * 16 + quad * 4 + j];
        unsigned short uraw[4][4];
#pragma unroll
        for (int dt = 0; dt < 4; ++dt)
#pragma unroll
            for (int j = 0; j < 4; ++j) uraw[dt][j] = pxa[(row0 + pt * 16 + quad * 4 + j) * NPXA + g * 64 + dt * 16 + fr];
#pragma unroll
        for (int dt = 0; dt < 4; ++dt) { const int chn = g * 64 + dt * 16 + fr;
            f32x4 acc = {0.f, 0.f, 0.f, 0.f};
#pragma unroll
            for (int ks = 0; ks < 4; ++ks) { const bf16x8 bv = *(const bf16x8*)(vT + chn * VT_PITCH + ks * 32 + quad * 8); acc = __builtin_amdgcn_mfma_f32_16x16x32_bf16(af[ks], bv, acc, 0, 0, 0); }
#pragma unroll
            for (int j = 0; j < 4; ++j) { const size_t row = row0 + pt * 16 + quad * 4 + j;
                const float uu = gelu_tanh(bf2f(uraw[dt][j]));
                hbuf[row * DM + chn] = f2bf(uu * (acc[j] + bs[j])); } }
    }
    __syncthreads();
}

struct PieceOrder { int unit; bool has;
    __device__ __forceinline__ bool next(int i, pg8::Unit& u) const { if (i != 0 || !has) return false; u.pm = unit >> 2; u.pn = unit & 3; return true; }
    __device__ __forceinline__ void a_ready(const pg8::Unit&) const {}
    __device__ __forceinline__ void done(const pg8::Unit&) const {}
};
#define LAS __attribute__((address_space(3)))
constexpr size_t WS_CTL = 768 * 1024, CTL_BYTES = 32768;
constexpr int LDS_BARST_OFF = 131072 + 64;
#define XB_TMO      128
#define XB_XCNT(j)  (256  + 64 * (j))
#define XB_XSUB(j)  (1280 + 64 * (j))
#define XB_XGEN(j)  (2304 + 64 * (j))
#define XB_TOP      3328
#define XB_TOPGEN   3392
#define XCD_BAR_WORDS 3456
#define XB_SPIN_CAP (1u << 18)

__device__ __forceinline__ unsigned xb_ld(unsigned* p)              { return __hip_atomic_load(p, __ATOMIC_RELAXED, __HIP_MEMORY_SCOPE_AGENT); }
__device__ __forceinline__ unsigned xb_add(unsigned* p, unsigned v) { return __hip_atomic_fetch_add(p, v, __ATOMIC_RELAXED, __HIP_MEMORY_SCOPE_AGENT); }
__device__ __forceinline__ unsigned xb_xcc_id() { return (unsigned)__builtin_amdgcn_s_getreg((3 << 11) | 20) & 0xFu; }
#define XB_SPIN(cond, bar) do { unsigned _sp = 0; while (cond) { __builtin_amdgcn_s_sleep(1); \
    if ((++_sp & 255u) == 0u) { if (xb_ld(&(bar)[XB_TMO])) break; if (_sp > XB_SPIN_CAP) { atomicAdd(&(bar)[XB_TMO], 1u); break; } } } } while (0)

struct XcdBarrier {
    unsigned* bar; unsigned x;
    volatile LAS unsigned* st;
};

__device__ __forceinline__ XcdBarrier xcd_barrier_post(unsigned* bar, volatile LAS unsigned* st) {
    XcdBarrier b; b.bar = bar; b.x = xb_xcc_id(); b.st = st;
    if (threadIdx.x == 0) (void)xb_add(&bar[XB_XCNT(b.x)], 1u);
    return b;
}
__device__ __forceinline__ void xcd_barrier_complete(unsigned* bar, unsigned x, unsigned& nloc, unsigned& nx) {
    const unsigned G = gridDim.x * gridDim.y * gridDim.z;
    unsigned sum, cnt, mine, sp = 0u;
    for (;;) {
        sum = 0u; cnt = 0u; mine = 0u;
#pragma unroll
        for (unsigned j = 0; j < 16; ++j) { const unsigned c = xb_ld(&bar[XB_XCNT(j)]); sum += c; cnt += (c > 0u) ? 1u : 0u; mine = (j == x) ? c : mine; }
        if (sum == G) break;
        __builtin_amdgcn_s_sleep(1);
        if ((++sp & 255u) == 0u) { if (xb_ld(&bar[XB_TMO])) break; if (sp > XB_SPIN_CAP) { atomicAdd(&bar[XB_TMO], 1u); break; } }
    }
    nloc = mine > 0u ? mine : 1u; nx = cnt > 0u ? cnt : 1u;
}

__device__ __forceinline__ void xcd_barrier(const XcdBarrier& b) {
    asm volatile("s_waitcnt vmcnt(0)" ::: "memory");
    __syncthreads();
    if (threadIdx.x == 0) {
        unsigned* bar = b.bar;
        __builtin_amdgcn_s_waitcnt(0);
        unsigned nloc = b.st[0], nx = b.st[1];
        if (nloc == 0u) { xcd_barrier_complete(bar, b.x, nloc, nx); b.st[0] = nloc; b.st[1] = nx; }
        const unsigned old = xb_add(&bar[XB_XSUB(b.x)], 1u);
        const unsigned gen = old / nloc;
        if (old + 1u == (gen + 1u) * nloc) {
            __builtin_amdgcn_fence(__ATOMIC_RELEASE, "agent");
            asm volatile("s_waitcnt vmcnt(0)" ::: "memory");
            const unsigned og = xb_add(&bar[XB_TOP], 1u);
            const unsigned tg = og / nx;
            if (og + 1u == (tg + 1u) * nx) xb_add(&bar[XB_TOPGEN], 1u);
            else XB_SPIN(xb_ld(&bar[XB_TOPGEN]) == tg, bar);
            __builtin_amdgcn_fence(__ATOMIC_ACQUIRE, "agent");
            xb_add(&bar[XB_XGEN(b.x)], 1u);
            asm volatile("s_waitcnt vmcnt(0)" ::: "memory");
        } else {
            XB_SPIN(xb_ld(&bar[XB_XGEN(b.x)]) == gen, bar);
            __builtin_amdgcn_fence(__ATOMIC_ACQUIRE, "agent");
            asm volatile("s_waitcnt vmcnt(0)" ::: "memory");
        }
    }
    __syncthreads();
}

constexpr int N_PHASES = 2 + 9 * NL;
template <int MASK> __device__ __forceinline__ void run_phase(const Args& a, int ph, unsigned char* lds) {
    int G = gridDim.x, bid = blockIdx.x; asm volatile("" : "+s"(G), "+s"(bid));
    bf16_t* HB = (bf16_t*)(a.ws + WS_HBUF); float* XC = (float*)(a.ws + WS_XC); bf16_t* YD = (bf16_t*)(a.ws + WS_YD);
    if (ph == 0) { if constexpr (MASK & 1) {
        for (int t = bid; t < 192; t += G) modv_task(a, t, lds);
        for (int t = bid; t < 256; t += G) rope_task(a, t);
        wconv_loop(a, 0, bid, G, lds);
        for (int t = bid; t < 192; t += G) lwconv_task(a, 0, t); }
        return;
    }
    if (ph == 1) { if constexpr (MASK & 2) row_pass(a, MT, nullptr, nullptr, 0, a.in[I_X], a.in[I_CTX], false, nullptr, nullptr, false, nullptr, 0, 0, true, a.in[I_NORMG] + 0, 0, 0, 1); return; }
    const int l = (ph - 2) / 9, s = (ph - 2) % 9;
    const bool last = (l == NL - 1);
    const float* ng = a.in[I_NORMG] + l * 4 * DM;
    const void* xl = l == 0 ? (const void*)a.in[I_X] : (const void*)a.out; const void* xc = l == 0 ? (const void*)a.in[I_CTX] : (const void*)XC;
    void* xmid = last ? (void*)(a.ws + WS_PXA) : (void*)a.out;
    float* YP = (float*)(a.ws + WS_YP);
    const int mpost = last ? ML : MT;
    switch (s) {
    case 0: if constexpr (MASK & 4) { pg8::Gemm g{HB, (const bf16_t*)(a.ws + wbase(l)), MT, NIN, DM, DM}; pg8::StaticOrder S; S.init(MT, NIN, G, bid);
              EpiIn E{(bf16_t*)(a.ws + WS_PXA), (bf16_t*)(a.ws + WS_PXR)};
              pg8::gemm_phase<EpiIn, pg8::StaticOrder, true, true>((PG8_LAS unsigned char*)lds, g, S, E); } break;
    case 1: if constexpr (MASK & 8) { if (bid < PREP_EARLY) { PrepRegs R; prep_issue_loads(R, (const bf16_t*)(a.ws + WS_PXR), prep_tile_of(bid), opaque_tid());
              for (int o = bid; o < PREP_EARLY; o += G) rwkv_prep_tile(a, l, prep_tile_of(o), o + G < PREP_EARLY ? prep_tile_of(o + G) : -1, R, lds); } } break;
    case 2: if constexpr (MASK & 16) { unsigned* pcnt = (unsigned*)(a.ws + WS_CTL) + CW_PREP + 64 * (l * 8);
            if (bid < 128) { for (int rep = 0; rep <= PROBE_SCAN; ++rep) scan_task(a, bid, pcnt, lds); }
            else { { const int w = bid - 128, nw = G - 128;
                if (PREP_EARLY + w < PREP_TILES) { PrepRegs R; prep_issue_loads(R, (const bf16_t*)(a.ws + WS_PXR), prep_tile_of(PREP_EARLY + w), opaque_tid());
                  for (int o = PREP_EARLY + w; o < PREP_TILES; o += nw) { rwkv_prep_tile(a, l, prep_tile_of(o), o + nw < PREP_TILES ? prep_tile_of(o + nw) : -1, R, lds); prep_publish(pcnt + 64 * ((o - PREP_EARLY) / nw)); } } }
            for (int rep = 0; rep <= PROBE_ATT; ++rep) { const int w = bid - 128, nw = G - 128; const int natt = last ? 256 : 272, ngm = last ? 128 : 136;
                for (int u = w; u < natt + ngm; u += nw) { if (u < natt) attn_unit(a, l, u, lds); else gmlp_unit(a, l, u - natt, lds); }
                if (!last && rep == 0) { wconv_loop(a, l + 1, w, nw, lds); for (int t = w; t < 192; t += nw) lwconv_task(a, l + 1, t); } } } } break;
    case 3: if constexpr (MASK & 32) rwkv_out(a, l, mpost); break;
    case 4: if constexpr (MASK & 64) {
              { pg8::Gemm g{HB, (const bf16_t*)(a.ws + wbase(l) + WO_OUT), ML, DM, DM, DM}; pg8::StaticOrder S; S.init(ML, DM, G, bid);
                EpiBf16Out E{YD}; pg8::gemm_phase<EpiBf16Out, pg8::StaticOrder, true, true>((PG8_LAS unsigned char*)lds, g, S, E); }
              if (!last) { const int piece = bid, sl = piece >> 4; PieceOrder S{piece & 15, piece < 64};
                pg8::Gemm g{HB + (size_t)ML * DM + (sl & 3) * 256, (const bf16_t*)(a.ws + wbase(l) + WO_OUT) + (sl & 3) * 256, MC, DM, 256, DM};
                EpiF32 E{YP + (size_t)(sl & 3) * MC * DM}; pg8::gemm_phase<EpiF32, PieceOrder, true, true>((PG8_LAS unsigned char*)lds, g, S, E); } } break;
    case 5: if constexpr (MASK & 2) row_pass(a, mpost, YD, YP, 4, xl, xc, l != 0, xmid, XC, true, ng + 1 * DM, l, 2, true, ng + 2 * DM, l, 3, 4); break;
    case 6: if constexpr (MASK & 128) { pg8::Gemm g{HB, (const bf16_t*)(a.ws + wbase(l) + WO_GU), mpost, 2 * DFF, DM, DM}; pg8::StaticOrder S; S.init(mpost, 2 * DFF, G, bid);
              EpiSwiglu E{(bf16_t*)(a.ws + WS_ACT)}; pg8::gemm_phase<EpiSwiglu, pg8::StaticOrder, true, true>((PG8_LAS unsigned char*)lds, g, S, E); } break;
    case 7: if constexpr (MASK & 512) {
              { pg8::Gemm g{(const bf16_t*)(a.ws + WS_ACT), (const bf16_t*)(a.ws + wbase(l) + WO_DN), ML, DM, DFF, DFF}; pg8::StaticOrder S; S.init(ML, DM, G, bid);
                EpiBf16Out E{YD}; pg8::gemm_phase<EpiBf16Out, pg8::StaticOrder, true, true>((PG8_LAS unsigned char*)lds, g, S, E); }
              if (!last) { const int piece = bid; int sl = piece >> 4; if (sl > 6) sl = 6; PieceOrder S{piece & 15, piece < 112};
                pg8::Gemm g{(const bf16_t*)(a.ws + WS_ACT) + (size_t)ML * DFF + sl * 384, (const bf16_t*)(a.ws + wbase(l) + WO_DN) + sl * 384, MC, DM, sl == 6 ? 512 : 384, DFF};
                EpiF32 E{YP + (size_t)sl * MC * DM}; pg8::gemm_phase<EpiF32, PieceOrder, true, true>((PG8_LAS unsigned char*)lds, g, S, E); } } break;
    case 8: if constexpr (MASK & 256) {
              row_pass(a, mpost, YD, YP, 7, xmid, XC, true, a.out, XC, !last, ng + 3 * DM, l, 5, !last, a.in[I_NORMG] + (last ? 0 : (l + 1) * 4 * DM), last ? 0 : l + 1, 0, 1); } break;
    }
}

template <int MASK> __global__ void __launch_bounds__(NTHR) trunk_fwd(Args args) {
    extern __shared__ __attribute__((aligned(16))) unsigned char lds[];
    cg::grid_group grid = cg::this_grid();
    if (args.ph_lo > args.ph_hi) grid.sync();
    if (threadIdx.x < 4) ((LAS unsigned*)((LAS unsigned char*)lds + LDS_BARST_OFF))[threadIdx.x] = 0u;
    __syncthreads();
    XcdBarrier bar = xcd_barrier_post((unsigned*)(args.ws + WS_CTL), (volatile LAS unsigned*)((LAS unsigned char*)lds + LDS_BARST_OFF));
#define GRID_SYNC() xcd_barrier(bar)
    for (int ph = args.ph_lo; ph < args.ph_hi; ++ph) {
        const int nrep = (ph == PROBE_PH) ? 2 : (PROBE_DUP && ph >= 2) ? 1 + ((PROBE_DUP >> ((ph - 2) % 9)) & 1) : 1;
        for (int rep = 0; rep < nrep; ++rep) {
            run_phase<MASK>(args, ph, lds);
            if (ph + 1 < args.ph_hi || rep + 1 < nrep) GRID_SYNC();
            for (int es = 0; es < PROBE_SYNC; ++es) GRID_SYNC();
        }
    }
}
__host__ inline int phase_mask(int ph) { if (ph == 0) return 1; if (ph == 1) return 2; const int s = (ph - 2) % 9; const int m[9] = {4, 8, 16, 32, 64, 2, 128, 512, 256}; return m[s]; }
__host__ inline const void* kernel_for(int mask) {
#if MK_PER_PHASE
    switch (mask) { case 1: return (const void*)trunk_fwd<1>; case 2: return (const void*)trunk_fwd<2>; case 4: return (const void*)trunk_fwd<4>; case 8: return (const void*)trunk_fwd<8>; case 16: return (const void*)trunk_fwd<16>;
        case 32: return (const void*)trunk_fwd<32>; case 64: return (const void*)trunk_fwd<64>; case 128: return (const void*)trunk_fwd<128>; case 256: return (const void*)trunk_fwd<256>; case 512: return (const void*)trunk_fwd<512>;
        default: return nullptr; }
#else
    (void)mask; return (const void*)trunk_fwd<1023>;
#endif
}

extern "C" void kernel_launch(void* const* d_in, const int* in_sizes, int n_in, void* d_out, int out_size, void* d_ws, size_t ws_size, hipStream_t stream) {
    static int grid = 0;
    if (grid == 0) {
        if (n_in != N_IN || out_size != ML * DM || ws_size < WS_END2) { fprintf(stderr, "kernel_launch: unexpected shapes: n_in %d out %d ws %zu (need %zu)\n", n_in, out_size, ws_size, (size_t)WS_END2); grid = -1; return; }
        int dev = 0, cus = 0, per_cu = 0;
        (void)hipGetDevice(&dev); (void)hipDeviceGetAttribute(&cus, hipDeviceAttributeMultiprocessorCount, dev);
#if MK_PER_PHASE
        for (int mk = 1; mk <= 512; mk <<= 1) {
#else
        for (int mk = 1023; mk <= 1023; ++mk) {
#endif
            if (hipFuncSetAttribute(kernel_for(mk), hipFuncAttributeMaxDynamicSharedMemorySize, LDS_BYTES) != hipSuccess) { fprintf(stderr, "kernel_launch: hipFuncSetAttribute failed\n"); grid = -1; return; }
            if (hipOccupancyMaxActiveBlocksPerMultiprocessor(&per_cu, kernel_for(mk), NTHR, LDS_BYTES) != hipSuccess || per_cu < 1) { fprintf(stderr, "kernel_launch: occupancy query says %d blocks per CU\n", per_cu); grid = -1; return; }
        }
        grid = cus;
        if (grid != 256) fprintf(stderr, "kernel_launch: note: %d CUs (the phase split assumes 256)\n", grid);
    }
    if (grid < 0) return;
    if (hipMemsetAsync((char*)d_ws + WS_CTL, 0, CTL_BYTES, stream) != hipSuccess) { fprintf(stderr, "kernel_launch: memset of the barrier words failed\n"); return; }
    Args a{};
    for (int i = 0; i < N_IN; ++i) a.in[i] = (const float*)d_in[i];
    a.out = (float*)d_out; a.ws = (unsigned char*)d_ws;
#if MK_PER_PHASE
    for (int ph = 0; ph < N_PHASES; ++ph) { a.ph_lo = ph; a.ph_hi = ph + 1; void* kargs[] = {&a};
        hipError_t e = hipLaunchCooperativeKernel(kernel_for(phase_mask(ph)), dim3(grid), dim3(NTHR), kargs, LDS_BYTES, stream);
        if (e != hipSuccess) { fprintf(stderr, "kernel_launch: launch of phase %d failed: %s\n", ph, hipGetErrorString(e)); break; } }
#else
    a.ph_lo = 0; a.ph_hi = N_PHASES; void* kargs[] = {&a};
    hipError_t e = hipLaunchCooperativeKernel(kernel_for(1023), dim3(grid), dim3(NTHR), kargs, LDS_BYTES, stream);
    if (e != hipSuccess) fprintf(stderr, "kernel_launch: cooperative launch failed: %s (grid %d)\n", hipGetErrorString(e), grid);
#endif
}
```

```cpp
#include <hip/hip_runtime.h>
#include <hip/hip_cooperative_groups.h>
#include <cstdio>
#include <cstdint>
namespace cg = cooperative_groups;
__device__ __forceinline__ int opaque_tid() { int t = threadIdx.x; asm volatile("" : "+v"(t)); return t; }
namespace pg8 {
#define PG8_LAS __attribute__((address_space(3)))
typedef unsigned short bf16_t;
typedef short bf16x8 __attribute__((ext_vector_type(8)));
typedef float f32x4 __attribute__((ext_vector_type(4)));
typedef unsigned u32x4 __attribute__((ext_vector_type(4)));
constexpr int BM = 256, BK = 64, HALF = 128, HTB = HALF * BK * 2  , STAGE_BYTES = 8 * HTB, NXCD = 8, WGM = 8;

__host__ __device__ __forceinline__ int lds_byte(int r, int c) { const int st = (r >> 4) * 2 + (c >> 5), rr = r & 15, cc = c & 31, ob = rr * 64 + cc * 2; return st * 1024 + (ob ^ (((ob >> 9) & 1) << 5)); }
__host__ __device__ __forceinline__ void stage_rc(int b, int& R, int& C) { const int st = b / 1024, sb = b % 1024, swz = sb ^ (((sb >> 9) & 1) << 5); R = (st >> 1) * 16 + swz / 64; C = (st & 1) * 32 + (swz % 64) / 2; }
__host__ __device__ __forceinline__ int perm32(int rho) { const int n = rho >> 4, i = rho & 15; return 8 * (i >> 2) + 4 * n + (i & 3); }

struct Unit { int pm, pn; };
struct Gemm { const bf16_t* A; const bf16_t* Bt; int M, N, K, ld; };

struct StaticOrder {
    int nM, nN, nwg, G, c;
    __host__ __device__ void init(int M, int N, int G_, int c_) { nM = M / BM; nN = N / BM; nwg = nM * nN; G = G_; c = c_; }
    __host__ __device__ bool next(int i, Unit& u) const {
        const long L = (long)i * G + c; if (L >= nwg) return false;
        int wgid = (int)L; { const int q = nwg / NXCD, r = nwg % NXCD, xcd = wgid % NXCD, off = wgid / NXCD; wgid = (xcd < r ? xcd * (q + 1) : r * (q + 1) + (xcd - r) * q) + off; }
        const int nig = WGM * nN, gid = wgid / nig, fm = gid * WGM, gsz = (nM - fm) < WGM ? (nM - fm) : WGM;
        u.pm = fm + ((wgid % nig) % gsz); u.pn = (wgid % nig) / gsz; return true;
    }
    __device__ __forceinline__ void a_ready(const Unit&) const {}
    __device__ __forceinline__ void done(const Unit&) const {}
};
__device__ __forceinline__ unsigned cvt_pk_bf16(float lo, float hi) { unsigned r; asm volatile("v_cvt_pk_bf16_f32 %0, %1, %2" : "=v"(r) : "v"(lo), "v"(hi)); return r; }
template <class Epi, class Sched, bool ALIGN_EPI = false, bool SP2 = false>
__device__ __forceinline__ void gemm_phase(PG8_LAS unsigned char* lds, const Gemm g, const Sched& S, const Epi& E) {
    const int tid = opaque_tid(), wid = __builtin_amdgcn_readfirstlane(tid >> 6), lane = tid & 63, wr = wid >> 2, wc = wid & 3, fr = lane & 15, fq = lane >> 4;
    const int K = g.ld, nt = g.K / BK;
    unsigned voffA[2], voffB[2];
#pragma unroll
    for (int i = 0; i < 2; ++i) { int R, C; stage_rc(tid * 16 + i * 8192, R, C); const int Rb = Epi::PERM ? ((R & ~31) + perm32(R & 31)) : R;
        voffA[i] = (unsigned)(R * K + C) * 2u; voffB[i] = (unsigned)(Rb * K + C) * 2u; }
    const size_t kstep = (size_t)(BK * 2);
    const size_t hstep = (size_t)HALF * K * 2;
    const size_t tstep = 2 * hstep;
    const unsigned ldsw = (unsigned)wid * 1024u;
    const int aoff = lds_byte(wr * 64 + fr, fq * 8), boff = lds_byte(wc * 32 + fr, fq * 8);
#define PG8_SA(b, h) (((b) * 2 + (h)) * HTB)
#define PG8_SB(b, h) ((4 + (b) * 2 + (h)) * HTB)
#define PG8_STAGE(bufoff, gbase, voff) do { _Pragma("unroll") for (int _i = 0; _i < 2; ++_i) \
        __builtin_amdgcn_global_load_lds((const unsigned*)((const char*)(gbase) + (voff)[_i]), (PG8_LAS unsigned*)(lds + (bufoff) + ldsw + _i * 8192), 16, 0, 0); } while (0)
#define PG8_LDA(dst, b, h) do { _Pragma("unroll") for (int m = 0; m < 4; ++m) _Pragma("unroll") for (int k = 0; k < 2; ++k) dst[m][k] = *(const PG8_LAS bf16x8*)(lds + PG8_SA(b, h) + aoff + m * 2048 + k * 1024); } while (0)
#define PG8_LDB(dst, b, h) do { _Pragma("unroll") for (int n = 0; n < 2; ++n) _Pragma("unroll") for (int k = 0; k < 2; ++k) dst[n][k] = *(const PG8_LAS bf16x8*)(lds + PG8_SB(b, h) + boff + n * 2048 + k * 1024); } while (0)
#define PG8_MMA(ai, bj, At, Bt) do { __builtin_amdgcn_s_setprio(1); _Pragma("unroll") for (int m = 0; m < 4; ++m) _Pragma("unroll") for (int n = 0; n < 2; ++n) _Pragma("unroll") for (int k = 0; k < 2; ++k) \
        acc[ai][bj][m][n] = __builtin_amdgcn_mfma_f32_16x16x32_bf16(Bt[n][k], At[m][k], acc[ai][bj][m][n], 0, 0, 0); __builtin_amdgcn_s_setprio(0); } while (0)
#define PG8_WAIT_V(n) asm volatile("s_waitcnt vmcnt(" #n ")" ::: "memory")
#define PG8_WAIT_L(n) asm volatile("s_waitcnt lgkmcnt(" #n ")" ::: "memory")
#define PG8_BAR __builtin_amdgcn_s_barrier()
#define PG8_SCHED __builtin_amdgcn_sched_barrier(0)
    Unit cur, nxt; int ui = 0;
    if (!S.next(0, cur)) return;
    f32x4 acc[2][2][4][2];
#pragma unroll
    for (int a = 0; a < 2; ++a)
#pragma unroll
        for (int b = 0; b < 2; ++b)
#pragma unroll
            for (int m = 0; m < 4; ++m)
#pragma unroll
                for (int n = 0; n < 2; ++n) acc[a][b][m][n] = (f32x4){0.f, 0.f, 0.f, 0.f};
    bf16x8 At[4][2], B0[2][2], B1[2][2];
    const char* cA = (const char*)g.A + (size_t)cur.pm * tstep; const char* cB = (const char*)g.Bt + (size_t)cur.pn * tstep;
    S.a_ready(cur);
    if constexpr (SP2) {
        PG8_STAGE(PG8_SB(0, 0), cB, voffB); PG8_STAGE(PG8_SB(0, 1), cB + hstep, voffB); PG8_STAGE(PG8_SA(0, 0), cA, voffA); PG8_STAGE(PG8_SA(0, 1), cA + hstep, voffA);
        if (wr == 1) PG8_BAR;
        PG8_WAIT_V(2); PG8_BAR;
        PG8_STAGE(PG8_SB(1, 0), cB + kstep, voffB); PG8_STAGE(PG8_SA(1, 0), cA + kstep, voffA); PG8_STAGE(PG8_SB(1, 1), cB + hstep + kstep, voffB);
        PG8_WAIT_V(6); PG8_BAR;
    } else {
        PG8_STAGE(PG8_SB(0, 0), cB, voffB); PG8_STAGE(PG8_SA(0, 0), cA, voffA); PG8_STAGE(PG8_SB(0, 1), cB + hstep, voffB); PG8_STAGE(PG8_SA(0, 1), cA + hstep, voffA);
        if (wr == 1) PG8_BAR;
        PG8_WAIT_V(4); PG8_BAR;
        PG8_STAGE(PG8_SB(1, 0), cB + kstep, voffB); PG8_STAGE(PG8_SA(1, 0), cA + kstep, voffA); PG8_STAGE(PG8_SB(1, 1), cB + hstep + kstep, voffB);
        PG8_WAIT_V(6); PG8_BAR;
    }
    for (;;) {
        const bool has_next = S.next(ui + 1, nxt);
        const char* nA = has_next ? (const char*)g.A + (size_t)nxt.pm * tstep : cA; const char* nB = has_next ? (const char*)g.Bt + (size_t)nxt.pn * tstep : cB;
        for (int t = 0; t < nt; t += 2) {
            const bool last = (t == nt - 2);
            const char* a1 = cA + (size_t)(t + 1) * kstep;
            const char* a2 = last ? nA : cA + (size_t)(t + 2) * kstep; const char* b2 = last ? nB : cB + (size_t)(t + 2) * kstep;
            const char* a3 = a2 + kstep; const char* b3 = b2 + kstep;
            if (last && has_next) S.a_ready(nxt);
            if constexpr (SP2) {
            PG8_LDB(B0, 0, 0); PG8_LDB(B1, 0, 1); PG8_SCHED; PG8_LDA(At, 0, 0); PG8_STAGE(PG8_SA(1, 1), a1 + hstep, voffA);
            PG8_WAIT_V(8); PG8_WAIT_L(0); PG8_BAR; PG8_MMA(0, 0, At, B0); PG8_MMA(0, 1, At, B1); PG8_BAR; PG8_SCHED;
            PG8_LDA(At, 0, 1); PG8_STAGE(PG8_SB(0, 0), b2, voffB); PG8_STAGE(PG8_SB(0, 1), b2 + hstep, voffB); PG8_STAGE(PG8_SA(0, 0), a2, voffA);
            PG8_WAIT_V(8); PG8_WAIT_L(0); PG8_BAR; PG8_MMA(1, 0, At, B0); PG8_MMA(1, 1, At, B1); PG8_BAR; PG8_SCHED;
            PG8_LDB(B0, 1, 0); PG8_LDB(B1, 1, 1); PG8_SCHED; PG8_LDA(At, 1, 0); PG8_STAGE(PG8_SA(0, 1), a2 + hstep, voffA);
            PG8_WAIT_V(8); PG8_WAIT_L(0); PG8_BAR; PG8_MMA(0, 0, At, B0); PG8_MMA(0, 1, At, B1); PG8_BAR; PG8_SCHED;
            PG8_LDA(At, 1, 1); PG8_STAGE(PG8_SB(1, 0), b3, voffB); PG8_STAGE(PG8_SB(1, 1), b3 + hstep, voffB); PG8_STAGE(PG8_SA(1, 0), a3, voffA);
            PG8_WAIT_V(8); PG8_WAIT_L(0); PG8_BAR; PG8_MMA(1, 0, At, B0); PG8_MMA(1, 1, At, B1); PG8_BAR; PG8_SCHED;
            } else {
            PG8_LDB(B0, 0, 0); PG8_SCHED; PG8_LDA(At, 0, 0); PG8_STAGE(PG8_SA(1, 1), a1 + hstep, voffA);
            PG8_WAIT_L(8); PG8_BAR; PG8_WAIT_L(0); PG8_MMA(0, 0, At, B0); PG8_BAR; PG8_SCHED;
            PG8_LDB(B1, 0, 1); PG8_STAGE(PG8_SB(0, 0), b2, voffB);
            PG8_BAR; PG8_WAIT_L(0); PG8_MMA(0, 1, At, B1); PG8_BAR;
            PG8_LDA(At, 0, 1); PG8_STAGE(PG8_SA(0, 0), a2, voffA);
            PG8_BAR; PG8_WAIT_L(0); PG8_MMA(1, 0, At, B0); PG8_BAR; PG8_SCHED;
            PG8_STAGE(PG8_SB(0, 1), b2 + hstep, voffB);
            PG8_WAIT_V(6); PG8_BAR; PG8_MMA(1, 1, At, B1); PG8_BAR;
            PG8_LDB(B0, 1, 0); PG8_SCHED; PG8_LDA(At, 1, 0); PG8_STAGE(PG8_SA(0, 1), a2 + hstep, voffA);
            PG8_WAIT_L(8); PG8_BAR; PG8_WAIT_L(0); PG8_MMA(0, 0, At, B0); PG8_BAR; PG8_SCHED;
            PG8_LDB(B1, 1, 1); PG8_STAGE(PG8_SB(1, 0), b3, voffB);
            PG8_BAR; PG8_WAIT_L(0); PG8_MMA(0, 1, At, B1); PG8_BAR;
            PG8_LDA(At, 1, 1); PG8_STAGE(PG8_SA(1, 0), a3, voffA);
            PG8_BAR; PG8_WAIT_L(0); PG8_MMA(1, 0, At, B0); PG8_BAR; PG8_SCHED;
            PG8_STAGE(PG8_SB(1, 1), b3 + hstep, voffB);
            PG8_WAIT_V(6); PG8_BAR; PG8_MMA(1, 1, At, B1); PG8_BAR;
            }
        }
        if constexpr (ALIGN_EPI) { if (wr == 0) PG8_BAR; }
        if constexpr (!Epi::AFTER_DRAIN) { E(acc, cur, wr, wc, fr, fq); S.done(cur); }
        if (!has_next) break;
#pragma unroll
        for (int a = 0; a < 2; ++a)
#pragma unroll
            for (int b = 0; b < 2; ++b)
#pragma unroll
                for (int m = 0; m < 4; ++m)
#pragma unroll
                    for (int n = 0; n < 2; ++n) acc[a][b][m][n] = (f32x4){0.f, 0.f, 0.f, 0.f};
        cur = nxt; cA = nA; cB = nB; ++ui;
        if constexpr (ALIGN_EPI) { if (wr == 1) PG8_BAR; }
    }
    PG8_WAIT_V(0);
    if constexpr (!ALIGN_EPI) { if (wr == 0) PG8_BAR; }
    PG8_BAR;
    if constexpr (Epi::AFTER_DRAIN) { E.fused(acc, cur, wr, wc, fr, fq, lds, wid, lane); S.done(cur); }
#undef PG8_SA
#undef PG8_SB
#undef PG8_STAGE
#undef PG8_LDA
#undef PG8_LDB
#undef PG8_MMA
#undef PG8_WAIT_V
#undef PG8_WAIT_L
#undef PG8_BAR
#undef PG8_SCHED
}
}

#ifndef PROBE_DUP
#define PROBE_DUP 0
#endif
#ifndef PROBE_PH
#define PROBE_PH -1
#endif
#ifndef PROBE_SYNC
#define PROBE_SYNC 0
#endif
#ifndef PROBE_SCANC
#define PROBE_SCANC 0
#endif
#ifndef PROBE_SCAN
#define PROBE_SCAN 0
#endif
#ifndef PROBE_ATT
#define PROBE_ATT 0
#endif
#ifndef MK_PER_PHASE
#define MK_PER_PHASE 0
#endif
using pg8::bf16_t; using pg8::bf16x8; using pg8::f32x4; using pg8::u32x4;
typedef __bf16 bf16x2v __attribute__((ext_vector_type(2)));
typedef float f32x2c __attribute__((ext_vector_type(2)));
__device__ __forceinline__ unsigned cvt_pk_bf16(float lo, float hi) { const f32x2c v = {lo, hi}; return __builtin_bit_cast(unsigned, __builtin_convertvector(v, bf16x2v)); }
typedef unsigned u32x2 __attribute__((ext_vector_type(2)));
typedef short bf16x4 __attribute__((ext_vector_type(4)));

constexpr int DM = 1024, NB = 4, TL = 4096, CL = 256, NL = 4;
constexpr int ML = NB * TL, MC = NB * CL, MT = ML + MC;
constexpr int NIN = 2560, NPXA = 1280, NPXR = 1152, DFF = 2816, INC = 2432;
constexpr int NTHR = 512;
constexpr int LDS_BYTES = 147456;
constexpr size_t MiB = 1u << 20;
constexpr size_t WS_MODV = 0, WS_ROPE = 1 * MiB, WS_XC = 2 * MiB, WS_WIN = 6 * MiB, WS_WOUT = 11 * MiB, WS_WGU = 13 * MiB, WS_WDN = 24 * MiB;
constexpr size_t WS_HBUF = 30 * MiB, WS_PXA = 64 * MiB, WS_PXR = 107 * MiB, WS_PREP = 184 * MiB, WS_END = 354 * MiB;
constexpr size_t WS_WB1 = 146 * MiB;
constexpr size_t WS_LW = 512 * 1024, WS_LW1 = 832 * 1024;
__device__ __forceinline__ size_t wbase(int l) { return (l & 1) ? WS_WB1 : WS_WIN; }
__device__ __forceinline__ size_t lwbase(int l) { return (l & 1) ? WS_LW1 : WS_LW; }
constexpr size_t WO_OUT = 5 * MiB, WO_GU = 7 * MiB, WO_DN = 18 * MiB;
constexpr size_t WS_YS = 312 * MiB;
constexpr size_t WS_ACT = WS_PREP, WS_YD = 278 * MiB, WS_YP = 346 * MiB, WS_END2 = 374 * MiB;
constexpr size_t PREP_W = 0, PREP_KA = (size_t)MT * 512 * 4, PREP_KD = 2 * PREP_KA, PREP_KK = PREP_KD + (size_t)MT * 512 * 2, PREP_R = PREP_KK + (size_t)MT * 256 * 4,
                 PREP_V = PREP_R + (size_t)MT * 256 * 2, PREP_G = PREP_V + (size_t)MT * 256 * 2;
static_assert(WS_HBUF + (size_t)MT * 1024 * 2 <= WS_PXA && WS_PXA + (size_t)MT * NPXA * 2 <= WS_PXR && WS_PXR + (size_t)MT * NPXR * 4 <= WS_PREP, "ws map 1");
static_assert(WS_PREP + PREP_G + (size_t)MT * 256 * 2 <= WS_YS && WS_YS + (size_t)MT * 512 * 4 <= WS_YP && WS_ACT + (size_t)MT * DFF * 2 <= WS_YD && WS_YD + (size_t)MT * 1024 * 4 <= WS_END, "ws map 2");

enum { I_X = 0, I_C, I_CTX, I_CCTX, I_WMOD, I_BMOD, I_NORMG, I_WIN, I_WOUT, I_SGLNG, I_SGLNB, I_SGW, I_SGB, I_SINK, I_MU, I_W0, I_W2, I_A0, I_A2, I_KK, I_KA, I_RK, I_G2, I_LNXG, I_LNXB, I_WGU, I_WDN, N_IN };
struct Args { const float* in[N_IN]; float* out; unsigned char* ws; int ph_lo, ph_hi; };

__device__ __forceinline__ float bf2f(unsigned short h) { return __builtin_bit_cast(float, (unsigned)h << 16); }
__device__ __forceinline__ unsigned cvt_pk_bf16(float lo, float hi);
__device__ __forceinline__ unsigned short f2bf(float f) { return (unsigned short)(cvt_pk_bf16(f, 0.f) & 0xffffu); }
__device__ __forceinline__ f32x4 bf4_to_f32(u32x2 r) { f32x4 o; o[0] = __builtin_bit_cast(float, r.x << 16); o[1] = __builtin_bit_cast(float, r.x & 0xffff0000u); o[2] = __builtin_bit_cast(float, r.y << 16); o[3] = __builtin_bit_cast(float, r.y & 0xffff0000u); return o; }
__device__ __forceinline__ u32x2 f32_to_bf4(f32x4 v) { u32x2 w; w.x = cvt_pk_bf16(v[0], v[1]); w.y = cvt_pk_bf16(v[2], v[3]); return w; }
template <int CTRL> __device__ __forceinline__ float dppf(float x) { return __builtin_bit_cast(float, __builtin_amdgcn_mov_dpp(__builtin_bit_cast(int, x), CTRL, 0xf, 0xf, true)); }
__device__ __forceinline__ float row16_sum(float x) { x += dppf<0xB1>(x); x += dppf<0x4E>(x); x += dppf<0x141>(x); x += dppf<0x128>(x); return x; }
__device__ __forceinline__ float wave_sum(float v) {
    v = row16_sum(v);
    const float r0 = __builtin_bit_cast(float, __builtin_amdgcn_readlane(__builtin_bit_cast(int, v), 0)), r1 = __builtin_bit_cast(float, __builtin_amdgcn_readlane(__builtin_bit_cast(int, v), 16)),
                r2 = __builtin_bit_cast(float, __builtin_amdgcn_readlane(__builtin_bit_cast(int, v), 32)), r3 = __builtin_bit_cast(float, __builtin_amdgcn_readlane(__builtin_bit_cast(int, v), 48));
    return (r0 + r1) + (r2 + r3);
}
__device__ __forceinline__ float gelu_tanh(float x) { const float u = 0.7978845608028654f * (x + 0.044715f * x * x * x); const float t = 1.f - 2.f * __builtin_amdgcn_rcpf(1.f + __expf(2.f * u)); return 0.5f * x * (1.f + t); }
__device__ __forceinline__ float sigmoidf_(float x) { return 1.f / (1.f + __expf(-x)); }

struct EpiIn {
    static constexpr bool PERM = true, AFTER_DRAIN = false;
    bf16_t* pxa; bf16_t* pxr;
    __device__ __forceinline__ void operator()(const f32x4 (&acc)[2][2][4][2], const pg8::Unit& u, int wr, int wc, int fr, int fq) const {
        const int row0 = u.pm * 256 + wr * 64 + fr, colt = u.pn * 256 + wc * 32 + 8 * fq;
#pragma unroll
        for (int ai = 0; ai < 2; ++ai)
#pragma unroll
            for (int m = 0; m < 4; ++m) { const size_t row = (size_t)(row0 + ai * 128 + m * 16);
#pragma unroll
                for (int bj = 0; bj < 2; ++bj) { const int col = colt + bj * 128; const f32x4 v0 = acc[ai][bj][m][0], v1 = acc[ai][bj][m][1];
                    u32x4 w; w.x = cvt_pk_bf16(v0[0], v0[1]); w.y = cvt_pk_bf16(v0[2], v0[3]); w.z = cvt_pk_bf16(v1[0], v1[1]); w.w = cvt_pk_bf16(v1[2], v1[3]);
                    if (u.pn < 5) *(u32x4*)(pxa + row * NPXA + col) = w;
                    else { const int cc = col - NPXA; if (cc < NPXR) *(u32x4*)(pxr + row * NPXR + cc) = w; } } }
    }
};
struct EpiF32 {
    static constexpr bool PERM = true, AFTER_DRAIN = false;
    float* O; static constexpr int ldc = DM;
    __device__ __forceinline__ void operator()(const f32x4 (&acc)[2][2][4][2], const pg8::Unit& u, int wr, int wc, int fr, int fq) const {
        const int row0 = u.pm * 256 + wr * 64 + fr, colt = u.pn * 256 + wc * 32 + 8 * fq;
#pragma unroll
        for (int ai = 0; ai < 2; ++ai)
#pragma unroll
            for (int m = 0; m < 4; ++m) { float* rp = O + (size_t)(row0 + ai * 128 + m * 16) * ldc + colt;
#pragma unroll
                for (int bj = 0; bj < 2; ++bj) { *(f32x4*)(rp + bj * 128) = acc[ai][bj][m][0]; *(f32x4*)(rp + bj * 128 + 4) = acc[ai][bj][m][1]; } }
    }
};
struct EpiBf16Out {
    static constexpr bool PERM = true, AFTER_DRAIN = false;
    bf16_t* O;
    __device__ __forceinline__ void operator()(const f32x4 (&acc)[2][2][4][2], const pg8::Unit& u, int wr, int wc, int fr, int fq) const {
        const int row0 = u.pm * 256 + wr * 64 + fr, colt = u.pn * 256 + wc * 32 + 8 * fq;
#pragma unroll
        for (int ai = 0; ai < 2; ++ai)
#pragma unroll
            for (int m = 0; m < 4; ++m) { bf16_t* rp = O + (size_t)(row0 + ai * 128 + m * 16) * DM + colt;
#pragma unroll
                for (int bj = 0; bj < 2; ++bj) { const f32x4 v0 = acc[ai][bj][m][0], v1 = acc[ai][bj][m][1];
                    u32x4 w; w.x = cvt_pk_bf16(v0[0], v0[1]); w.y = cvt_pk_bf16(v0[2], v0[3]); w.z = cvt_pk_bf16(v1[0], v1[1]); w.w = cvt_pk_bf16(v1[2], v1[3]);
                    *(u32x4*)(rp + bj * 128) = w; } }
    }
};
struct EpiSwiglu {
    static constexpr bool PERM = true, AFTER_DRAIN = false;
    bf16_t* O;
    __device__ __forceinline__ void operator()(const f32x4 (&acc)[2][2][4][2], const pg8::Unit& u, int wr, int wc, int fr, int fq) const {
        const int row0 = u.pm * 256 + wr * 64 + fr, col = u.pn * 128 + wc * 32 + 8 * fq;
#pragma unroll
        for (int ai = 0; ai < 2; ++ai)
#pragma unroll
            for (int m = 0; m < 4; ++m) { float r[8];
#pragma unroll
                for (int n = 0; n < 2; ++n)
#pragma unroll
                    for (int j = 0; j < 4; ++j) { const float g = acc[ai][0][m][n][j], up = acc[ai][1][m][n][j]; r[n * 4 + j] = g * __builtin_amdgcn_rcpf(1.f + __expf(-g)) * up; }
                u32x4 w; w.x = cvt_pk_bf16(r[0], r[1]); w.y = cvt_pk_bf16(r[2], r[3]); w.z = cvt_pk_bf16(r[4], r[5]); w.w = cvt_pk_bf16(r[6], r[7]);
                *(u32x4*)(O + (size_t)(row0 + ai * 128 + m * 16) * DFF + col) = w; }
    }
};

__device__ __forceinline__ void modv_task(const Args& a, int task, unsigned char* lds) {
    float* act = (float*)lds; float* red = act + 5 * 1024;
    const int tid = opaque_tid();
    for (int i = tid; i < 5 * 1024; i += NTHR) { const int r = i >> 10, k = i & 1023; const float v = r < 4 ? a.in[I_C][r * 1024 + k] : a.in[I_CCTX][k]; act[i] = v / (1.f + expf(-v)); }
    __syncthreads();
    const int l = task / 48, cb = task % 48, cl = tid & 127, kq = tid >> 7;
    const float* W = a.in[I_WMOD] + (size_t)l * 1024 * 6144 + cb * 128 + cl;
    float a0 = 0.f, a1 = 0.f, a2 = 0.f, a3 = 0.f, a4 = 0.f;
    for (int k0 = kq * 256; k0 < kq * 256 + 256; k0 += 16) { float wv[16];
#pragma unroll
        for (int u = 0; u < 16; ++u) wv[u] = W[(size_t)(k0 + u) * 6144];
#pragma unroll
        for (int u = 0; u < 16; ++u) { const int k = k0 + u; const float w = wv[u]; a0 += act[k] * w; a1 += act[1024 + k] * w; a2 += act[2048 + k] * w; a3 += act[3072 + k] * w; a4 += act[4096 + k] * w; } }
    red[(kq * 5 + 0) * 128 + cl] = a0; red[(kq * 5 + 1) * 128 + cl] = a1; red[(kq * 5 + 2) * 128 + cl] = a2; red[(kq * 5 + 3) * 128 + cl] = a3; red[(kq * 5 + 4) * 128 + cl] = a4;
    __syncthreads();
    float* modv = (float*)(a.ws + WS_MODV);
    for (int i = tid; i < 640; i += NTHR) { const int r = i >> 7, c2 = i & 127;
        const float s = red[(0 * 5 + r) * 128 + c2] + red[(1 * 5 + r) * 128 + c2] + red[(2 * 5 + r) * 128 + c2] + red[(3 * 5 + r) * 128 + c2];
        modv[(size_t)(l * 5 + r) * 6144 + cb * 128 + c2] = s + a.in[I_BMOD][l * 6144 + cb * 128 + c2]; }
    __syncthreads();
}
__device__ __forceinline__ void rope_task(const Args& a, int task) {
    const int idx = task * NTHR + opaque_tid(); const int t = idx >> 5, j = idx & 31, axis = j >> 4, f = j & 15;
    const float pos = (float)(axis == 0 ? (t >> 6) : (t & 63));
    const float inv = powf(10000.0f, -(float)f / 16.0f);
    const float ang = pos * inv;
    float* rc = (float*)(a.ws + WS_ROPE); float* rs = rc + TL * 32;
    rc[idx] = cosf(ang); rs[idx] = sinf(ang);
}
constexpr int WCONV_TASKS = 640 + 256 + 1408 + 704;
struct WconvDesc { const float* src; bf16_t* dst; int Ksz, Nsrc, kt, n0, sc0; bool zero; };
__device__ __forceinline__ WconvDesc wconv_decode(const Args& a, int l, int task) {
    WconvDesc D; D.zero = false;
    if (task < 640) { const int nt = task >> 4; D.kt = task & 15; D.Ksz = 1024; D.Nsrc = INC; D.src = a.in[I_WIN] + (size_t)l * 1024 * INC; D.dst = (bf16_t*)(a.ws + wbase(l)); D.n0 = nt * 64; const int n0 = D.n0;
        if (n0 < 1024) D.sc0 = n0; else if (n0 < 1280) D.sc0 = 1408 + (n0 - 1024); else if (n0 < 1664) D.sc0 = 1024 + (n0 - 1280); else if (n0 < 2432) D.sc0 = n0; else { D.sc0 = 0; D.zero = true; } }
    else if (task < 896) { const int t = task - 640; const int nt = t >> 4; D.kt = t & 15; D.Ksz = 1024; D.Nsrc = 1024; D.src = a.in[I_WOUT] + (size_t)l * 1024 * 1024; D.dst = (bf16_t*)(a.ws + wbase(l) + WO_OUT); D.n0 = nt * 64; D.sc0 = D.n0; }
    else if (task < 2304) { const int t = task - 896; const int nt = t >> 4; D.kt = t & 15; D.Ksz = 1024; D.Nsrc = 2 * DFF; D.src = a.in[I_WGU] + (size_t)l * 1024 * 2 * DFF; D.dst = (bf16_t*)(a.ws + wbase(l) + WO_GU); D.n0 = nt * 64;
        const int tt = D.n0 >> 8, bj = (D.n0 >> 7) & 1, jj = D.n0 & 127; D.sc0 = bj * DFF + tt * 128 + jj; }
    else { const int t = task - 2304; const int nt = t / 44; D.kt = t % 44; D.Ksz = DFF; D.Nsrc = 1024; D.src = a.in[I_WDN] + (size_t)l * DFF * 1024; D.dst = (bf16_t*)(a.ws + wbase(l) + WO_DN); D.n0 = nt * 64; D.sc0 = D.n0; }
    return D;
}
__device__ __forceinline__ void wconv_issue(f32x4 (&v)[2], const WconvDesc& D, int tid) {
    const int c4 = tid & 15;
#pragma unroll
    for (int h = 0; h < 2; ++h) { const int kr = (tid >> 4) + 32 * h; v[h] = (f32x4){0.f, 0.f, 0.f, 0.f};
        if (!D.zero) v[h] = *(const f32x4*)(D.src + (size_t)(D.kt * 64 + kr) * D.Nsrc + D.sc0 + c4 * 4); }
}
__device__ __forceinline__ void wconv_loop(const Args& a, int l, int first, int stride, unsigned char* lds) {
    if (first >= WCONV_TASKS) return;
    const int tid = opaque_tid();
    float* tile = (float*)lds;
    f32x4 v[2]; WconvDesc D = wconv_decode(a, l, first); wconv_issue(v, D, tid);
    for (int task = first; task < WCONV_TASKS; task += stride) {
        { const int c4 = tid & 15;
#pragma unroll
          for (int h = 0; h < 2; ++h) { const int kr = (tid >> 4) + 32 * h;
              tile[kr * 65 + c4 * 4 + 0] = v[h][0]; tile[kr * 65 + c4 * 4 + 1] = v[h][1]; tile[kr * 65 + c4 * 4 + 2] = v[h][2]; tile[kr * 65 + c4 * 4 + 3] = v[h][3]; } }
        __syncthreads();
        const WconvDesc C = D;
        if (task + stride < WCONV_TASKS) { D = wconv_decode(a, l, task + stride); wconv_issue(v, D, tid); }
        { const int n = tid >> 3, k8 = tid & 7; float r[8];
#pragma unroll
          for (int i = 0; i < 8; ++i) r[i] = tile[(k8 * 8 + i) * 65 + n];
          u32x4 w; w.x = cvt_pk_bf16(r[0], r[1]); w.y = cvt_pk_bf16(r[2], r[3]); w.z = cvt_pk_bf16(r[4], r[5]); w.w = cvt_pk_bf16(r[6], r[7]);
          *(u32x4*)(C.dst + (size_t)(C.n0 + n) * C.Ksz + C.kt * 64 + k8 * 8) = w; }
        __syncthreads();
    }
}

struct RowRegs { f32x4 xv[4], yv[4]; };
__device__ __forceinline__ void row_load(RowRegs& R, int row, int lane, const bf16_t* y, const float* ypart, int nsl, const void* xl_src, const void* xc_src, bool xbf) {
    if (xbf) { const bf16_t* xs = row < ML ? (const bf16_t*)xl_src + (size_t)row * DM : (const bf16_t*)xc_src + (size_t)(row - ML) * DM;
#pragma unroll
        for (int j = 0; j < 4; ++j) R.xv[j] = bf4_to_f32(*(const u32x2*)(xs + j * 256 + lane * 4)); }
    else { const float* xs = row < ML ? (const float*)xl_src + (size_t)row * DM : (const float*)xc_src + (size_t)(row - ML) * DM;
#pragma unroll
        for (int j = 0; j < 4; ++j) R.xv[j] = *(const f32x4*)(xs + j * 256 + lane * 4); }
    if (y) {
        if (row < ML) {
#pragma unroll
            for (int j = 0; j < 4; ++j) R.yv[j] = bf4_to_f32(*(const u32x2*)(y + (size_t)row * DM + j * 256 + lane * 4));
        } else {
#pragma unroll
            for (int j = 0; j < 4; ++j) R.yv[j] = (f32x4){0.f, 0.f, 0.f, 0.f};
#pragma unroll
            for (int sl = 0; sl < 7; ++sl) if (sl < nsl) {
#pragma unroll
                for (int j = 0; j < 4; ++j) R.yv[j] += *(const f32x4*)(ypart + ((size_t)sl * MC + (row - ML)) * DM + j * 256 + lane * 4); }
        }
    }
}
__device__ __forceinline__ void row_process(const Args& a, RowRegs& C, int row, int lane, bool has_y, void* xl_dst, void* xc_dst, bool obf,
                         const f32x4 (&gyv)[4], int l_gate, int gate_idx, bool do_h, const f32x4 (&ghv)[4], int l_h, int shift_idx, int scale_idx, f32x4 (&gtv)[4], f32x4 (&s1v)[4], f32x4 (&s2v)[4], int& cur) {
    const float* modv = (const float*)(a.ws + WS_MODV); bf16_t* hbuf = (bf16_t*)(a.ws + WS_HBUF);
    const int mrow = row < ML ? (row >> 12) : 4;
    if (mrow != cur) { cur = mrow;
    if (has_y) { const float* gate = modv + (size_t)(l_gate * 5 + mrow) * 6144 + gate_idx * 1024;
#pragma unroll
        for (int j = 0; j < 4; ++j) gtv[j] = *(const f32x4*)(gate + j * 256 + lane * 4); }
    if (do_h) { const float* sh = modv + (size_t)(l_h * 5 + mrow) * 6144 + shift_idx * 1024; const float* sc = modv + (size_t)(l_h * 5 + mrow) * 6144 + scale_idx * 1024;
#pragma unroll
        for (int j = 0; j < 4; ++j) { s1v[j] = *(const f32x4*)(sh + j * 256 + lane * 4); s2v[j] = *(const f32x4*)(sc + j * 256 + lane * 4); } } }
    if (has_y) {
        float ss = 0.f;
#pragma unroll
        for (int j = 0; j < 4; ++j) ss += C.yv[j][0] * C.yv[j][0] + C.yv[j][1] * C.yv[j][1] + C.yv[j][2] * C.yv[j][2] + C.yv[j][3] * C.yv[j][3];
        ss = wave_sum(ss); const float rstd = rsqrtf(ss * (1.f / 1024.f) + 1e-6f);
#pragma unroll
        for (int j = 0; j < 4; ++j) C.xv[j] = C.xv[j] + gtv[j] * (C.yv[j] * rstd * gyv[j]);
        if (obf) { bf16_t* xd = row < ML ? (bf16_t*)xl_dst + (size_t)row * DM : (bf16_t*)xc_dst + (size_t)(row - ML) * DM;
#pragma unroll
            for (int j = 0; j < 4; ++j) { const u32x2 w = f32_to_bf4(C.xv[j]); *(u32x2*)(xd + j * 256 + lane * 4) = w; C.xv[j] = bf4_to_f32(w); } }
        else { float* xd = row < ML ? (float*)xl_dst + (size_t)row * DM : (float*)xc_dst + (size_t)(row - ML) * DM;
#pragma unroll
            for (int j = 0; j < 4; ++j) *(f32x4*)(xd + j * 256 + lane * 4) = C.xv[j]; }
    }
    if (do_h) {
        float ss = 0.f;
#pragma unroll
        for (int j = 0; j < 4; ++j) ss += C.xv[j][0] * C.xv[j][0] + C.xv[j][1] * C.xv[j][1] + C.xv[j][2] * C.xv[j][2] + C.xv[j][3] * C.xv[j][3];
        ss = wave_sum(ss); const float rstd = rsqrtf(ss * (1.f / 1024.f) + 1e-6f);
#pragma unroll
        for (int j = 0; j < 4; ++j) { const f32x4 h = (C.xv[j] * rstd * ghv[j]) * (1.f + s2v[j]) + s1v[j];
            u32x2 w; w.x = cvt_pk_bf16(h[0], h[1]); w.y = cvt_pk_bf16(h[2], h[3]);
            *(u32x2*)(hbuf + (size_t)row * DM + j * 256 + lane * 4) = w; }
    }
}
__device__ __forceinline__ void row_pass(const Args& a, int mrows, const bf16_t* y, const float* ypart, int nsl, const void* xl_src, const void* xc_src, bool xbf, void* xl_dst, void* xc_dst, bool obf,
                         const float* gy, int l_gate, int gate_idx, bool do_h, const float* gh, int l_h, int shift_idx, int scale_idx) {
    const int tid = opaque_tid(); const int lane = tid & 63, wave = tid >> 6;
    const int stride = gridDim.x * 8;
    int row = blockIdx.x * 8 + wave;
    f32x4 gyv[4], ghv[4];
#pragma unroll
    for (int j = 0; j < 4; ++j) { gyv[j] = y ? *(const f32x4*)(gy + j * 256 + lane * 4) : (f32x4){0.f, 0.f, 0.f, 0.f}; ghv[j] = do_h ? *(const f32x4*)(gh + j * 256 + lane * 4) : (f32x4){0.f, 0.f, 0.f, 0.f}; }
    f32x4 gtv[4], s1v[4], s2v[4]; int cur = -1;
#pragma unroll
    for (int j = 0; j < 4; ++j) { gtv[j] = (f32x4){0.f, 0.f, 0.f, 0.f}; s1v[j] = gtv[j]; s2v[j] = gtv[j]; }
    RowRegs N0, N1;
    if (row < mrows) row_load(N0, row, lane, y, ypart, nsl, xl_src, xc_src, xbf);
    if (row + stride < mrows) row_load(N1, row + stride, lane, y, ypart, nsl, xl_src, xc_src, xbf);
    for (; row < mrows; row += 2 * stride) {
        RowRegs C0 = N0, C1 = N1;
        const bool two = row + stride < mrows;
        if (row + 2 * stride < mrows) row_load(N0, row + 2 * stride, lane, y, ypart, nsl, xl_src, xc_src, xbf);
        if (row + 3 * stride < mrows) row_load(N1, row + 3 * stride, lane, y, ypart, nsl, xl_src, xc_src, xbf);
        row_process(a, C0, row, lane, y != nullptr, xl_dst, xc_dst, obf, gyv, l_gate, gate_idx, do_h, ghv, l_h, shift_idx, scale_idx, gtv, s1v, s2v, cur);
        if (two) row_process(a, C1, row + stride, lane, y != nullptr, xl_dst, xc_dst, obf, gyv, l_gate, gate_idx, do_h, ghv, l_h, shift_idx, scale_idx, gtv, s1v, s2v, cur);
    }
}


__device__ __forceinline__ void lwconv_task(const Args& a, int l, int frag) {
    const int tid = opaque_tid(); const int lane = tid >> 3, j = tid & 7;
    const float* W; int ct, ks;
    if (frag < 128) { const int m = frag >> 6, rem = frag & 63, d = rem >> 5; ct = (rem >> 1) & 15; ks = rem & 1; W = (m == 0 ? a.in[I_W2] : a.in[I_A2]) + (size_t)(l * 2 + d) * 64 * 256; }
    else { const int rem = frag - 128; ct = rem >> 2; ks = rem & 3; W = a.in[I_G2] + (size_t)l * 128 * 256; }
    const int r = ks * 32 + (lane >> 4) * 8 + j, c = ct * 16 + (lane & 15);
    ((bf16_t*)(a.ws + lwbase(l)))[(size_t)frag * 512 + lane * 8 + j] = f2bf(W[r * 256 + c]);
}
__device__ __forceinline__ bf16x8 lds_afrag(const float* p) {
    const f32x4 x0 = *(const f32x4*)p, x1 = *(const f32x4*)(p + 4);
    u32x4 w; w.x = cvt_pk_bf16(x0[0], x0[1]); w.y = cvt_pk_bf16(x0[2], x0[3]); w.z = cvt_pk_bf16(x1[0], x1[1]); w.w = cvt_pk_bf16(x1[2], x1[3]); return __builtin_bit_cast(bf16x8, w);
}
struct PrepRegs { u32x2 fraw[9], sraw[9]; };
__device__ __forceinline__ void prep_issue_loads(PrepRegs& R, const bf16_t* pxr, int tile, int tid) {
#pragma unroll
    for (int it = 0; it < 9; ++it) {
        const int i = tid + it * NTHR; const int tk = i / (NPXR / 4), j = (i - tk * (NPXR / 4)) * 4; const int row = tile * 16 + tk;
        R.fraw[it] = *(const u32x2*)(pxr + (size_t)row * NPXR + j);
        int nrow; bool valid;
        if (row < ML) { const int t = row & 4095; const int q = j < 384 ? j / 96 : (j - 384) / 192;
            if (q == 0) { valid = (t & 63) > 0; nrow = row - 1; } else if (q == 1) { valid = (t & 63) < 63; nrow = row + 1; }
            else if (q == 2) { valid = t >= 64; nrow = row - 64; } else { valid = t < TL - 64; nrow = row + 64; } }
        else { const int c = (row - ML) & 255; const int hf = j < 384 ? j / 192 : (j - 384) / 384;
            if (hf == 0) { valid = c > 0; nrow = row - 1; } else { valid = c < 255; nrow = row + 1; } }
        R.sraw[it] = (u32x2){0u, 0u}; if (valid) R.sraw[it] = *(const u32x2*)(pxr + (size_t)nrow * NPXR + j);
    }
}
__device__ __forceinline__ void rwkv_prep_tile(const Args& a, int l, int tile, int tile_next, PrepRegs& R, unsigned char* lds) {
    float* mx = (float*)lds; float* rinv = mx + 16 * NPXR;
    const int tid = opaque_tid(), lane = tid & 63, wave = tid >> 6, fr = lane & 15, quad = lane >> 4;
    const bf16_t* pxr = (const bf16_t*)(a.ws + WS_PXR);
    const float* mu = a.in[I_MU] + l * NPXR;
    unsigned char* prep = a.ws + WS_PREP;
    float* PW = (float*)(prep + PREP_W); float* PKA = (float*)(prep + PREP_KA); bf16_t* PKD = (bf16_t*)(prep + PREP_KD); float* PKK = (float*)(prep + PREP_KK);
    bf16_t* PR = (bf16_t*)(prep + PREP_R); bf16_t* PV = (bf16_t*)(prep + PREP_V); bf16_t* PG = (bf16_t*)(prep + PREP_G);
    const size_t row0 = (size_t)tile * 16;
    {
#pragma unroll
        for (int it = 0; it < 9; ++it) {
            const int i = tid + it * NTHR; const int tk = i / (NPXR / 4), j = (i - tk * (NPXR / 4)) * 4; const int row = tile * 16 + tk;
            const f32x4 f = bf4_to_f32(R.fraw[it]), sv = bf4_to_f32(R.sraw[it]);
            const f32x4 muv = *(const f32x4*)(mu + j);
            f32x4 m = f + (sv - f) * muv;
            if (j >= 256 && j < 384) { for (int e = 0; e < 4; ++e) m[e] = __builtin_amdgcn_rcpf(1.f + __expf(-m[e])); }
            else if (j >= 896 && j < 1024) { for (int e = 0; e < 4; ++e) m[e] = 1.f - 2.f * __builtin_amdgcn_rcpf(1.f + __expf(2.f * m[e])); }
            *(f32x4*)(mx + tk * NPXR + j) = m;
            if (j < 256) *(u32x2*)(PR + (size_t)row * 256 + j) = f32_to_bf4(m);
            else if (j >= 640 && j < 896) *(u32x2*)(PV + (size_t)row * 256 + (j - 640)) = f32_to_bf4(m);
        }
    }
    __syncthreads();
    {
#pragma unroll
        for (int tt = 0; tt < 2; ++tt) { const int tk = wave * 2 + tt;
#pragma unroll
            for (int hh = 0; hh < 4; ++hh) { const float x = mx[tk * NPXR + 384 + hh * 64 + lane] * a.in[I_KK][l * 256 + hh * 64 + lane];
                const float ss = wave_sum(x * x); const float ri = fminf(__builtin_amdgcn_rsqf(ss), 1e12f);
                PKK[(row0 + tk) * 256 + hh * 64 + lane] = x * ri; if (lane == 0) rinv[tk * 4 + hh] = ri; } }
    }
    __syncthreads();
    if (tile_next >= 0) prep_issue_loads(R, pxr, tile_next, tid);
    const bf16_t* lw = (const bf16_t*)(a.ws + lwbase(l));
    const size_t orow = row0 + fr;
#pragma unroll 1
    for (int cc = 0; cc < 2; ++cc) {
        const int ct = wave * 2 + cc; const int c0 = ct * 16 + quad * 4; const int hh = ct >> 2;
        const f32x4 kx = *(const f32x4*)(mx + fr * NPXR + 384 + c0);
        const f32x4 kkp = *(const f32x4*)(a.in[I_KK] + l * 256 + c0), kap = *(const f32x4*)(a.in[I_KA] + l * 256 + c0);
        const float ri = rinv[fr * 4 + hh];
        bf16x8 wg[4], ww[2][2], wa[2][2]; f32x4 w0p2[2], a0p2[2];
#pragma unroll
        for (int ks = 0; ks < 4; ++ks) wg[ks] = *(const bf16x8*)(lw + (size_t)(128 + ct * 4 + ks) * 512 + lane * 8);
#pragma unroll
        for (int d = 0; d < 2; ++d) {
#pragma unroll
            for (int ks = 0; ks < 2; ++ks) { ww[d][ks] = *(const bf16x8*)(lw + (size_t)((d * 16 + ct) * 2 + ks) * 512 + lane * 8); wa[d][ks] = *(const bf16x8*)(lw + (size_t)(64 + (d * 16 + ct) * 2 + ks) * 512 + lane * 8); }
            w0p2[d] = *(const f32x4*)(a.in[I_W0] + (l * 2 + d) * 256 + c0); a0p2[d] = *(const f32x4*)(a.in[I_A0] + (l * 2 + d) * 256 + c0); }
        {
            f32x4 acc = {0.f, 0.f, 0.f, 0.f};
#pragma unroll
            for (int ks = 0; ks < 4; ++ks) { const bf16x8 wf = wg[ks]; const bf16x8 af = lds_afrag(mx + fr * NPXR + 256 + ks * 32 + quad * 8);
                acc = __builtin_amdgcn_mfma_f32_16x16x32_bf16(wf, af, acc, 0, 0, 0); }
            *(u32x2*)(PG + orow * 256 + c0) = f32_to_bf4(acc);
        }
#pragma unroll
        for (int d = 0; d < 2; ++d) {
            f32x4 accw = {0.f, 0.f, 0.f, 0.f}, acca = {0.f, 0.f, 0.f, 0.f};
#pragma unroll
            for (int ks = 0; ks < 2; ++ks) {
                const bf16x8 wf = ww[d][ks]; const bf16x8 af = lds_afrag(mx + fr * NPXR + 896 + d * 64 + ks * 32 + quad * 8);
                accw = __builtin_amdgcn_mfma_f32_16x16x32_bf16(wf, af, accw, 0, 0, 0);
                const bf16x8 wf2 = wa[d][ks]; const bf16x8 af2 = lds_afrag(mx + fr * NPXR + 1024 + d * 64 + ks * 32 + quad * 8);
                acca = __builtin_amdgcn_mfma_f32_16x16x32_bf16(wf2, af2, acca, 0, 0, 0); }
            const f32x4 w0p = w0p2[d], a0p = a0p2[d];
            f32x4 wv, kav, kdv;
#pragma unroll
            for (int e = 0; e < 4; ++e) { const float z = w0p[e] + accw[e];
                wv[e] = __expf(-0.6065306597126334f * __builtin_amdgcn_rcpf(1.f + __expf(-z)));
                const float av = __builtin_amdgcn_rcpf(1.f + __expf(-(a0p[e] + acca[e])));
                kav[e] = kx[e] * kkp[e] * ri * av; kdv[e] = kx[e] * (1.f + (av - 1.f) * kap[e]); }
            *(f32x4*)(PW + (orow * 2 + d) * 256 + c0) = wv; *(f32x4*)(PKA + (orow * 2 + d) * 256 + c0) = kav; *(u32x2*)(PKD + (orow * 2 + d) * 256 + c0) = f32_to_bf4(kdv);
        }
    }
    __syncthreads();
}

__device__ __forceinline__ unsigned gl_ld(const unsigned* p) { return __hip_atomic_load(p, __ATOMIC_RELAXED, __HIP_MEMORY_SCOPE_AGENT); }
__device__ __forceinline__ void gl_add(unsigned* p, unsigned v) { (void)__hip_atomic_fetch_add(p, v, __ATOMIC_RELAXED, __HIP_MEMORY_SCOPE_AGENT); }
#ifndef PREP_EARLY_TILES
#define PREP_EARLY_TILES 512
#endif
constexpr int PREP_TILES = MT / 16, PREP_EARLY = PREP_EARLY_TILES, PREP_LATE_ROUNDS = (PREP_TILES - PREP_EARLY + 127) / 128;
constexpr int CW_PREP = 4096;
static_assert(PREP_LATE_ROUNDS <= 8 && PREP_EARLY % 256 == 0 && PREP_EARLY >= 64, "prep split");
__device__ __forceinline__ int prep_tile_of(int o) {
    if (o < 64) return ML / 16 + o;
    const int q = o - 64, b = q & 3, p = q >> 2, i = p >> 1; return b * 256 + ((p & 1) ? 255 - i : i);
}
__device__ __forceinline__ void prep_publish(unsigned* cnt) {
    asm volatile("s_waitcnt vmcnt(0)" ::: "memory");
    __syncthreads();
    if (threadIdx.x == 0) { __builtin_amdgcn_fence(__ATOMIC_RELEASE, "agent"); asm volatile("s_waitcnt vmcnt(0)" ::: "memory"); gl_add(cnt, 1u); }
}
__device__ __forceinline__ void prep_wait_for_chunk(const unsigned* cnt_layer, int ck, int& rd) {
    if (ck < 16 || rd >= PREP_LATE_ROUNDS) return;
    const int ft = ck - 16; const int i = ft < 128 ? ft : 255 - ft; const int oneed = 64 + 8 * i + 7;
    if (oneed < PREP_EARLY) return;
    const int r = (oneed - PREP_EARLY) >> 7;
    if (rd > r) return;
    while (rd <= r) {
        const unsigned expect = (unsigned)((PREP_TILES - PREP_EARLY - rd * 128) < 128 ? (PREP_TILES - PREP_EARLY - rd * 128) : 128);
        unsigned sp = 0; while (gl_ld(cnt_layer + 64 * rd) < expect) { __builtin_amdgcn_s_sleep(2); if (++sp > (1u << 22)) break; }
        ++rd;
    }
    __builtin_amdgcn_fence(__ATOMIC_ACQUIRE, "agent"); asm volatile("s_waitcnt vmcnt(0)" ::: "memory");
}
constexpr int SC_STEPS = 16, SC_NCH = (CL + TL) / SC_STEPS, SC_OPB = 5 * SC_STEPS * 256 + SC_STEPS * 64, SC_PB = SC_STEPS * 16 * 64;
__device__ __forceinline__ int scan_row(int b, int d, int s) {
    if (d == 0) return s < CL ? ML + b * CL + s : b * TL + (s - CL);
    return s < CL ? ML + b * CL + (CL - 1 - s) : b * TL + (TL - 1 - (s - CL));
}
typedef float f32x2 __attribute__((ext_vector_type(2)));
struct ScanStage { f32x4 w, kk, ka; u32x2 kd, r, v; };
struct ScanPtrs { const float *PW, *PKA, *PKK; const bf16_t *PKD, *PR, *PV; float* YS; int b, h, d, rgp; };
__device__ __forceinline__ void scan_issue_loads(ScanStage& R, const ScanPtrs& P, int ck, int lt) {
    const int st = lt >> 4, q4 = lt & 15; const size_t row = (size_t)scan_row(P.b, P.d, ck * SC_STEPS + st); const int co = P.h * 64 + q4 * 4;
    R.w = *(const f32x4*)(P.PW + (row * 2 + P.d) * 256 + co); R.kd = *(const u32x2*)(P.PKD + (row * 2 + P.d) * 256 + co); R.kk = *(const f32x4*)(P.PKK + row * 256 + co);
    R.ka = *(const f32x4*)(P.PKA + (row * 2 + P.d) * 256 + co); R.r = *(const u32x2*)(P.PR + row * 256 + co);
    { const int lv = lt & 63; const size_t rowV = (size_t)scan_row(P.b, P.d, ck * SC_STEPS + (lv >> 2)); R.v = *(const u32x2*)(P.PV + rowV * 256 + P.h * 64 + P.rgp * 16 + (lv & 3) * 4); }
}
__device__ __forceinline__ void scan_store_lds(const ScanStage& R, unsigned char* buf, int lt) {
    const int st = lt >> 4, q4 = lt & 15;
    unsigned char* p = buf + st * 256 + q4 * 16;
    *(f32x4*)(p) = R.w; *(f32x4*)(p + SC_STEPS * 256) = bf4_to_f32(R.kd); *(f32x4*)(p + 2 * SC_STEPS * 256) = R.kk; *(f32x4*)(p + 3 * SC_STEPS * 256) = R.ka; *(f32x4*)(p + 4 * SC_STEPS * 256) = bf4_to_f32(R.r);
    if (lt < 64) { const f32x4 vv = bf4_to_f32(R.v); float* vb = (float*)(buf + 5 * SC_STEPS * 256) + (lt & 3) * 4 * SC_STEPS + (lt >> 2);
        vb[0] = vv[0]; vb[SC_STEPS] = vv[1]; vb[2 * SC_STEPS] = vv[2]; vb[3 * SC_STEPS] = vv[3]; }
}
__device__ __forceinline__ void scan_reduce_y(const ScanPtrs& P, const unsigned char* pb, int ck, int lt) {
    const int st = lt >> 4, row = lt & 15; const float* p = (const float*)(pb + (st * 16 + row) * 64);
    const f32x4 p0 = *(const f32x4*)p, p1 = *(const f32x4*)(p + 4), p2 = *(const f32x4*)(p + 8), p3 = *(const f32x4*)(p + 12);
    const f32x4 q = (p0 + p1) + (p2 + p3);
    const size_t grow = (size_t)scan_row(P.b, P.d, ck * SC_STEPS + st);
    P.YS[(grow * 2 + P.d) * 256 + P.h * 64 + P.rgp * 16 + row] = (q[0] + q[1]) + (q[2] + q[3]);
}
struct ScanOps { f32x4 w4, kd4, kk4, ka4, r4; };
__device__ __forceinline__ void scan_ld_ops(ScanOps& o, const unsigned char* bp, const unsigned char* vp, int st) {
    o.w4 = *(const f32x4*)(bp + st * 256); o.kd4 = *(const f32x4*)(bp + SC_STEPS * 256 + st * 256); o.kk4 = *(const f32x4*)(bp + 2 * SC_STEPS * 256 + st * 256);
    o.ka4 = *(const f32x4*)(bp + 3 * SC_STEPS * 256 + st * 256); o.r4 = *(const f32x4*)(bp + 4 * SC_STEPS * 256 + st * 256);
    (void)vp;
}
#define SCAN_BAR() asm volatile("s_waitcnt lgkmcnt(0)\n\ts_barrier" ::: "memory")
__device__ __forceinline__ void scan_task(const Args& a, int task, const unsigned* prep_cnt, unsigned char* lds) {
    const int tid = opaque_tid(), lane = tid & 63, wave = tid >> 6;
    const int xcd = task & 7, kx = task >> 3; const int chain = xcd * 4 + (kx >> 2); ScanPtrs P;
    P.rgp = kx & 3; P.b = chain >> 3; P.h = (chain >> 1) & 3; P.d = chain & 1;
    unsigned char* prep = a.ws + WS_PREP;
    P.PW = (const float*)(prep + PREP_W); P.PKA = (const float*)(prep + PREP_KA); P.PKD = (const bf16_t*)(prep + PREP_KD); P.PKK = (const float*)(prep + PREP_KK);
    P.PR = (const bf16_t*)(prep + PREP_R); P.PV = (const bf16_t*)(prep + PREP_V); P.YS = (float*)(a.ws + WS_YS);
    unsigned char* pbase = lds + 2 * SC_OPB;
    __syncthreads();
    if (wave >= 4) {
        const int lt = tid - 256; ScanStage R0, R1, R2;
        int rd = 0;
        scan_issue_loads(R0, P, 0, lt); scan_store_lds(R0, lds, lt);
        scan_issue_loads(R1, P, 1, lt); scan_issue_loads(R2, P, 2, lt); scan_issue_loads(R0, P, 3, lt);
        SCAN_BAR();
#define SCAN_LOADER_IT(CK, RS) do { const int ck_ = (CK); if (ck_ < SC_NCH) { \
            if (ck_ + 1 < SC_NCH) scan_store_lds(RS, lds + ((ck_ + 1) & 1) * SC_OPB, lt); \
            if (ck_ + 4 < SC_NCH) { prep_wait_for_chunk(prep_cnt, ck_ + 4, rd); scan_issue_loads(RS, P, ck_ + 4, lt); } \
            if (ck_ >= 1) scan_reduce_y(P, pbase + ((ck_ - 1) & 1) * SC_PB, ck_ - 1, lt); \
            SCAN_BAR(); } } while (0)
        for (int ck = 0; ck < SC_NCH; ck += 3) { SCAN_LOADER_IT(ck, R1); SCAN_LOADER_IT(ck + 1, R2); SCAN_LOADER_IT(ck + 2, R0); }
#undef SCAN_LOADER_IT
        scan_reduce_y(P, pbase + ((SC_NCH - 1) & 1) * SC_PB, SC_NCH - 1, lt);
    } else {
        const int rw = lane >> 4, kq = lane & 15, rowA = wave * 4 + rw;
        f32x2 SL = {0.f, 0.f}, SH = {0.f, 0.f};
        SCAN_BAR();
        for (int ck = 0; ck < SC_NCH; ++ck) {
            const unsigned char* bp = lds + (ck & 1) * SC_OPB + kq * 16;
            const unsigned char* vp = lds + (ck & 1) * SC_OPB + 5 * SC_STEPS * 256 + rowA * (SC_STEPS * 4);
            f32x4 vq[4];
#pragma unroll
            for (int q = 0; q < 4; ++q) vq[q] = *(const f32x4*)(vp + q * 16);
            float* pw = (float*)(pbase + (ck & 1) * SC_PB) + rowA * 16 + kq;
            ScanOps o0, o1, o2;
            scan_ld_ops(o0, bp, vp, 0); scan_ld_ops(o1, bp, vp, 1);
#pragma unroll
            for (int st = 0; st < SC_STEPS; ++st) {
                scan_ld_ops(o2, bp, vp, st + 2 < SC_STEPS ? st + 2 : SC_STEPS - 1);
                const f32x2 wlo = {o0.w4[0], o0.w4[1]}, whi = {o0.w4[2], o0.w4[3]}, kdlo = {o0.kd4[0], o0.kd4[1]}, kdhi = {o0.kd4[2], o0.kd4[3]}, kklo = {o0.kk4[0], o0.kk4[1]}, kkhi = {o0.kk4[2], o0.kk4[3]},
                            kalo = {o0.ka4[0], o0.ka4[1]}, kahi = {o0.ka4[2], o0.ka4[3]}, rlo = {o0.r4[0], o0.r4[1]}, rhi = {o0.r4[2], o0.r4[3]};
                const f32x2 dp = SL * kklo + SH * kkhi;
                const float sa = row16_sum(dp[0] + dp[1]);
                const float va = vq[st >> 2][st & 3];
                const f32x2 TL = SL * wlo + kdlo * va, TH = SH * whi + kdhi * va;
                SL = TL - kalo * sa; SH = TH - kahi * sa;
                const f32x2 yy = SL * rlo + SH * rhi;
                pw[st * 256] = yy[0] + yy[1];
                o0 = o1; o1 = o2;
            }
            SCAN_BAR();
        }
    }
}

struct RoRegs { float y0, y1; unsigned short r, kd0, kd1, v, g; };
__device__ __forceinline__ void ro_load(RoRegs& R, size_t row, int c, const float* YS, const bf16_t* PR, const bf16_t* PKD, const bf16_t* PV, const bf16_t* PG) {
    R.y0 = YS[(row * 2 + 0) * 256 + c]; R.y1 = YS[(row * 2 + 1) * 256 + c]; R.r = PR[row * 256 + c]; R.kd0 = PKD[(row * 2 + 0) * 256 + c]; R.kd1 = PKD[(row * 2 + 1) * 256 + c];
    R.v = PV[row * 256 + c]; R.g = PG[row * 256 + c];
}
__device__ __forceinline__ void rwkv_out(const Args& a, int l, int mrows) {
    const int tid = opaque_tid(), c = tid & 255;
    unsigned char* prep = a.ws + WS_PREP;
    const bf16_t* PKD = (const bf16_t*)(prep + PREP_KD); const bf16_t* PR = (const bf16_t*)(prep + PREP_R); const bf16_t* PV = (const bf16_t*)(prep + PREP_V); const bf16_t* PG = (const bf16_t*)(prep + PREP_G);
    const float* YS = (const float*)(a.ws + WS_YS); bf16_t* hbuf = (bf16_t*)(a.ws + WS_HBUF);
    const float lg = a.in[I_LNXG][l * 256 + c], lb = a.in[I_LNXB][l * 256 + c], rk = a.in[I_RK][l * 256 + c];
    const size_t stride = (size_t)gridDim.x * 2;
    size_t row = (size_t)blockIdx.x * 2 + (tid >> 8);
    RoRegs N0, N1; N1.y0 = 0.f; N1.y1 = 0.f; N1.r = 0; N1.kd0 = 0; N1.kd1 = 0; N1.v = 0; N1.g = 0;
    if (row < (size_t)mrows) ro_load(N0, row, c, YS, PR, PKD, PV, PG);
    if (row + stride < (size_t)mrows) ro_load(N1, row + stride, c, YS, PR, PKD, PV, PG);
    for (; row < (size_t)mrows; row += 2 * stride) {
        const RoRegs C0 = N0, C1 = N1; const bool two = row + stride < (size_t)mrows;
        if (row + 2 * stride < (size_t)mrows) ro_load(N0, row + 2 * stride, c, YS, PR, PKD, PV, PG);
        if (row + 3 * stride < (size_t)mrows) ro_load(N1, row + 3 * stride, c, YS, PR, PKD, PV, PG);
        const float ya = C0.y0 + C0.y1, yb = C1.y0 + C1.y1;
        const float ma = wave_sum(ya) * (1.f / 64.f), mb = wave_sum(yb) * (1.f / 64.f);
        const float da = ya - ma, db = yb - mb;
        const float va = wave_sum(da * da) * (1.f / 64.f), vb = wave_sum(db * db) * (1.f / 64.f);
        const float ba = wave_sum(bf2f(C0.r) * (bf2f(C0.kd0) + bf2f(C0.kd1)) * rk), bb = wave_sum(bf2f(C1.r) * (bf2f(C1.kd0) + bf2f(C1.kd1)) * rk);
        const float oa = (da * rsqrtf(va + 64e-5f) * lg + lb + ba * bf2f(C0.v)) * bf2f(C0.g), ob = (db * rsqrtf(vb + 64e-5f) * lg + lb + bb * bf2f(C1.v)) * bf2f(C1.g);
        hbuf[row * DM + 768 + c] = f2bf(oa);
        if (two) hbuf[(row + stride) * DM + 768 + c] = f2bf(ob);
    }
}

__device__ __forceinline__ bf16x8 load_rope8(const bf16_t* base, int sgm, bool rope, const float* rc, const float* rs, float scale) {
    const u32x4 own = *(const u32x4*)(base + sgm * 8);
    float o[8];
#pragma unroll
    for (int i = 0; i < 4; ++i) { o[2 * i] = __builtin_bit_cast(float, own[i] << 16); o[2 * i + 1] = __builtin_bit_cast(float, own[i] & 0xffff0000u); }
    if (rope) {
        const u32x4 par = *(const u32x4*)(base + (sgm ^ 2) * 8);
        const int tb = (sgm >> 2) * 16 + (sgm & 1) * 8; const float sgn = (sgm & 2) ? 1.f : -1.f;
#pragma unroll
        for (int i = 0; i < 4; ++i) { const float p0 = __builtin_bit_cast(float, par[i] << 16), p1 = __builtin_bit_cast(float, par[i] & 0xffff0000u);
            o[2 * i] = o[2 * i] * rc[tb + 2 * i] + sgn * p0 * rs[tb + 2 * i]; o[2 * i + 1] = o[2 * i + 1] * rc[tb + 2 * i + 1] + sgn * p1 * rs[tb + 2 * i + 1]; }
    }
    u32x4 w; w.x = cvt_pk_bf16(o[0] * scale, o[1] * scale); w.y = cvt_pk_bf16(o[2] * scale, o[3] * scale); w.z = cvt_pk_bf16(o[4] * scale, o[5] * scale); w.w = cvt_pk_bf16(o[6] * scale, o[7] * scale);
    return __builtin_bit_cast(bf16x8, w);
}
constexpr int KS_PITCH = 72, VT_PITCH = 136, VT_OFF = 128 * KS_PITCH * 2;
__device__ __forceinline__ void attn_unit(const Args& a, int l, int unit, unsigned char* lds) {
    const int tid = opaque_tid(), lane = tid & 63, wave = tid >> 6, fr = lane & 15, quad = lane >> 4;
    bf16_t* Ks = (bf16_t*)lds; bf16_t* Vt = (bf16_t*)(lds + VT_OFF);
    const bf16_t* pxa = (const bf16_t*)(a.ws + WS_PXA); bf16_t* hbuf = (bf16_t*)(a.ws + WS_HBUF);
    const float* rc = (const float*)(a.ws + WS_ROPE); const float* rs = rc + TL * 32;
    const bool isctx = unit >= 256; int b, nblk, kvh, qrow0;
    if (!isctx) { b = unit >> 6; nblk = (unit >> 1) & 31; kvh = unit & 1; qrow0 = b * TL + nblk * 128; }
    else { const int u2 = unit - 256; b = u2 >> 2; nblk = (u2 >> 1) & 1; kvh = u2 & 1; qrow0 = ML + b * CL + nblk * 128; }
    const int qi = wave * 16 + fr; const size_t qrow = (size_t)qrow0 + qi; const int tq = nblk * 128 + qi;
    bf16x8 bq[4][2]; float mrun[4], lsum[4]; f32x4 O[4][4];
#pragma unroll
    for (int g = 0; g < 4; ++g) { const int head = kvh * 4 + g;
#pragma unroll
        for (int ks = 0; ks < 2; ++ks) bq[g][ks] = load_rope8(pxa + qrow * NPXA + 512 + head * 64, 4 * ks + quad, !isctx, rc + tq * 32, rs + tq * 32, 0.18033688011112042f);
        mrun[g] = a.in[I_SINK][l * 8 + head] * 1.4426950408889634f; lsum[g] = quad == 0 ? 1.f : 0.f;
#pragma unroll
        for (int dt = 0; dt < 4; ++dt) O[g][dt] = (f32x4){0.f, 0.f, 0.f, 0.f}; }
    const int nchunk = isctx ? 2 : 5;
    for (int ch = 0; ch < nchunk; ++ch) {
        const bool cchunk = ch < 2; const int lc = ch - 2; const int blk = nblk - 1 + lc;
        if (!cchunk && (blk < 0 || blk > 31)) continue;
        __syncthreads();
#pragma unroll
        for (int it = 0; it < 2; ++it) { const int item = tid + NTHR * it; const int key = item >> 3, sgm = item & 7;
            const size_t krow = cchunk ? (size_t)ML + b * CL + ch * 128 + key : (size_t)b * TL + blk * 128 + key; const int tk = blk * 128 + key;
            const bf16x8 kf = load_rope8(pxa + krow * NPXA + 1024 + kvh * 64, sgm, !cchunk, rc + (cchunk ? 0 : tk) * 32, rs + (cchunk ? 0 : tk) * 32, 1.f);
            *(bf16x8*)(Ks + key * KS_PITCH + sgm * 8) = kf;
            const bf16x8 vf = *(const bf16x8*)(pxa + krow * NPXA + 1152 + kvh * 64 + sgm * 8);
#pragma unroll
            for (int i = 0; i < 8; ++i) Vt[(sgm * 8 + i) * VT_PITCH + key] = (bf16_t)vf[i]; }
        __syncthreads();
#pragma unroll 1
        for (int kt = 0; kt < 4; ++kt) {
            bf16x8 ak[2][2], av[4];
#pragma unroll
            for (int sub = 0; sub < 2; ++sub)
#pragma unroll
                for (int ks = 0; ks < 2; ++ks) ak[sub][ks] = *(const bf16x8*)(Ks + (kt * 32 + sub * 16 + fr) * KS_PITCH + ks * 32 + quad * 8);
#pragma unroll
            for (int dt = 0; dt < 4; ++dt) { const bf16_t* vp = Vt + (dt * 16 + fr) * VT_PITCH + kt * 32 + quad * 4;
                const u32x2 lo = *(const u32x2*)vp, hi = *(const u32x2*)(vp + 16); u32x4 w; w.x = lo.x; w.y = lo.y; w.z = hi.x; w.w = hi.y; av[dt] = __builtin_bit_cast(bf16x8, w); }
#pragma unroll
            for (int g = 0; g < 4; ++g) {
                f32x4 s0 = {0.f, 0.f, 0.f, 0.f}, s1 = {0.f, 0.f, 0.f, 0.f};
                s0 = __builtin_amdgcn_mfma_f32_16x16x32_bf16(ak[0][0], bq[g][0], s0, 0, 0, 0); s0 = __builtin_amdgcn_mfma_f32_16x16x32_bf16(ak[0][1], bq[g][1], s0, 0, 0, 0);
                s1 = __builtin_amdgcn_mfma_f32_16x16x32_bf16(ak[1][0], bq[g][0], s1, 0, 0, 0); s1 = __builtin_amdgcn_mfma_f32_16x16x32_bf16(ak[1][1], bq[g][1], s1, 0, 0, 0);
                if (!cchunk && lc != 1) {
#pragma unroll
                    for (int j = 0; j < 4; ++j) { const int k0 = kt * 32 + quad * 4 + j, k1 = k0 + 16;
                        const bool v0 = lc == 0 ? (k0 >= qi) : (k0 <= qi), v1 = lc == 0 ? (k1 >= qi) : (k1 <= qi);
                        s0[j] = v0 ? s0[j] : -1e30f; s1[j] = v1 ? s1[j] : -1e30f; } }
                float mx = fmaxf(fmaxf(fmaxf(s0[0], s0[1]), fmaxf(s0[2], s0[3])), fmaxf(fmaxf(s1[0], s1[1]), fmaxf(s1[2], s1[3])));
                mx = fmaxf(mx, __shfl_xor(mx, 16)); mx = fmaxf(mx, __shfl_xor(mx, 32));
                const float mold = mrun[g]; const float mn = fmaxf(mold, mx); mrun[g] = mn;
                float p[8];
#pragma unroll
                for (int j = 0; j < 4; ++j) { p[j] = __builtin_amdgcn_exp2f(s0[j] - mn); p[4 + j] = __builtin_amdgcn_exp2f(s1[j] - mn); }
                const float psum = ((p[0] + p[1]) + (p[2] + p[3])) + ((p[4] + p[5]) + (p[6] + p[7]));
                const bool grew = __builtin_amdgcn_ballot_w64(mn != mold) != 0ull;
                if (grew) { const float alpha = __builtin_amdgcn_exp2f(mold - mn); lsum[g] = lsum[g] * alpha + psum;
#pragma unroll
                    for (int dt = 0; dt < 4; ++dt) O[g][dt] = O[g][dt] * alpha; }
                else lsum[g] += psum;
                u32x4 w; w.x = cvt_pk_bf16(p[0], p[1]); w.y = cvt_pk_bf16(p[2], p[3]); w.z = cvt_pk_bf16(p[4], p[5]); w.w = cvt_pk_bf16(p[6], p[7]);
                const bf16x8 bp = __builtin_bit_cast(bf16x8, w);
#pragma unroll
                for (int dt = 0; dt < 4; ++dt) O[g][dt] = __builtin_amdgcn_mfma_f32_16x16x32_bf16(av[dt], bp, O[g][dt], 0, 0, 0);
            }
        }
    }
#pragma unroll
    for (int g = 0; g < 4; ++g) { const int head = kvh * 4 + g;
        float lt = lsum[g]; lt += __shfl_xor(lt, 16); lt += __shfl_xor(lt, 32); const float inv = 1.f / lt;
#pragma unroll
        for (int dt = 0; dt < 4; ++dt) { const f32x4 o = O[g][dt] * inv; u32x2 w; w.x = cvt_pk_bf16(o[0], o[1]); w.y = cvt_pk_bf16(o[2], o[3]);
            *(u32x2*)(hbuf + qrow * DM + 256 + head * 64 + dt * 16 + quad * 4) = w; } }
    __syncthreads();
}

__device__ __forceinline__ void gmlp_unit(const Args& a, int l, int chunk, unsigned char* lds) {
    const int tid = opaque_tid(), lane = tid & 63, wave = tid >> 6, fr = lane & 15, quad = lane >> 4;
    bf16_t* vT = (bf16_t*)lds;
    const bf16_t* pxa = (const bf16_t*)(a.ws + WS_PXA); bf16_t* hbuf = (bf16_t*)(a.ws + WS_HBUF);
    const size_t row0 = (size_t)chunk * 128;
    { const f32x4 lg = *(const f32x4*)(a.in[I_SGLNG] + l * 256 + lane * 4), lb = *(const f32x4*)(a.in[I_SGLNB] + l * 256 + lane * 4);
      u32x2 raws[16];
#pragma unroll
      for (int i = 0; i < 16; ++i) raws[i] = *(const u32x2*)(pxa + (row0 + wave * 16 + i) * NPXA + 256 + lane * 4);
#pragma unroll
      for (int hf = 0; hf < 2; ++hf) {
          unsigned pk[4][4];
#pragma unroll
          for (int i2 = 0; i2 < 4; ++i2) {
              float xn[2][4];
#pragma unroll
              for (int s2 = 0; s2 < 2; ++s2) {
                  const u32x2 raw = raws[hf * 8 + i2 * 2 + s2];
                  float x[4] = { gelu_tanh(__builtin_bit_cast(float, raw.x << 16)), gelu_tanh(__builtin_bit_cast(float, raw.x & 0xffff0000u)), gelu_tanh(__builtin_bit_cast(float, raw.y << 16)), gelu_tanh(__builtin_bit_cast(float, raw.y & 0xffff0000u)) };
                  const float mean = wave_sum((x[0] + x[1]) + (x[2] + x[3])) * (1.f / 256.f);
                  float q = 0.f;
#pragma unroll
                  for (int j = 0; j < 4; ++j) { x[j] -= mean; q += x[j] * x[j]; }
                  const float rstd = rsqrtf(wave_sum(q) * (1.f / 256.f) + 1e-5f);
#pragma unroll
                  for (int j = 0; j < 4; ++j) xn[s2][j] = x[j] * rstd * lg[j] + lb[j]; }
#pragma unroll
              for (int j = 0; j < 4; ++j) pk[j][i2] = cvt_pk_bf16(xn[0][j], xn[1][j]);
          }
#pragma unroll
          for (int j = 0; j < 4; ++j) { u32x4 w; w.x = pk[j][0]; w.y = pk[j][1]; w.z = pk[j][2]; w.w = pk[j][3];
              *(u32x4*)(vT + (lane * 4 + j) * VT_PITCH + wave * 16 + hf * 8) = w; }
      } }
    __syncthreads();
    const int pt = wave;
#pragma unroll 1
    for (int g = 0; g < 4; ++g) {
        bf16x8 af[4];
        const float* wsrc = a.in[I_SGW] + ((size_t)(l * 4 + g) * 128 + pt * 16 + fr) * 128 + quad * 8;
#pragma unroll
        for (int ks = 0; ks < 4; ++ks) { const f32x4 w0 = *(const f32x4*)(wsrc + ks * 32), w1 = *(const f32x4*)(wsrc + ks * 32 + 4);
            u32x4 w; w.x = cvt_pk_bf16(w0[0], w0[1]); w.y = cvt_pk_bf16(w0[2], w0[3]); w.z = cvt_pk_bf16(w1[0], w1[1]); w.w = cvt_pk_bf16(w1[2], w1[3]); af[ks] = __builtin_bit_cast(bf16x8, w); }
        f32x4 bs;
#pragma unroll
        for (int j = 0; j < 4; ++j) bs[j] = a.in[I_SGB][(l * 4 + g) * 128 + pt * 16 + quad * 4 + j];
        unsigned short uraw[4][4];
#pragma unroll
        for (int dt = 0; dt < 4; ++dt)
#pragma unroll
            for (int j = 0; j < 4; ++j) uraw[dt][j] = pxa[(row0 + pt * 16 + quad * 4 + j) * NPXA + g * 64 + dt * 16 + fr];
#pragma unroll
        for (int dt = 0; dt < 4; ++dt) { const int chn = g * 64 + dt * 16 + fr;
            f32x4 acc = {0.f, 0.f, 0.f, 0.f};
#pragma unroll
            for (int ks = 0; ks < 4; ++ks) { const bf16x8 bv = *(const bf16x8*)(vT + chn * VT_PITCH + ks * 32 + quad * 8); acc = __builtin_amdgcn_mfma_f32_16x16x32_bf16(af[ks], bv, acc, 0, 0, 0); }
#pragma unroll
            for (int j = 0; j < 4; ++j) { const size_t row = row0 + pt * 16 + quad * 4 + j;
                const float uu = gelu_tanh(bf2f(uraw[dt][j]));
                hbuf[row * DM + chn] = f2bf(uu * (acc[j] + bs[j])); } }
    }
    __syncthreads();
}

struct PieceOrder { int unit; bool has;
    __device__ __forceinline__ bool next(int i, pg8::Unit& u) const { if (i != 0 || !has) return false; u.pm = unit >> 2; u.pn = unit & 3; return true; }
    __device__ __forceinline__ void a_ready(const pg8::Unit&) const {}
    __device__ __forceinline__ void done(const pg8::Unit&) const {}
};
#define LAS __attribute__((address_space(3)))
constexpr size_t WS_CTL = 768 * 1024, CTL_BYTES = 32768;
constexpr int LDS_BARST_OFF = 131072 + 64;
#define XB_TMO      128
#define XB_XCNT(j)  (256  + 64 * (j))
#define XB_XSUB(j)  (1280 + 64 * (j))
#define XB_XGEN(j)  (2304 + 64 * (j))
#define XB_TOP      3328
#define XB_TOPGEN   3392
#define XCD_BAR_WORDS 3456
#define XB_SPIN_CAP (1u << 18)

__device__ __forceinline__ unsigned xb_ld(unsigned* p)              { return __hip_atomic_load(p, __ATOMIC_RELAXED, __HIP_MEMORY_SCOPE_AGENT); }
__device__ __forceinline__ unsigned xb_add(unsigned* p, unsigned v) { return __hip_atomic_fetch_add(p, v, __ATOMIC_RELAXED, __HIP_MEMORY_SCOPE_AGENT); }
__device__ __forceinline__ unsigned xb_xcc_id() { return (unsigned)__builtin_amdgcn_s_getreg((3 << 11) | 20) & 0xFu; }
#define XB_SPIN(cond, bar) do { unsigned _sp = 0; while (cond) { __builtin_amdgcn_s_sleep(1); \
    if ((++_sp & 255u) == 0u) { if (xb_ld(&(bar)[XB_TMO])) break; if (_sp > XB_SPIN_CAP) { atomicAdd(&(bar)[XB_TMO], 1u); break; } } } } while (0)

struct XcdBarrier {
    unsigned* bar; unsigned x;
    volatile LAS unsigned* st;
};

__device__ __forceinline__ XcdBarrier xcd_barrier_post(unsigned* bar, volatile LAS unsigned* st) {
    XcdBarrier b; b.bar = bar; b.x = xb_xcc_id(); b.st = st;
    if (threadIdx.x == 0) (void)xb_add(&bar[XB_XCNT(b.x)], 1u);
    return b;
}
__device__ __forceinline__ void xcd_barrier_complete(unsigned* bar, unsigned x, unsigned& nloc, unsigned& nx) {
    const unsigned G = gridDim.x * gridDim.y * gridDim.z;
    unsigned sum, cnt, mine, sp = 0u;
    for (;;) {
        sum = 0u; cnt = 0u; mine = 0u;
#pragma unroll
        for (unsigned j = 0; j < 16; ++j) { const unsigned c = xb_ld(&bar[XB_XCNT(j)]); sum += c; cnt += (c > 0u) ? 1u : 0u; mine = (j == x) ? c : mine; }
        if (sum == G) break;
        __builtin_amdgcn_s_sleep(1);
        if ((++sp & 255u) == 0u) { if (xb_ld(&bar[XB_TMO])) break; if (sp > XB_SPIN_CAP) { atomicAdd(&bar[XB_TMO], 1u); break; } }
    }
    nloc = mine > 0u ? mine : 1u; nx = cnt > 0u ? cnt : 1u;
}

__device__ __forceinline__ void xcd_barrier(const XcdBarrier& b) {
    asm volatile("s_waitcnt vmcnt(0)" ::: "memory");
    __syncthreads();
    if (threadIdx.x == 0) {
        unsigned* bar = b.bar;
        __builtin_amdgcn_s_waitcnt(0);
        unsigned nloc = b.st[0], nx = b.st[1];
        if (nloc == 0u) { xcd_barrier_complete(bar, b.x, nloc, nx); b.st[0] = nloc; b.st[1] = nx; }
        const unsigned old = xb_add(&bar[XB_XSUB(b.x)], 1u);
        const unsigned gen = old / nloc;
        if (old + 1u == (gen + 1u) * nloc) {
            __builtin_amdgcn_fence(__ATOMIC_RELEASE, "agent");
            asm volatile("s_waitcnt vmcnt(0)" ::: "memory");
            const unsigned og = xb_add(&bar[XB_TOP], 1u);
            const unsigned tg = og / nx;
            if (og + 1u == (tg + 1u) * nx) xb_add(&bar[XB_TOPGEN], 1u);
            else XB_SPIN(xb_ld(&bar[XB_TOPGEN]) == tg, bar);
            __builtin_amdgcn_fence(__ATOMIC_ACQUIRE, "agent");
            xb_add(&bar[XB_XGEN(b.x)], 1u);
            asm volatile("s_waitcnt vmcnt(0)" ::: "memory");
        } else {
            XB_SPIN(xb_ld(&bar[XB_XGEN(b.x)]) == gen, bar);
            __builtin_amdgcn_fence(__ATOMIC_ACQUIRE, "agent");
            asm volatile("s_waitcnt vmcnt(0)" ::: "memory");
        }
    }
    __syncthreads();
}

constexpr int N_PHASES = 2 + 9 * NL;
template <int MASK> __device__ __forceinline__ void run_phase(const Args& a, int ph, unsigned char* lds) {
    int G = gridDim.x, bid = blockIdx.x; asm volatile("" : "+s"(G), "+s"(bid));
    bf16_t* HB = (bf16_t*)(a.ws + WS_HBUF); float* XC = (float*)(a.ws + WS_XC); bf16_t* YD = (bf16_t*)(a.ws + WS_YD);
    if (ph == 0) { if constexpr (MASK & 1) {
        for (int t = bid; t < 192; t += G) modv_task(a, t, lds);
        for (int t = bid; t < 256; t += G) rope_task(a, t);
        wconv_loop(a, 0, bid, G, lds);
        for (int t = bid; t < 192; t += G) lwconv_task(a, 0, t); }
        return;
    }
    if (ph == 1) { if constexpr (MASK & 2) row_pass(a, MT, nullptr, nullptr, 0, a.in[I_X], a.in[I_CTX], false, nullptr, nullptr, false, nullptr, 0, 0, true, a.in[I_NORMG] + 0, 0, 0, 1); return; }
    const int l = (ph - 2) / 9, s = (ph - 2) % 9;
    const bool last = (l == NL - 1);
    const float* ng = a.in[I_NORMG] + l * 4 * DM;
    const void* xl = l == 0 ? (const void*)a.in[I_X] : (const void*)a.out; const void* xc = l == 0 ? (const void*)a.in[I_CTX] : (const void*)XC;
    void* xmid = last ? (void*)(a.ws + WS_PXA) : (void*)a.out;
    float* YP = (float*)(a.ws + WS_YP);
    const int mpost = last ? ML : MT;
    switch (s) {
    case 0: if constexpr (MASK & 4) { pg8::Gemm g{HB, (const bf16_t*)(a.ws + wbase(l)), MT, NIN, DM, DM}; pg8::StaticOrder S; S.init(MT, NIN, G, bid);
              EpiIn E{(bf16_t*)(a.ws + WS_PXA), (bf16_t*)(a.ws + WS_PXR)};
              pg8::gemm_phase<EpiIn, pg8::StaticOrder, true, true>((PG8_LAS unsigned char*)lds, g, S, E); } break;
    case 1: if constexpr (MASK & 8) { if (bid < PREP_EARLY) { PrepRegs R; prep_issue_loads(R, (const bf16_t*)(a.ws + WS_PXR), prep_tile_of(bid), opaque_tid());
              for (int o = bid; o < PREP_EARLY; o += G) rwkv_prep_tile(a, l, prep_tile_of(o), o + G < PREP_EARLY ? prep_tile_of(o + G) : -1, R, lds); } } break;
    case 2: if constexpr (MASK & 16) { unsigned* pcnt = (unsigned*)(a.ws + WS_CTL) + CW_PREP + 64 * (l * 8);
            if (bid < 128) { for (int rep = 0; rep <= PROBE_SCAN; ++rep) scan_task(a, bid, pcnt, lds); }
            else { { const int w = bid - 128, nw = G - 128;
                if (PREP_EARLY + w < PREP_TILES) { PrepRegs R; prep_issue_loads(R, (const bf16_t*)(a.ws + WS_PXR), prep_tile_of(PREP_EARLY + w), opaque_tid());
                  for (int o = PREP_EARLY + w; o < PREP_TILES; o += nw) { rwkv_prep_tile(a, l, prep_tile_of(o), o + nw < PREP_TILES ? prep_tile_of(o + nw) : -1, R, lds); prep_publish(pcnt + 64 * ((o - PREP_EARLY) / nw)); } } }
            for (int rep = 0; rep <= PROBE_ATT; ++rep) { const int w = bid - 128, nw = G - 128; const int natt = last ? 256 : 272, ngm = last ? 128 : 136;
                for (int u = w; u < natt + ngm; u += nw) { if (u < natt) attn_unit(a, l, u, lds); else gmlp_unit(a, l, u - natt, lds); }
                if (!last && rep == 0) { wconv_loop(a, l + 1, w, nw, lds); for (int t = w; t < 192; t += nw) lwconv_task(a, l + 1, t); } } } } break;
    case 3: if constexpr (MASK & 32) rwkv_out(a, l, mpost); break;
    case 4: if constexpr (MASK & 64) {
              { pg8::Gemm g{HB, (const bf16_t*)(a.ws + wbase(l) + WO_OUT), ML, DM, DM, DM}; pg8::StaticOrder S; S.init(ML, DM, G, bid);
                EpiBf16Out E{YD}; pg8::gemm_phase<EpiBf16Out, pg8::StaticOrder, true, true>((PG8_LAS unsigned char*)lds, g, S, E); }
              if (!last) { const int piece = bid, sl = piece >> 4; PieceOrder S{piece & 15, piece < 64};
                pg8::Gemm g{HB + (size_t)ML * DM + (sl & 3) * 256, (const bf16_t*)(a.ws + wbase(l) + WO_OUT) + (sl & 3) * 256, MC, DM, 256, DM};
                EpiF32 E{YP + (size_t)(sl & 3) * MC * DM}; pg8::gemm_phase<EpiF32, PieceOrder, true, true>((PG8_LAS unsigned char*)lds, g, S, E); } } break;
    case 5: if constexpr (MASK & 2) row_pass(a, mpost, YD, YP, 4, xl, xc, l != 0, xmid, XC, true, ng + 1 * DM, l, 2, true, ng + 2 * DM, l, 3, 4); break;
    case 6: if constexpr (MASK & 128) { pg8::Gemm g{HB, (const bf16_t*)(a.ws + wbase(l) + WO_GU), mpost, 2 * DFF, DM, DM}; pg8::StaticOrder S; S.init(mpost, 2 * DFF, G, bid);
              EpiSwiglu E{(bf16_t*)(a.ws + WS_ACT)}; pg8::gemm_phase<EpiSwiglu, pg8::StaticOrder, true, true>((PG8_LAS unsigned char*)lds, g, S, E); } break;
    case 7: if constexpr (MASK & 512) {
              { pg8::Gemm g{(const bf16_t*)(a.ws + WS_ACT), (const bf16_t*)(a.ws + wbase(l) + WO_DN), ML, DM, DFF, DFF}; pg8::StaticOrder S; S.init(ML, DM, G, bid);
                EpiBf16Out E{YD}; pg8::gemm_phase<EpiBf16Out, pg8::StaticOrder, true, true>((PG8_LAS unsigned char*)lds, g, S, E); }
              if (!last) { const int piece = bid; int sl = piece >> 4; if (sl > 6) sl = 6; PieceOrder S{piece & 15, piece < 112};
                pg8::Gemm g{(const bf16_t*)(a.ws + WS_ACT) + (size_t)ML * DFF + sl * 384, (const bf16_t*)(a.ws + wbase(l) + WO_DN) + sl * 384, MC, DM, sl == 6 ? 512 : 384, DFF};
                EpiF32 E{YP + (size_t)sl * MC * DM}; pg8::gemm_phase<EpiF32, PieceOrder, true, true>((PG8_LAS unsigned char*)lds, g, S, E); } } break;
    case 8: if constexpr (MASK & 256) {
              row_pass(a, mpost, YD, YP, 7, xmid, XC, true, a.out, XC, !last, ng + 3 * DM, l, 5, !last, a.in[I_NORMG] + (last ? 0 : (l + 1) * 4 * DM), last ? 0 : l + 1, 0, 1); } break;
    }
}

template <int MASK> __global__ void __launch_bounds__(NTHR) trunk_fwd(Args args) {
    extern __shared__ __attribute__((aligned(16))) unsigned char lds[];
    cg::grid_group grid = cg::this_grid();
    if (args.ph_lo > args.ph_hi) grid.sync();
    if (threadIdx.x < 4) ((LAS unsigned*)((LAS unsigned char*)lds + LDS_BARST_OFF))[threadIdx.x] = 0u;
    __syncthreads();
    XcdBarrier bar = xcd_barrier_post((unsigned*)(args.ws + WS_CTL), (volatile LAS unsigned*)((LAS unsigned char*)lds + LDS_BARST_OFF));
#define GRID_SYNC() xcd_barrier(bar)
    for (int ph = args.ph_lo; ph < args.ph_hi; ++ph) {
        const int nrep = (ph == PROBE_PH) ? 2 : (PROBE_DUP && ph >= 2) ? 1 + ((PROBE_DUP >> ((ph - 2) % 9)) & 1) : 1;
        for (int rep = 0; rep < nrep; ++rep) {
            run_phase<MASK>(args, ph, lds);
            if (ph + 1 < args.ph_hi || rep + 1 < nrep) GRID_SYNC();
            for (int es = 0; es < PROBE_SYNC; ++es) GRID_SYNC();
        }
    }
}
__host__ inline int phase_mask(int ph) { if (ph == 0) return 1; if (ph == 1) return 2; const int s = (ph - 2) % 9; const int m[9] = {4, 8, 16, 32, 64, 2, 128, 512, 256}; return m[s]; }
__host__ inline const void* kernel_for(int mask) {
#if MK_PER_PHASE
    switch (mask) { case 1: return (const void*)trunk_fwd<1>; case 2: return (const void*)trunk_fwd<2>; case 4: return (const void*)trunk_fwd<4>; case 8: return (const void*)trunk_fwd<8>; case 16: return (const void*)trunk_fwd<16>;
        case 32: return (const void*)trunk_fwd<32>; case 64: return (const void*)trunk_fwd<64>; case 128: return (const void*)trunk_fwd<128>; case 256: return (const void*)trunk_fwd<256>; case 512: return (const void*)trunk_fwd<512>;
        default: return nullptr; }
#else
    (void)mask; return (const void*)trunk_fwd<1023>;
#endif
}

extern "C" void kernel_launch(void* const* d_in, const int* in_sizes, int n_in, void* d_out, int out_size, void* d_ws, size_t ws_size, hipStream_t stream) {
    static int grid = 0;
    if (grid == 0) {
        if (n_in != N_IN || out_size != ML * DM || ws_size < WS_END2) { fprintf(stderr, "kernel_launch: unexpected shapes: n_in %d out %d ws %zu (need %zu)\n", n_in, out_size, ws_size, (size_t)WS_END2); grid = -1; return; }
        int dev = 0, cus = 0, per_cu = 0;
        (void)hipGetDevice(&dev); (void)hipDeviceGetAttribute(&cus, hipDeviceAttributeMultiprocessorCount, dev);
#if MK_PER_PHASE
        for (int mk = 1; mk <= 512; mk <<= 1) {
#else
        for (int mk = 1023; mk <= 1023; ++mk) {
#endif
            if (hipFuncSetAttribute(kernel_for(mk), hipFuncAttributeMaxDynamicSharedMemorySize, LDS_BYTES) != hipSuccess) { fprintf(stderr, "kernel_launch: hipFuncSetAttribute failed\n"); grid = -1; return; }
            if (hipOccupancyMaxActiveBlocksPerMultiprocessor(&per_cu, kernel_for(mk), NTHR, LDS_BYTES) != hipSuccess || per_cu < 1) { fprintf(stderr, "kernel_launch: occupancy query says %d blocks per CU\n", per_cu); grid = -1; return; }
        }
        grid = cus;
        if (grid != 256) fprintf(stderr, "kernel_launch: note: %d CUs (the phase split assumes 256)\n", grid);
    }
    if (grid < 0) return;
    if (hipMemsetAsync((char*)d_ws + WS_CTL, 0, CTL_BYTES, stream) != hipSuccess) { fprintf(stderr, "kernel_launch: memset of the barrier words failed\n"); return; }
    Args a{};
    for (int i = 0; i < N_IN; ++i) a.in[i] = (const float*)d_in[i];
    a.out = (float*)d_out; a.ws = (unsigned char*)d_ws;
#if MK_PER_PHASE
    for (int ph = 0; ph < N_PHASES; ++ph) { a.ph_lo = ph; a.ph_hi = ph + 1; void* kargs[] = {&a};
        hipError_t e = hipLaunchCooperativeKernel(kernel_for(phase_mask(ph)), dim3(grid), dim3(NTHR), kargs, LDS_BYTES, stream);
        if (e != hipSuccess) { fprintf(stderr, "kernel_launch: launch of phase %d failed: %s\n", ph, hipGetErrorString(e)); break; } }
#else
    a.ph_lo = 0; a.ph_hi = N_PHASES; void* kargs[] = {&a};
    hipError_t e = hipLaunchCooperativeKernel(kernel_for(1023), dim3(grid), dim3(NTHR), kargs, LDS_BYTES, stream);
    if (e != hipSuccess) fprintf(stderr, "kernel_launch: cooperative launch failed: %s (grid %d)\n", hipGetErrorString(e), grid);
#endif
}
```

```cpp
#include <hip/hip_runtime.h>
#include <hip/hip_cooperative_groups.h>
#include <cstdio>
#include <cstdint>
namespace cg = cooperative_groups;
__device__ __forceinline__ int opaque_tid() { int t = threadIdx.x; asm volatile("" : "+v"(t)); return t; }
namespace pg8 {
#define PG8_LAS __attribute__((address_space(3)))
typedef unsigned short bf16_t;
typedef short bf16x8 __attribute__((ext_vector_type(8)));
typedef float f32x4 __attribute__((ext_vector_type(4)));
typedef unsigned u32x4 __attribute__((ext_vector_type(4)));
constexpr int BM = 256, BK = 64, HALF = 128, HTB = HALF * BK * 2  , STAGE_BYTES = 8 * HTB, NXCD = 8, WGM = 8;

__host__ __device__ __forceinline__ int lds_byte(int r, int c) { const int st = (r >> 4) * 2 + (c >> 5), rr = r & 15, cc = c & 31, ob = rr * 64 + cc * 2; return st * 1024 + (ob ^ (((ob >> 9) & 1) << 5)); }
__host__ __device__ __forceinline__ void stage_rc(int b, int& R, int& C) { const int st = b / 1024, sb = b % 1024, swz = sb ^ (((sb >> 9) & 1) << 5); R = (st >> 1) * 16 + swz / 64; C = (st & 1) * 32 + (swz % 64) / 2; }
__host__ __device__ __forceinline__ int perm32(int rho) { const int n = rho >> 4, i = rho & 15; return 8 * (i >> 2) + 4 * n + (i & 3); }

struct Unit { int pm, pn; };
struct Gemm { const bf16_t* A; const bf16_t* Bt; int M, N, K, ld; };

struct StaticOrder {
    int nM, nN, nwg, G, c;
    __host__ __device__ void init(int M, int N, int G_, int c_) { nM = M / BM; nN = N / BM; nwg = nM * nN; G = G_; c = c_; }
    __host__ __device__ bool next(int i, Unit& u) const {
        const long L = (long)i * G + c; if (L >= nwg) return false;
        int wgid = (int)L; { const int q = nwg / NXCD, r = nwg % NXCD, xcd = wgid % NXCD, off = wgid / NXCD; wgid = (xcd < r ? xcd * (q + 1) : r * (q + 1) + (xcd - r) * q) + off; }
        const int nig = WGM * nN, gid = wgid / nig, fm = gid * WGM, gsz = (nM - fm) < WGM ? (nM - fm) : WGM;
        u.pm = fm + ((wgid % nig) % gsz); u.pn = (wgid % nig) / gsz; return true;
    }
    __device__ __forceinline__ void a_ready(const Unit&) const {}
    __device__ __forceinline__ void done(const Unit&) const {}
};
__device__ __forceinline__ unsigned cvt_pk_bf16(float lo, float hi) { unsigned r; asm volatile("v_cvt_pk_bf16_f32 %0, %1, %2" : "=v"(r) : "v"(lo), "v"(hi)); return r; }
template <class Epi, class Sched, bool ALIGN_EPI = false, bool SP2 = false>
__device__ __forceinline__ void gemm_phase(PG8_LAS unsigned char* lds, const Gemm g, const Sched& S, const Epi& E) {
    const int tid = opaque_tid(), wid = __builtin_amdgcn_readfirstlane(tid >> 6), lane = tid & 63, wr = wid >> 2, wc = wid & 3, fr = lane & 15, fq = lane >> 4;
    const int K = g.ld, nt = g.K / BK;
    unsigned voffA[2], voffB[2];
#pragma unroll
    for (int i = 0; i < 2; ++i) { int R, C; stage_rc(tid * 16 + i * 8192, R, C); const int Rb = Epi::PERM ? ((R & ~31) + perm32(R & 31)) : R;
        voffA[i] = (unsigned)(R * K + C) * 2u; voffB[i] = (unsigned)(Rb * K + C) * 2u; }
    const size_t kstep = (size_t)(BK * 2);
    const size_t hstep = (size_t)HALF * K * 2;
    const size_t tstep = 2 * hstep;
    const unsigned ldsw = (unsigned)wid * 1024u;
    const int aoff = lds_byte(wr * 64 + fr, fq * 8), boff = lds_byte(wc * 32 + fr, fq * 8);
#define PG8_SA(b, h) (((b) * 2 + (h)) * HTB)
#define PG8_SB(b, h) ((4 + (b) * 2 + (h)) * HTB)
#define PG8_STAGE(bufoff, gbase, voff) do { _Pragma("unroll") for (int _i = 0; _i < 2; ++_i) \
        __builtin_amdgcn_global_load_lds((const unsigned*)((const char*)(gbase) + (voff)[_i]), (PG8_LAS unsigned*)(lds + (bufoff) + ldsw + _i * 8192), 16, 0, 0); } while (0)
#define PG8_LDA(dst, b, h) do { _Pragma("unroll") for (int m = 0; m < 4; ++m) _Pragma("unroll") for (int k = 0; k < 2; ++k) dst[m][k] = *(const PG8_LAS bf16x8*)(lds + PG8_SA(b, h) + aoff + m * 2048 + k * 1024); } while (0)
#define PG8_LDB(dst, b, h) do { _Pragma("unroll") for (int n = 0; n < 2; ++n) _Pragma("unroll") for (int k = 0; k < 2; ++k) dst[n][k] = *(const PG8_LAS bf16x8*)(lds + PG8_SB(b, h) + boff + n * 2048 + k * 1024); } while (0)
#define PG8_MMA(ai, bj, At, Bt) do { __builtin_amdgcn_s_setprio(1); _Pragma("unroll") for (int m = 0; m < 4; ++m) _Pragma("unroll") for (int n = 0; n < 2; ++n) _Pragma("unroll") for (int k = 0; k < 2; ++k) \
        acc[ai][bj][m][n] = __builtin_amdgcn_mfma_f32_16x16x32_bf16(Bt[n][k], At[m][k], acc[ai][bj][m][n], 0, 0, 0); __builtin_amdgcn_s_setprio(0); } while (0)
#define PG8_WAIT_V(n) asm volatile("s_waitcnt vmcnt(" #n ")" ::: "memory")
#define PG8_WAIT_L(n) asm volatile("s_waitcnt lgkmcnt(" #n ")" ::: "memory")
#define PG8_BAR __builtin_amdgcn_s_barrier()
#define PG8_SCHED __builtin_amdgcn_sched_barrier(0)
    Unit cur, nxt; int ui = 0;
    if (!S.next(0, cur)) return;
    f32x4 acc[2][2][4][2];
#pragma unroll
    for (int a = 0; a < 2; ++a)
#pragma unroll
        for (int b = 0; b < 2; ++b)
#pragma unroll
            for (int m = 0; m < 4; ++m)
#pragma unroll
                for (int n = 0; n < 2; ++n) acc[a][b][m][n] = (f32x4){0.f, 0.f, 0.f, 0.f};
    bf16x8 At[4][2], B0[2][2], B1[2][2];
    const char* cA = (const char*)g.A + (size_t)cur.pm * tstep; const char* cB = (const char*)g.Bt + (size_t)cur.pn * tstep;
    S.a_ready(cur);
    if constexpr (SP2) {
        PG8_STAGE(PG8_SB(0, 0), cB, voffB); PG8_STAGE(PG8_SB(0, 1), cB + hstep, voffB); PG8_STAGE(PG8_SA(0, 0), cA, voffA); PG8_STAGE(PG8_SA(0, 1), cA + hstep, voffA);
        if (wr == 1) PG8_BAR;
        PG8_WAIT_V(2); PG8_BAR;
        PG8_STAGE(PG8_SB(1, 0), cB + kstep, voffB); PG8_STAGE(PG8_SA(1, 0), cA + kstep, voffA); PG8_STAGE(PG8_SB(1, 1), cB + hstep + kstep, voffB);
        PG8_WAIT_V(6); PG8_BAR;
    } else {
        PG8_STAGE(PG8_SB(0, 0), cB, voffB); PG8_STAGE(PG8_SA(0, 0), cA, voffA); PG8_STAGE(PG8_SB(0, 1), cB + hstep, voffB); PG8_STAGE(PG8_SA(0, 1), cA + hstep, voffA);
        if (wr == 1) PG8_BAR;
        PG8_WAIT_V(4); PG8_BAR;
        PG8_STAGE(PG8_SB(1, 0), cB + kstep, voffB); PG8_STAGE(PG8_SA(1, 0), cA + kstep, voffA); PG8_STAGE(PG8_SB(1, 1), cB + hstep + kstep, voffB);
        PG8_WAIT_V(6); PG8_BAR;
    }
    for (;;) {
        const bool has_next = S.next(ui + 1, nxt);
        const char* nA = has_next ? (const char*)g.A + (size_t)nxt.pm * tstep : cA; const char* nB = has_next ? (const char*)g.Bt + (size_t)nxt.pn * tstep : cB;
        for (int t = 0; t < nt; t += 2) {
            const bool last = (t == nt - 2);
            const char* a1 = cA + (size_t)(t + 1) * kstep;
            const char* a2 = last ? nA : cA + (size_t)(t + 2) * kstep; const char* b2 = last ? nB : cB + (size_t)(t + 2) * kstep;
            const char* a3 = a2 + kstep; const char* b3 = b2 + kstep;
            if (last && has_next) S.a_ready(nxt);
            if constexpr (SP2) {
            PG8_LDB(B0, 0, 0); PG8_LDB(B1, 0, 1); PG8_SCHED; PG8_LDA(At, 0, 0); PG8_STAGE(PG8_SA(1, 1), a1 + hstep, voffA);
            PG8_WAIT_V(8); PG8_WAIT_L(0); PG8_BAR; PG8_MMA(0, 0, At, B0); PG8_MMA(0, 1, At, B1); PG8_BAR; PG8_SCHED;
            PG8_LDA(At, 0, 1); PG8_STAGE(PG8_SB(0, 0), b2, voffB); PG8_STAGE(PG8_SB(0, 1), b2 + hstep, voffB); PG8_STAGE(PG8_SA(0, 0), a2, voffA);
            PG8_WAIT_V(8); PG8_WAIT_L(0); PG8_BAR; PG8_MMA(1, 0, At, B0); PG8_MMA(1, 1, At, B1); PG8_BAR; PG8_SCHED;
            PG8_LDB(B0, 1, 0); PG8_LDB(B1, 1, 1); PG8_SCHED; PG8_LDA(At, 1, 0); PG8_STAGE(PG8_SA(0, 1), a2 + hstep, voffA);
            PG8_WAIT_V(8); PG8_WAIT_L(0); PG8_BAR; PG8_MMA(0, 0, At, B0); PG8_MMA(0, 1, At, B1); PG8_BAR; PG8_SCHED;
            PG8_LDA(At, 1, 1); PG8_STAGE(PG8_SB(1, 0), b3, voffB); PG8_STAGE(PG8_SB(1, 1), b3 + hstep, voffB); PG8_STAGE(PG8_SA(1, 0), a3, voffA);
            PG8_WAIT_V(8); PG8_WAIT_L(0); PG8_BAR; PG8_MMA(1, 0, At, B0); PG8_MMA(1, 1, At, B1); PG8_BAR; PG8_SCHED;
            } else {
            PG8_LDB(B0, 0, 0); PG8_SCHED; PG8_LDA(At, 0, 0); PG8_STAGE(PG8_SA(1, 1), a1 + hstep, voffA);
            PG8_WAIT_L(8); PG8_BAR; PG8_WAIT_L(0); PG8_MMA(0, 0, At, B0); PG8_BAR; PG8_SCHED;
            PG8_LDB(B1, 0, 1); PG8_STAGE(PG8_SB(0, 0), b2, voffB);
            PG8_BAR; PG8_WAIT_L(0); PG8_MMA(0, 1, At, B1); PG8_BAR;
            PG8_LDA(At, 0, 1); PG8_STAGE(PG8_SA(0, 0), a2, voffA);
            PG8_BAR; PG8_WAIT_L(0); PG8_MMA(1, 0, At, B0); PG8_BAR; PG8_SCHED;
            PG8_STAGE(PG8_SB(0, 1), b2 + hstep, voffB);
            PG8_WAIT_V(6); PG8_BAR; PG8_MMA(1, 1, At, B1); PG8_BAR;
            PG8_LDB(B0, 1, 0); PG8_SCHED; PG8_LDA(At, 1, 0); PG8_STAGE(PG8_SA(0, 1), a2 + hstep, voffA);
            PG8_WAIT_L(8); PG8_BAR; PG8_WAIT_L(0); PG8_MMA(0, 0, At, B0); PG8_BAR; PG8_SCHED;
            PG8_LDB(B1, 1, 1); PG8_STAGE(PG8_SB(1, 0), b3, voffB);
            PG8_BAR; PG8_WAIT_L(0); PG8_MMA(0, 1, At, B1); PG8_BAR;
            PG8_LDA(At, 1, 1); PG8_STAGE(PG8_SA(1, 0), a3, voffA);
            PG8_BAR; PG8_WAIT_L(0); PG8_MMA(1, 0, At, B0); PG8_BAR; PG8_SCHED;
            PG8_STAGE(PG8_SB(1, 1), b3 + hstep, voffB);
            PG8_WAIT_V(6); PG8_BAR; PG8_MMA(1, 1, At, B1); PG8_BAR;
            }
        }
        if constexpr (ALIGN_EPI) { if (wr == 0) PG8_BAR; }
        if constexpr (!Epi::AFTER_DRAIN) { E(acc, cur, wr, wc, fr, fq); S.done(cur); }
        if (!has_next) break;
#pragma unroll
        for (int a = 0; a < 2; ++a)
#pragma unroll
            for (int b = 0; b < 2; ++b)
#pragma unroll
                for (int m = 0; m < 4; ++m)
#pragma unroll
                    for (int n = 0; n < 2; ++n) acc[a][b][m][n] = (f32x4){0.f, 0.f, 0.f, 0.f};
        cur = nxt; cA = nA; cB = nB; ++ui;
        if constexpr (ALIGN_EPI) { if (wr == 1) PG8_BAR; }
    }
    PG8_WAIT_V(0);
    if constexpr (!ALIGN_EPI) { if (wr == 0) PG8_BAR; }
    PG8_BAR;
    if constexpr (Epi::AFTER_DRAIN) { E.fused(acc, cur, wr, wc, fr, fq, lds, wid, lane); S.done(cur); }
#undef PG8_SA
#undef PG8_SB
#undef PG8_STAGE
#undef PG8_LDA
#undef PG8_LDB
#undef PG8_MMA
#undef PG8_WAIT_V
#undef PG8_WAIT_L
#undef PG8_BAR
#undef PG8_SCHED
}
}

#ifndef PROBE_DUP
#define PROBE_DUP 0
#endif
#ifndef PROBE_PH
#define PROBE_PH -1
#endif
#ifndef PROBE_SYNC
#define PROBE_SYNC 0
#endif
#ifndef PROBE_SCANC
#define PROBE_SCANC 0
#endif
#ifndef PROBE_SCAN
#define PROBE_SCAN 0
#endif
#ifndef PROBE_ATT
#define PROBE_ATT 0
#endif
#ifndef MK_PER_PHASE
#define MK_PER_PHASE 0
#endif
using pg8::bf16_t; using pg8::bf16x8; using pg8::f32x4; using pg8::u32x4;
typedef __bf16 bf16x2v __attribute__((ext_vector_type(2)));
typedef float f32x2c __attribute__((ext_vector_type(2)));
__device__ __forceinline__ unsigned cvt_pk_bf16(float lo, float hi) { const f32x2c v = {lo, hi}; return __builtin_bit_cast(unsigned, __builtin_convertvector(v, bf16x2v)); }
typedef unsigned u32x2 __attribute__((ext_vector_type(2)));
typedef short bf16x4 __attribute__((ext_vector_type(4)));

constexpr int DM = 1024, NB = 4, TL = 4096, CL = 256, NL = 4;
constexpr int ML = NB * TL, MC = NB * CL, MT = ML + MC;
constexpr int NIN = 2560, NPXA = 1280, NPXR = 1152, DFF = 2816, INC = 2432;
constexpr int NTHR = 512;
constexpr int LDS_BYTES = 147456;
constexpr size_t MiB = 1u << 20;
constexpr size_t WS_MODV = 0, WS_ROPE = 1 * MiB, WS_XC = 2 * MiB, WS_WIN = 6 * MiB, WS_WOUT = 11 * MiB, WS_WGU = 13 * MiB, WS_WDN = 24 * MiB;
constexpr size_t WS_HBUF = 30 * MiB, WS_PXA = 64 * MiB, WS_PXR = 107 * MiB, WS_PREP = 184 * MiB, WS_END = 354 * MiB;
constexpr size_t WS_WB1 = 146 * MiB;
constexpr size_t WS_LW = 512 * 1024, WS_LW1 = 832 * 1024;
__device__ __forceinline__ size_t wbase(int l) { return (l & 1) ? WS_WB1 : WS_WIN; }
__device__ __forceinline__ size_t lwbase(int l) { return (l & 1) ? WS_LW1 : WS_LW; }
constexpr size_t WO_OUT = 5 * MiB, WO_GU = 7 * MiB, WO_DN = 18 * MiB;
constexpr size_t WS_YS = 312 * MiB;
constexpr size_t WS_ACT = WS_PREP, WS_YD = 278 * MiB, WS_YP = 346 * MiB, WS_END2 = 374 * MiB;
constexpr size_t PREP_W = 0, PREP_KA = (size_t)MT * 512 * 4, PREP_KD = 2 * PREP_KA, PREP_KK = PREP_KD + (size_t)MT * 512 * 2, PREP_R = PREP_KK + (size_t)MT * 256 * 4,
                 PREP_V = PREP_R + (size_t)MT * 256 * 2, PREP_G = PREP_V + (size_t)MT * 256 * 2;
static_assert(WS_HBUF + (size_t)MT * 1024 * 2 <= WS_PXA && WS_PXA + (size_t)MT * NPXA * 2 <= WS_PXR && WS_PXR + (size_t)MT * NPXR * 4 <= WS_PREP, "ws map 1");
static_assert(WS_PREP + PREP_G + (size_t)MT * 256 * 2 <= WS_YS && WS_YS + (size_t)MT * 512 * 4 <= WS_YP && WS_ACT + (size_t)MT * DFF * 2 <= WS_YD && WS_YD + (size_t)MT * 1024 * 4 <= WS_END, "ws map 2");

enum { I_X = 0, I_C, I_CTX, I_CCTX, I_WMOD, I_BMOD, I_NORMG, I_WIN, I_WOUT, I_SGLNG, I_SGLNB, I_SGW, I_SGB, I_SINK, I_MU, I_W0, I_W2, I_A0, I_A2, I_KK, I_KA, I_RK, I_G2, I_LNXG, I_LNXB, I_WGU, I_WDN, N_IN };
struct Args { const float* in[N_IN]; float* out; unsigned char* ws; int ph_lo, ph_hi; };

__device__ __forceinline__ float bf2f(unsigned short h) { return __builtin_bit_cast(float, (unsigned)h << 16); }
__device__ __forceinline__ unsigned cvt_pk_bf16(float lo, float hi);
__device__ __forceinline__ unsigned short f2bf(float f) { return (unsigned short)(cvt_pk_bf16(f, 0.f) & 0xffffu); }
__device__ __forceinline__ f32x4 bf4_to_f32(u32x2 r) { f32x4 o; o[0] = __builtin_bit_cast(float, r.x << 16); o[1] = __builtin_bit_cast(float, r.x & 0xffff0000u); o[2] = __builtin_bit_cast(float, r.y << 16); o[3] = __builtin_bit_cast(float, r.y & 0xffff0000u); return o; }
__device__ __forceinline__ u32x2 f32_to_bf4(f32x4 v) { u32x2 w; w.x = cvt_pk_bf16(v[0], v[1]); w.y = cvt_pk_bf16(v[2], v[3]); return w; }
template <int CTRL> __device__ __forceinline__ float dppf(float x) { return __builtin_bit_cast(float, __builtin_amdgcn_mov_dpp(__builtin_bit_cast(int, x), CTRL, 0xf, 0xf, true)); }
__device__ __forceinline__ float row16_sum(float x) { x += dppf<0xB1>(x); x += dppf<0x4E>(x); x += dppf<0x141>(x); x += dppf<0x128>(x); return x; }
__device__ __forceinline__ float wave_sum(float v) {
    v = row16_sum(v);
    const float r0 = __builtin_bit_cast(float, __builtin_amdgcn_readlane(__builtin_bit_cast(int, v), 0)), r1 = __builtin_bit_cast(float, __builtin_amdgcn_readlane(__builtin_bit_cast(int, v), 16)),
                r2 = __builtin_bit_cast(float, __builtin_amdgcn_readlane(__builtin_bit_cast(int, v), 32)), r3 = __builtin_bit_cast(float, __builtin_amdgcn_readlane(__builtin_bit_cast(int, v), 48));
    return (r0 + r1) + (r2 + r3);
}
__device__ __forceinline__ float gelu_tanh(float x) { const float u = 0.7978845608028654f * (x + 0.044715f * x * x * x); const float t = 1.f - 2.f * __builtin_amdgcn_rcpf(1.f + __expf(2.f * u)); return 0.5f * x * (1.f + t); }
__device__ __forceinline__ float sigmoidf_(float x) { return 1.f / (1.f + __expf(-x)); }

struct EpiIn {
    static constexpr bool PERM = true, AFTER_DRAIN = false;
    bf16_t* pxa; bf16_t* pxr;
    __device__ __forceinline__ void operator()(const f32x4 (&acc)[2][2][4][2], const pg8::Unit& u, int wr, int wc, int fr, int fq) const {
        const int row0 = u.pm * 256 + wr * 64 + fr, colt = u.pn * 256 + wc * 32 + 8 * fq;
#pragma unroll
        for (int ai = 0; ai < 2; ++ai)
#pragma unroll
            for (int m = 0; m < 4; ++m) { const size_t row = (size_t)(row0 + ai * 128 + m * 16);
#pragma unroll
                for (int bj = 0; bj < 2; ++bj) { const int col = colt + bj * 128; const f32x4 v0 = acc[ai][bj][m][0], v1 = acc[ai][bj][m][1];
                    u32x4 w; w.x = cvt_pk_bf16(v0[0], v0[1]); w.y = cvt_pk_bf16(v0[2], v0[3]); w.z = cvt_pk_bf16(v1[0], v1[1]); w.w = cvt_pk_bf16(v1[2], v1[3]);
                    if (u.pn < 5) *(u32x4*)(pxa + row * NPXA + col) = w;
                    else { const int cc = col - NPXA; if (cc < NPXR) *(u32x4*)(pxr + row * NPXR + cc) = w; } } }
    }
};
struct EpiF32 {
    static constexpr bool PERM = true, AFTER_DRAIN = false;
    float* O; static constexpr int ldc = DM;
    __device__ __forceinline__ void operator()(const f32x4 (&acc)[2][2][4][2], const pg8::Unit& u, int wr, int wc, int fr, int fq) const {
        const int row0 = u.pm * 256 + wr * 64 + fr, colt = u.pn * 256 + wc * 32 + 8 * fq;
#pragma unroll
        for (int ai = 0; ai < 2; ++ai)
#pragma unroll
            for (int m = 0; m < 4; ++m) { float* rp = O + (size_t)(row0 + ai * 128 + m * 16) * ldc + colt;
#pragma unroll
                for (int bj = 0; bj < 2; ++bj) { *(f32x4*)(rp + bj * 128) = acc[ai][bj][m][0]; *(f32x4*)(rp + bj * 128 + 4) = acc[ai][bj][m][1]; } }
    }
};
struct EpiBf16Out {
    static constexpr bool PERM = true, AFTER_DRAIN = false;
    bf16_t* O;
    __device__ __forceinline__ void operator()(const f32x4 (&acc)[2][2][4][2], const pg8::Unit& u, int wr, int wc, int fr, int fq) const {
        const int row0 = u.pm * 256 + wr * 64 + fr, colt = u.pn * 256 + wc * 32 + 8 * fq;
#pragma unroll
        for (int ai = 0; ai < 2; ++ai)
#pragma unroll
            for (int m = 0; m < 4; ++m) { bf16_t* rp = O + (size_t)(row0 + ai * 128 + m * 16) * DM + colt;
#pragma unroll
                for (int bj = 0; bj < 2; ++bj) { const f32x4 v0 = acc[ai][bj][m][0], v1 = acc[ai][bj][m][1];
                    u32x4 w; w.x = cvt_pk_bf16(v0[0], v0[1]); w.y = cvt_pk_bf16(v0[2], v0[3]); w.z = cvt_pk_bf16(v1[0], v1[1]); w.w = cvt_pk_bf16(v1[2], v1[3]);
                    *(u32x4*)(rp + bj * 128) = w; } }
    }
};
struct EpiSwiglu {
    static constexpr bool PERM = true, AFTER_DRAIN = false;
    bf16_t* O;
    __device__ __forceinline__ void operator()(const f32x4 (&acc)[2][2][4][2], const pg8::Unit& u, int wr, int wc, int fr, int fq) const {
        const int row0 = u.pm * 256 + wr * 64 + fr, col = u.pn * 128 + wc * 32 + 8 * fq;
#pragma unroll
        for (int ai = 0; ai < 2; ++ai)
#pragma unroll
            for (int m = 0; m < 4; ++m) { float r[8];
#pragma unroll
                for (int n = 0; n < 2; ++n)
#pragma unroll
                    for (int j = 0; j < 4; ++j) { const float g = acc[ai][0][m][n][j], up = acc[ai][1][m][n][j]; r[n * 4 + j] = g * __builtin_amdgcn_rcpf(1.f + __expf(-g)) * up; }
                u32x4 w; w.x = cvt_pk_bf16(r[0], r[1]); w.y = cvt_pk_bf16(r[2], r[3]); w.z = cvt_pk_bf16(r[4], r[5]); w.w = cvt_pk_bf16(r[6], r[7]);
                *(u32x4*)(O + (size_t)(row0 + ai * 128 + m * 16) * DFF + col) = w; }
    }
};

__device__ __forceinline__ void modv_task(const Args& a, int task, unsigned char* lds) {
    float* act = (float*)lds; float* red = act + 5 * 1024;
    const int tid = opaque_tid();
    for (int i = tid; i < 5 * 1024; i += NTHR) { const int r = i >> 10, k = i & 1023; const float v = r < 4 ? a.in[I_C][r * 1024 + k] : a.in[I_CCTX][k]; act[i] = v / (1.f + expf(-v)); }
    __syncthreads();
    const int l = task / 48, cb = task % 48, cl = tid & 127, kq = tid >> 7;
    const float* W = a.in[I_WMOD] + (size_t)l * 1024 * 6144 + cb * 128 + cl;
    float a0 = 0.f, a1 = 0.f, a2 = 0.f, a3 = 0.f, a4 = 0.f;
    for (int k0 = kq * 256; k0 < kq * 256 + 256; k0 += 16) { float wv[16];
#pragma unroll
        for (int u = 0; u < 16; ++u) wv[u] = W[(size_t)(k0 + u) * 6144];
#pragma unroll
        for (int u = 0; u < 16; ++u) { const int k = k0 + u; const float w = wv[u]; a0 += act[k] * w; a1 += act[1024 + k] * w; a2 += act[2048 + k] * w; a3 += act[3072 + k] * w; a4 += act[4096 + k] * w; } }
    red[(kq * 5 + 0) * 128 + cl] = a0; red[(kq * 5 + 1) * 128 + cl] = a1; red[(kq * 5 + 2) * 128 + cl] = a2; red[(kq * 5 + 3) * 128 + cl] = a3; red[(kq * 5 + 4) * 128 + cl] = a4;
    __syncthreads();
    float* modv = (float*)(a.ws + WS_MODV);
    for (int i = tid; i < 640; i += NTHR) { const int r = i >> 7, c2 = i & 127;
        const float s = red[(0 * 5 + r) * 128 + c2] + red[(1 * 5 + r) * 128 + c2] + red[(2 * 5 + r) * 128 + c2] + red[(3 * 5 + r) * 128 + c2];
        modv[(size_t)(l * 5 + r) * 6144 + cb * 128 + c2] = s + a.in[I_BMOD][l * 6144 + cb * 128 + c2]; }
    __syncthreads();
}
__device__ __forceinline__ void rope_task(const Args& a, int task) {
    const int idx = task * NTHR + opaque_tid(); const int t = idx >> 5, j = idx & 31, axis = j >> 4, f = j & 15;
    const float pos = (float)(axis == 0 ? (t >> 6) : (t & 63));
    const float inv = powf(10000.0f, -(float)f / 16.0f);
    const float ang = pos * inv;
    float* rc = (float*)(a.ws + WS_ROPE); float* rs = rc + TL * 32;
    rc[idx] = cosf(ang); rs[idx] = sinf(ang);
}
constexpr int WCONV_TASKS = 640 + 256 + 1408 + 704;
struct WconvDesc { const float* src; bf16_t* dst; int Ksz, Nsrc, kt, n0, sc0; bool zero; };
__device__ __forceinline__ WconvDesc wconv_decode(const Args& a, int l, int task) {
    WconvDesc D; D.zero = false;
    if (task < 640) { const int nt = task >> 4; D.kt = task & 15; D.Ksz = 1024; D.Nsrc = INC; D.src = a.in[I_WIN] + (size_t)l * 1024 * INC; D.dst = (bf16_t*)(a.ws + wbase(l)); D.n0 = nt * 64; const int n0 = D.n0;
        if (n0 < 1024) D.sc0 = n0; else if (n0 < 1280) D.sc0 = 1408 + (n0 - 1024); else if (n0 < 1664) D.sc0 = 1024 + (n0 - 1280); else if (n0 < 2432) D.sc0 = n0; else { D.sc0 = 0; D.zero = true; } }
    else if (task < 896) { const int t = task - 640; const int nt = t >> 4; D.kt = t & 15; D.Ksz = 1024; D.Nsrc = 1024; D.src = a.in[I_WOUT] + (size_t)l * 1024 * 1024; D.dst = (bf16_t*)(a.ws + wbase(l) + WO_OUT); D.n0 = nt * 64; D.sc0 = D.n0; }
    else if (task < 2304) { const int t = task - 896; const int nt = t >> 4; D.kt = t & 15; D.Ksz = 1024; D.Nsrc = 2 * DFF; D.src = a.in[I_WGU] + (size_t)l * 1024 * 2 * DFF; D.dst = (bf16_t*)(a.ws + wbase(l) + WO_GU); D.n0 = nt * 64;
        const int tt = D.n0 >> 8, bj = (D.n0 >> 7) & 1, jj = D.n0 & 127; D.sc0 = bj * DFF + tt * 128 + jj; }
    else { const int t = task - 2304; const int nt = t / 44; D.kt = t % 44; D.Ksz = DFF; D.Nsrc = 1024; D.src = a.in[I_WDN] + (size_t)l * DFF * 1024; D.dst = (bf16_t*)(a.ws + wbase(l) + WO_DN); D.n0 = nt * 64; D.sc0 = D.n0; }
    return D;
}
__device__ __forceinline__ void wconv_issue(f32x4 (&v)[2], const WconvDesc& D, int tid) {
    const int c4 = tid & 15;
#pragma unroll
    for (int h = 0; h < 2; ++h) { const int kr = (tid >> 4) + 32 * h; v[h] = (f32x4){0.f, 0.f, 0.f, 0.f};
        if (!D.zero) v[h] = *(const f32x4*)(D.src + (size_t)(D.kt * 64 + kr) * D.Nsrc + D.sc0 + c4 * 4); }
}
__device__ __forceinline__ void wconv_loop(const Args& a, int l, int first, int stride, unsigned char* lds) {
    if (first >= WCONV_TASKS) return;
    const int tid = opaque_tid();
    float* tile = (float*)lds;
    f32x4 v[2]; WconvDesc D = wconv_decode(a, l, first); wconv_issue(v, D, tid);
    for (int task = first; task < WCONV_TASKS; task += stride) {
        { const int c4 = tid & 15;
#pragma unroll
          for (int h = 0; h < 2; ++h) { const int kr = (tid >> 4) + 32 * h;
              tile[kr * 65 + c4 * 4 + 0] = v[h][0]; tile[kr * 65 + c4 * 4 + 1] = v[h][1]; tile[kr * 65 + c4 * 4 + 2] = v[h][2]; tile[kr * 65 + c4 * 4 + 3] = v[h][3]; } }
        __syncthreads();
        const WconvDesc C = D;
        if (task + stride < WCONV_TASKS) { D = wconv_decode(a, l, task + stride); wconv_issue(v, D, tid); }
        { const int n = tid >> 3, k8 = tid & 7; float r[8];
#pragma unroll
          for (int i = 0; i < 8; ++i) r[i] = tile[(k8 * 8 + i) * 65 + n];
          u32x4 w; w.x = cvt_pk_bf16(r[0], r[1]); w.y = cvt_pk_bf16(r[2], r[3]); w.z = cvt_pk_bf16(r[4], r[5]); w.w = cvt_pk_bf16(r[6], r[7]);
          *(u32x4*)(C.dst + (size_t)(C.n0 + n) * C.Ksz + C.kt * 64 + k8 * 8) = w; }
        __syncthreads();
    }
}

struct RowRegs { f32x4 xv[4], yv[4]; };
__device__ __forceinline__ void row_load(RowRegs& R, int row, int lane, const bf16_t* y, const float* ypart, int nsl, const void* xl_src, const void* xc_src, bool xbf) {
    if (xbf) { const bf16_t* xs = row < ML ? (const bf16_t*)xl_src + (size_t)row * DM : (const bf16_t*)xc_src + (size_t)(row - ML) * DM;
#pragma unroll
        for (int j = 0; j < 4; ++j) R.xv[j] = bf4_to_f32(*(const u32x2*)(xs + j * 256 + lane * 4)); }
    else { const float* xs = row < ML ? (const float*)xl_src + (size_t)row * DM : (const float*)xc_src + (size_t)(row - ML) * DM;
#pragma unroll
        for (int j = 0; j < 4; ++j) R.xv[j] = *(const f32x4*)(xs + j * 256 + lane * 4); }
    if (y) {
        if (row < ML) {
#pragma unroll
            for (int j = 0; j < 4; ++j) R.yv[j] = bf4_to_f32(*(const u32x2*)(y + (size_t)row * DM + j * 256 + lane * 4));
        } else {
#pragma unroll
            for (int j = 0; j < 4; ++j) R.yv[j] = (f32x4){0.f, 0.f, 0.f, 0.f};
#pragma unroll
            for (int sl = 0; sl < 7; ++sl) if (sl < nsl) {
#pragma unroll
                for (int j = 0; j < 4; ++j) R.yv[j] += *(const f32x4*)(ypart + ((size_t)sl * MC + (row - ML)) * DM + j * 256 + lane * 4); }
        }
    }
}
__device__ __forceinline__ void row_process(const Args& a, RowRegs& C, int row, int lane, bool has_y, void* xl_dst, void* xc_dst, bool obf,
                         const f32x4 (&gyv)[4], int l_gate, int gate_idx, bool do_h, const f32x4 (&ghv)[4], int l_h, int shift_idx, int scale_idx, f32x4 (&gtv)[4], f32x4 (&s1v)[4], f32x4 (&s2v)[4], int& cur) {
    const float* modv = (const float*)(a.ws + WS_MODV); bf16_t* hbuf = (bf16_t*)(a.ws + WS_HBUF);
    const int mrow = row < ML ? (row >> 12) : 4;
    if (mrow != cur) { cur = mrow;
    if (has_y) { const float* gate = modv + (size_t)(l_gate * 5 + mrow) * 6144 + gate_idx * 1024;
#pragma unroll
        for (int j = 0; j < 4; ++j) gtv[j] = *(const f32x4*)(gate + j * 256 + lane * 4); }
    if (do_h) { const float* sh = modv + (size_t)(l_h * 5 + mrow) * 6144 + shift_idx * 1024; const float* sc = modv + (size_t)(l_h * 5 + mrow) * 6144 + scale_idx * 1024;
#pragma unroll
        for (int j = 0; j < 4; ++j) { s1v[j] = *(const f32x4*)(sh + j * 256 + lane * 4); s2v[j] = *(const f32x4*)(sc + j * 256 + lane * 4); } } }
    if (has_y) {
        float ss = 0.f;
#pragma unroll
        for (int j = 0; j < 4; ++j) ss += C.yv[j][0] * C.yv[j][0] + C.yv[j][1] * C.yv[j][1] + C.yv[j][2] * C.yv[j][2] + C.yv[j][3] * C.yv[j][3];
        ss = wave_sum(ss); const float rstd = rsqrtf(ss * (1.f / 1024.f) + 1e-6f);
#pragma unroll
        for (int j = 0; j < 4; ++j) C.xv[j] = C.xv[j] + gtv[j] * (C.yv[j] * rstd * gyv[j]);
        if (obf) { bf16_t* xd = row < ML ? (bf16_t*)xl_dst + (size_t)row * DM : (bf16_t*)xc_dst + (size_t)(row - ML) * DM;
#pragma unroll
            for (int j = 0; j < 4; ++j) { const u32x2 w = f32_to_bf4(C.xv[j]); *(u32x2*)(xd + j * 256 + lane * 4) = w; C.xv[j] = bf4_to_f32(w); } }
        else { float* xd = row < ML ? (float*)xl_dst + (size_t)row * DM : (float*)xc_dst + (size_t)(row - ML) * DM;
#pragma unroll
            for (int j = 0; j < 4; ++j) *(f32x4*)(xd + j * 256 + lane * 4) = C.xv[j]; }
    }
    if (do_h) {
        float ss = 0.f;
#pragma unroll
        for (int j = 0; j < 4; ++j) ss += C.xv[j][0] * C.xv[j][0] + C.xv[j][1] * C.xv[j][1] + C.xv[j][2] * C.xv[j][2] + C.xv[j][3] * C.xv[j][3];
        ss = wave_sum(ss); const float rstd = rsqrtf(ss * (1.f / 1024.f) + 1e-6f);
#pragma unroll
        for (int j = 0; j < 4; ++j) { const f32x4 h = (C.xv[j] * rstd * ghv[j]) * (1.f + s2v[j]) + s1v[j];
            u32x2 w; w.x = cvt_pk_bf16(h[0], h[1]); w.y = cvt_pk_bf16(h[2], h[3]);
            *(u32x2*)(hbuf + (size_t)row * DM + j * 256 + lane * 4) = w; }
    }
}
__device__ __forceinline__ void row_pass(const Args& a, int mrows, const bf16_t* y, const float* ypart, int nsl, const void* xl_src, const void* xc_src, bool xbf, void* xl_dst, void* xc_dst, bool obf,
                         const float* gy, int l_gate, int gate_idx, bool do_h, const float* gh, int l_h, int shift_idx, int scale_idx) {
    const int tid = opaque_tid(); const int lane = tid & 63, wave = tid >> 6;
    const int stride = gridDim.x * 8;
    int row = blockIdx.x * 8 + wave;
    f32x4 gyv[4], ghv[4];
#pragma unroll
    for (int j = 0; j < 4; ++j) { gyv[j] = y ? *(const f32x4*)(gy + j * 256 + lane * 4) : (f32x4){0.f, 0.f, 0.f, 0.f}; ghv[j] = do_h ? *(const f32x4*)(gh + j * 256 + lane * 4) : (f32x4){0.f, 0.f, 0.f, 0.f}; }
    f32x4 gtv[4], s1v[4], s2v[4]; int cur = -1;
#pragma unroll
    for (int j = 0; j < 4; ++j) { gtv[j] = (f32x4){0.f, 0.f, 0.f, 0.f}; s1v[j] = gtv[j]; s2v[j] = gtv[j]; }
    RowRegs N0, N1;
    if (row < mrows) row_load(N0, row, lane, y, ypart, nsl, xl_src, xc_src, xbf);
    if (row + stride < mrows) row_load(N1, row + stride, lane, y, ypart, nsl, xl_src, xc_src, xbf);
    for (; row < mrows; row += 2 * stride) {
        RowRegs C0 = N0, C1 = N1;
        const bool two = row + stride < mrows;
        if (row + 2 * stride < mrows) row_load(N0, row + 2 * stride, lane, y, ypart, nsl, xl_src, xc_src, xbf);
        if (row + 3 * stride < mrows) row_load(N1, row + 3 * stride, lane, y, ypart, nsl, xl_src, xc_src, xbf);
        row_process(a, C0, row, lane, y != nullptr, xl_dst, xc_dst, obf, gyv, l_gate, gate_idx, do_h, ghv, l_h, shift_idx, scale_idx, gtv, s1v, s2v, cur);
        if (two) row_process(a, C1, row + stride, lane, y != nullptr, xl_dst, xc_dst, obf, gyv, l_gate, gate_idx, do_h, ghv, l_h, shift_idx, scale_idx, gtv, s1v, s2v, cur);
    }
}


__device__ __forceinline__ void lwconv_task(const Args& a, int l, int frag) {
    const int tid = opaque_tid(); const int lane = tid >> 3, j = tid & 7;
    const float* W; int ct, ks;
    if (frag < 128) { const int m = frag >> 6, rem = frag & 63, d = rem >> 5; ct = (rem >> 1) & 15; ks = rem & 1; W = (m == 0 ? a.in[I_W2] : a.in[I_A2]) + (size_t)(l * 2 + d) * 64 * 256; }
    else { const int rem = frag - 128; ct = rem >> 2; ks = rem & 3; W = a.in[I_G2] + (size_t)l * 128 * 256; }
    const int r = ks * 32 + (lane >> 4) * 8 + j, c = ct * 16 + (lane & 15);
    ((bf16_t*)(a.ws + lwbase(l)))[(size_t)frag * 512 + lane * 8 + j] = f2bf(W[r * 256 + c]);
}
__device__ __forceinline__ bf16x8 lds_afrag(const float* p) {
    const f32x4 x0 = *(const f32x4*)p, x1 = *(const f32x4*)(p + 4);
    u32x4 w; w.x = cvt_pk_bf16(x0[0], x0[1]); w.y = cvt_pk_bf16(x0[2], x0[3]); w.z = cvt_pk_bf16(x1[0], x1[1]); w.w = cvt_pk_bf16(x1[2], x1[3]); return __builtin_bit_cast(bf16x8, w);
}
struct PrepRegs { u32x2 fraw[9], sraw[9]; };
__device__ __forceinline__ void prep_issue_loads(PrepRegs& R, const bf16_t* pxr, int tile, int tid) {
#pragma unroll
    for (int it = 0; it < 9; ++it) {
        const int i = tid + it * NTHR; const int tk = i / (NPXR / 4), j = (i - tk * (NPXR / 4)) * 4; const int row = tile * 16 + tk;
        R.fraw[it] = *(const u32x2*)(pxr + (size_t)row * NPXR + j);
        int nrow; bool valid;
        if (row < ML) { const int t = row & 4095; const int q = j < 384 ? j / 96 : (j - 384) / 192;
            if (q == 0) { valid = (t & 63) > 0; nrow = row - 1; } else if (q == 1) { valid = (t & 63) < 63; nrow = row + 1; }
            else if (q == 2) { valid = t >= 64; nrow = row - 64; } else { valid = t < TL - 64; nrow = row + 64; } }
        else { const int c = (row - ML) & 255; const int hf = j < 384 ? j / 192 : (j - 384) / 384;
            if (hf == 0) { valid = c > 0; nrow = row - 1; } else { valid = c < 255; nrow = row + 1; } }
        R.sraw[it] = (u32x2){0u, 0u}; if (valid) R.sraw[it] = *(const u32x2*)(pxr + (size_t)nrow * NPXR + j);
    }
}
__device__ __forceinline__ void rwkv_prep_tile(const Args& a, int l, int tile, int tile_next, PrepRegs& R, unsigned char* lds) {
    float* mx = (float*)lds; float* rinv = mx + 16 * NPXR;
    const int tid = opaque_tid(), lane = tid & 63, wave = tid >> 6, fr = lane & 15, quad = lane >> 4;
    const bf16_t* pxr = (const bf16_t*)(a.ws + WS_PXR);
    const float* mu = a.in[I_MU] + l * NPXR;
    unsigned char* prep = a.ws + WS_PREP;
    float* PW = (float*)(prep + PREP_W); float* PKA = (float*)(prep + PREP_KA); bf16_t* PKD = (bf16_t*)(prep + PREP_KD); float* PKK = (float*)(prep + PREP_KK);
    bf16_t* PR = (bf16_t*)(prep + PREP_R); bf16_t* PV = (bf16_t*)(prep + PREP_V); bf16_t* PG = (bf16_t*)(prep + PREP_G);
    const size_t row0 = (size_t)tile * 16;
    {
#pragma unroll
        for (int it = 0; it < 9; ++it) {
            const int i = tid + it * NTHR; const int tk = i / (NPXR / 4), j = (i - tk * (NPXR / 4)) * 4; const int row = tile * 16 + tk;
            const f32x4 f = bf4_to_f32(R.fraw[it]), sv = bf4_to_f32(R.sraw[it]);
            const f32x4 muv = *(const f32x4*)(mu + j);
            f32x4 m = f + (sv - f) * muv;
            if (j >= 256 && j < 384) { for (int e = 0; e < 4; ++e) m[e] = __builtin_amdgcn_rcpf(1.f + __expf(-m[e])); }
            else if (j >= 896 && j < 1024) { for (int e = 0; e < 4; ++e) m[e] = 1.f - 2.f * __builtin_amdgcn_rcpf(1.f + __expf(2.f * m[e])); }
            *(f32x4*)(mx + tk * NPXR + j) = m;
            if (j < 256) *(u32x2*)(PR + (size_t)row * 256 + j) = f32_to_bf4(m);
            else if (j >= 640 && j < 896) *(u32x2*)(PV + (size_t)row * 256 + (j - 640)) = f32_to_bf4(m);
        }
    }
    __syncthreads();
    {
#pragma unroll
        for (int tt = 0; tt < 2; ++tt) { const int tk = wave * 2 + tt;
#pragma unroll
            for (int hh = 0; hh < 4; ++hh) { const float x = mx[tk * NPXR + 384 + hh * 64 + lane] * a.in[I_KK][l * 256 + hh * 64 + lane];
                const float ss = wave_sum(x * x); const float ri = fminf(__builtin_amdgcn_rsqf(ss), 1e12f);
                PKK[(row0 + tk) * 256 + hh * 64 + lane] = x * ri; if (lane == 0) rinv[tk * 4 + hh] = ri; } }
    }
    __syncthreads();
    if (tile_next >= 0) prep_issue_loads(R, pxr, tile_next, tid);
    const bf16_t* lw = (const bf16_t*)(a.ws + lwbase(l));
    const size_t orow = row0 + fr;
#pragma unroll 1
    for (int cc = 0; cc < 2; ++cc) {
        const int ct = wave * 2 + cc; const int c0 = ct * 16 + quad * 4; const int hh = ct >> 2;
        const f32x4 kx = *(const f32x4*)(mx + fr * NPXR + 384 + c0);
        const f32x4 kkp = *(const f32x4*)(a.in[I_KK] + l * 256 + c0), kap = *(const f32x4*)(a.in[I_KA] + l * 256 + c0);
        const float ri = rinv[fr * 4 + hh];
        bf16x8 wg[4], ww[2][2], wa[2][2]; f32x4 w0p2[2], a0p2[2];
#pragma unroll
        for (int ks = 0; ks < 4; ++ks) wg[ks] = *(const bf16x8*)(lw + (size_t)(128 + ct * 4 + ks) * 512 + lane * 8);
#pragma unroll
        for (int d = 0; d < 2; ++d) {
#pragma unroll
            for (int ks = 0; ks < 2; ++ks) { ww[d][ks] = *(const bf16x8*)(lw + (size_t)((d * 16 + ct) * 2 + ks) * 512 + lane * 8); wa[d][ks] = *(const bf16x8*)(lw + (size_t)(64 + (d * 16 + ct) * 2 + ks) * 512 + lane * 8); }
            w0p2[d] = *(const f32x4*)(a.in[I_W0] + (l * 2 + d) * 256 + c0); a0p2[d] = *(const f32x4*)(a.in[I_A0] + (l * 2 + d) * 256 + c0); }
        {
            f32x4 acc = {0.f, 0.f, 0.f, 0.f};
#pragma unroll
            for (int ks = 0; ks < 4; ++ks) { const bf16x8 wf = wg[ks]; const bf16x8 af = lds_afrag(mx + fr * NPXR + 256 + ks * 32 + quad * 8);
                acc = __builtin_amdgcn_mfma_f32_16x16x32_bf16(wf, af, acc, 0, 0, 0); }
            *(u32x2*)(PG + orow * 256 + c0) = f32_to_bf4(acc);
        }
#pragma unroll
        for (int d = 0; d < 2; ++d) {
            f32x4 accw = {0.f, 0.f, 0.f, 0.f}, acca = {0.f, 0.f, 0.f, 0.f};
#pragma unroll
            for (int ks = 0; ks < 2; ++ks) {
                const bf16x8 wf = ww[d][ks]; const bf16x8 af = lds_afrag(mx + fr * NPXR + 896 + d * 64 + ks * 32 + quad * 8);
                accw = __builtin_amdgcn_mfma_f32_16x16x32_bf16(wf, af, accw, 0, 0, 0);
                const bf16x8 wf2 = wa[d][ks]; const bf16x8 af2 = lds_afrag(mx + fr * NPXR + 1024 + d * 64 + ks * 32 + quad * 8);
                acca = __builtin_amdgcn_mfma_f32_16x16x32_bf16(wf2, af2, acca, 0, 0, 0); }
            const f32x4 w0p = w0p2[d], a0p = a0p2[d];
            f32x4 wv, kav, kdv;
#pragma unroll
            for (int e = 0; e < 4; ++e) { const float z = w0p[e] + accw[e];
                wv[e] = __expf(-0.6065306597126334f * __builtin_amdgcn_rcpf(1.f + __expf(-z)));
                const float av = __builtin_amdgcn_rcpf(1.f + __expf(-(a0p[e] + acca[e])));
                kav[e] = kx[e] * kkp[e] * ri * av; kdv[e] = kx[e] * (1.f + (av - 1.f) * kap[e]); }
            *(f32x4*)(PW + (orow * 2 + d) * 256 + c0) = wv; *(f32x4*)(PKA + (orow * 2 + d) * 256 + c0) = kav; *(u32x2*)(PKD + (orow * 2 + d) * 256 + c0) = f32_to_bf4(kdv);
        }
    }
    __syncthreads();
}

__device__ __forceinline__ unsigned gl_ld(const unsigned* p) { return __hip_atomic_load(p, __ATOMIC_RELAXED, __HIP_MEMORY_SCOPE_AGENT); }
__device__ __forceinline__ void gl_add(unsigned* p, unsigned v) { (void)__hip_atomic_fetch_add(p, v, __ATOMIC_RELAXED, __HIP_MEMORY_SCOPE_AGENT); }
#ifndef PREP_EARLY_TILES
#define PREP_EARLY_TILES 512
#endif
constexpr int PREP_TILES = MT / 16, PREP_EARLY = PREP_EARLY_TILES, PREP_LATE_ROUNDS = (PREP_TILES - PREP_EARLY + 127) / 128;
constexpr int CW_PREP = 4096;
static_assert(PREP_LATE_ROUNDS <= 8 && PREP_EARLY % 256 == 0 && PREP_EARLY >= 64, "prep split");
__device__ __forceinline__ int prep_tile_of(int o) {
    if (o < 64) return ML / 16 + o;
    const int q = o - 64, b = q & 3, p = q >> 2, i = p >> 1; return b * 256 + ((p & 1) ? 255 - i : i);
}
__device__ __forceinline__ void prep_publish(unsigned* cnt) {
    asm volatile("s_waitcnt vmcnt(0)" ::: "memory");
    __syncthreads();
    if (threadIdx.x == 0) { __builtin_amdgcn_fence(__ATOMIC_RELEASE, "agent"); asm volatile("s_waitcnt vmcnt(0)" ::: "memory"); gl_add(cnt, 1u); }
}
__device__ __forceinline__ void prep_wait_for_chunk(const unsigned* cnt_layer, int ck, int& rd) {
    if (ck < 16 || rd >= PREP_LATE_ROUNDS) return;
    const int ft = ck - 16; const int i = ft < 128 ? ft : 255 - ft; const int oneed = 64 + 8 * i + 7;
    if (oneed < PREP_EARLY) return;
    const int r = (oneed - PREP_EARLY) >> 7;
    if (rd > r) return;
    while (rd <= r) {
        const unsigned expect = (unsigned)((PREP_TILES - PREP_EARLY - rd * 128) < 128 ? (PREP_TILES - PREP_EARLY - rd * 128) : 128);
        unsigned sp = 0; while (gl_ld(cnt_layer + 64 * rd) < expect) { __builtin_amdgcn_s_sleep(2); if (++sp > (1u << 22)) break; }
        ++rd;
    }
    __builtin_amdgcn_fence(__ATOMIC_ACQUIRE, "agent"); asm volatile("s_waitcnt vmcnt(0)" ::: "memory");
}
constexpr int SC_STEPS = 16, SC_NCH = (CL + TL) / SC_STEPS, SC_OPB = 5 * SC_STEPS * 256 + SC_STEPS * 64, SC_PB = SC_STEPS * 16 * 64;
__device__ __forceinline__ int scan_row(int b, int d, int s) {
    if (d == 0) return s < CL ? ML + b * CL + s : b * TL + (s - CL);
    return s < CL ? ML + b * CL + (CL - 1 - s) : b * TL + (TL - 1 - (s - CL));
}
typedef float f32x2 __attribute__((ext_vector_type(2)));
struct ScanStage { f32x4 w, kk, ka; u32x2 kd, r, v; };
struct ScanPtrs { const float *PW, *PKA, *PKK; const bf16_t *PKD, *PR, *PV; float* YS; int b, h, d, rgp; };
__device__ __forceinline__ void scan_issue_loads(ScanStage& R, const ScanPtrs& P, int ck, int lt) {
    const int st = lt >> 4, q4 = lt & 15; const size_t row = (size_t)scan_row(P.b, P.d, ck * SC_STEPS + st); const int co = P.h * 64 + q4 * 4;
    R.w = *(const f32x4*)(P.PW + (row * 2 + P.d) * 256 + co); R.kd = *(const u32x2*)(P.PKD + (row * 2 + P.d) * 256 + co); R.kk = *(const f32x4*)(P.PKK + row * 256 + co);
    R.ka = *(const f32x4*)(P.PKA + (row * 2 + P.d) * 256 + co); R.r = *(const u32x2*)(P.PR + row * 256 + co);
    { const int lv = lt & 63; const size_t rowV = (size_t)scan_row(P.b, P.d, ck * SC_STEPS + (lv >> 2)); R.v = *(const u32x2*)(P.PV + rowV * 256 + P.h * 64 + P.rgp * 16 + (lv & 3) * 4); }
}
__device__ __forceinline__ void scan_store_lds(const ScanStage& R, unsigned char* buf, int lt) {
    const int st = lt >> 4, q4 = lt & 15;
    unsigned char* p = buf + st * 256 + q4 * 16;
    *(f32x4*)(p) = R.w; *(f32x4*)(p + SC_STEPS * 256) = bf4_to_f32(R.kd); *(f32x4*)(p + 2 * SC_STEPS * 256) = R.kk; *(f32x4*)(p + 3 * SC_STEPS * 256) = R.ka; *(f32x4*)(p + 4 * SC_STEPS * 256) = bf4_to_f32(R.r);
    if (lt < 64) { const f32x4 vv = bf4_to_f32(R.v); float* vb = (float*)(buf + 5 * SC_STEPS * 256) + (lt & 3) * 4 * SC_STEPS + (lt >> 2);
        vb[0] = vv[0]; vb[SC_STEPS] = vv[1]; vb[2 * SC_STEPS] = vv[2]; vb[3 * SC_STEPS] = vv[3]; }
}
__device__ __forceinline__ void scan_reduce_y(const ScanPtrs& P, const unsigned char* pb, int ck, int lt) {
    const int st = lt >> 4, row = lt & 15; const float* p = (const float*)(pb + (st * 16 + row) * 64);
    const f32x4 p0 = *(const f32x4*)p, p1 = *(const f32x4*)(p + 4), p2 = *(const f32x4*)(p + 8), p3 = *(const f32x4*)(p + 12);
    const f32x4 q = (p0 + p1) + (p2 + p3);
    const size_t grow = (size_t)scan_row(P.b, P.d, ck * SC_STEPS + st);
    P.YS[(grow * 2 + P.d) * 256 + P.h * 64 + P.rgp * 16 + row] = (q[0] + q[1]) + (q[2] + q[3]);
}
struct ScanOps { f32x4 w4, kd4, kk4, ka4, r4; };
__device__ __forceinline__ void scan_ld_ops(ScanOps& o, const unsigned char* bp, const unsigned char* vp, int st) {
    o.w4 = *(const f32x4*)(bp + st * 256); o.kd4 = *(const f32x4*)(bp + SC_STEPS * 256 + st * 256); o.kk4 = *(const f32x4*)(bp + 2 * SC_STEPS * 256 + st * 256);
    o.ka4 = *(const f32x4*)(bp + 3 * SC_STEPS * 256 + st * 256); o.r4 = *(const f32x4*)(bp + 4 * SC_STEPS * 256 + st * 256);
    (void)vp;
}
#define SCAN_BAR() asm volatile("s_waitcnt lgkmcnt(0)\n\ts_barrier" ::: "memory")
__device__ __forceinline__ void scan_task(const Args& a, int task, const unsigned* prep_cnt, unsigned char* lds) {
    const int tid = opaque_tid(), lane = tid & 63, wave = tid >> 6;
    const int xcd = task & 7, kx = task >> 3; const int chain = xcd * 4 + (kx >> 2); ScanPtrs P;
    P.rgp = kx & 3; P.b = chain >> 3; P.h = (chain >> 1) & 3; P.d = chain & 1;
    unsigned char* prep = a.ws + WS_PREP;
    P.PW = (const float*)(prep + PREP_W); P.PKA = (const float*)(prep + PREP_KA); P.PKD = (const bf16_t*)(prep + PREP_KD); P.PKK = (const float*)(prep + PREP_KK);
    P.PR = (const bf16_t*)(prep + PREP_R); P.PV = (const bf16_t*)(prep + PREP_V); P.YS = (float*)(a.ws + WS_YS);
    unsigned char* pbase = lds + 2 * SC_OPB;
    __syncthreads();
    if (wave >= 4) {
        const int lt = tid - 256; ScanStage R0, R1, R2;
        int rd = 0;
        scan_issue_loads(R0, P, 0, lt); scan_store_lds(R0, lds, lt);
        scan_issue_loads(R1, P, 1, lt); scan_issue_loads(R2, P, 2, lt); scan_issue_loads(R0, P, 3, lt);
        SCAN_BAR();
#define SCAN_LOADER_IT(CK, RS) do { const int ck_ = (CK); if (ck_ < SC_NCH) { \
            if (ck_ + 1 < SC_NCH) scan_store_lds(RS, lds + ((ck_ + 1) & 1) * SC_OPB, lt); \
            if (ck_ + 4 < SC_NCH) { prep_wait_for_chunk(prep_cnt, ck_ + 4, rd); scan_issue_loads(RS, P, ck_ + 4, lt); } \
            if (ck_ >= 1) scan_reduce_y(P, pbase + ((ck_ - 1) & 1) * SC_PB, ck_ - 1, lt); \
            SCAN_BAR(); } } while (0)
        for (int ck = 0; ck < SC_NCH; ck += 3) { SCAN_LOADER_IT(ck, R1); SCAN_LOADER_IT(ck + 1, R2); SCAN_LOADER_IT(ck + 2, R0); }
#undef SCAN_LOADER_IT
        scan_reduce_y(P, pbase + ((SC_NCH - 1) & 1) * SC_PB, SC_NCH - 1, lt);
    } else {
        const int rw = lane >> 4, kq = lane & 15, rowA = wave * 4 + rw;
        f32x2 SL = {0.f, 0.f}, SH = {0.f, 0.f};
        SCAN_BAR();
        for (int ck = 0; ck < SC_NCH; ++ck) {
            const unsigned char* bp = lds + (ck & 1) * SC_OPB + kq * 16;
            const unsigned char* vp = lds + (ck & 1) * SC_OPB + 5 * SC_STEPS * 256 + rowA * (SC_STEPS * 4);
            f32x4 vq[4];
#pragma unroll
            for (int q = 0; q < 4; ++q) vq[q] = *(const f32x4*)(vp + q * 16);
            float* pw = (float*)(pbase + (ck & 1) * SC_PB) + rowA * 16 + kq;
            ScanOps o0, o1, o2;
            scan_ld_ops(o0, bp, vp, 0); scan_ld_ops(o1, bp, vp, 1);
#pragma unroll
            for (int st = 0; st < SC_STEPS; ++st) {
                scan_ld_ops(o2, bp, vp, st + 2 < SC_STEPS ? st + 2 : SC_STEPS - 1);
                const f32x2 wlo = {o0.w4[0], o0.w4[1]}, whi = {o0.w4[2], o0.w4[3]}, kdlo = {o0.kd4[0], o0.kd4[1]}, kdhi = {o0.kd4[2], o0.kd4[3]}, kklo = {o0.kk4[0], o0.kk4[1]}, kkhi = {o0.kk4[2], o0.kk4[3]},
                            kalo = {o0.ka4[0], o0.ka4[1]}, kahi = {o0.ka4[2], o0.ka4[3]}, rlo = {o0.r4[0], o0.r4[1]}, rhi = {o0.r4[2], o0.r4[3]};
                const f32x2 dp = SL * kklo + SH * kkhi;
                const float sa = row16_sum(dp[0] + dp[1]);
                const float va = vq[st >> 2][st & 3];
                const f32x2 TL = SL * wlo + kdlo * va, TH = SH * whi + kdhi * va;
                SL = TL - kalo * sa; SH = TH - kahi * sa;
                const f32x2 yy = SL * rlo + SH * rhi;
                pw[st * 256] = yy[0] + yy[1];
                o0 = o1; o1 = o2;
            }
            SCAN_BAR();
        }
    }
}

struct RoRegs { float y0, y1; unsigned short r, kd0, kd1, v, g; };
__device__ __forceinline__ void ro_load(RoRegs& R, size_t row, int c, const float* YS, const bf16_t* PR, const bf16_t* PKD, const bf16_t* PV, const bf16_t* PG) {
    R.y0 = YS[(row * 2 + 0) * 256 + c]; R.y1 = YS[(row * 2 + 1) * 256 + c]; R.r = PR[row * 256 + c]; R.kd0 = PKD[(row * 2 + 0) * 256 + c]; R.kd1 = PKD[(row * 2 + 1) * 256 + c];
    R.v = PV[row * 256 + c]; R.g = PG[row * 256 + c];
}
__device__ __forceinline__ void rwkv_out(const Args& a, int l, int mrows) {
    const int tid = opaque_tid(), c = tid & 255;
    unsigned char* prep = a.ws + WS_PREP;
    const bf16_t* PKD = (const bf16_t*)(prep + PREP_KD); const bf16_t* PR = (const bf16_t*)(prep + PREP_R); const bf16_t* PV = (const bf16_t*)(prep + PREP_V); const bf16_t* PG = (const bf16_t*)(prep + PREP_G);
    const float* YS = (const float*)(a.ws + WS_YS); bf16_t* hbuf = (bf16_t*)(a.ws + WS_HBUF);
    const float lg = a.in[I_LNXG][l * 256 + c], lb = a.in[I_LNXB][l * 256 + c], rk = a.in[I_RK][l * 256 + c];
    const size_t stride = (size_t)gridDim.x * 2;
    size_t row = (size_t)blockIdx.x * 2 + (tid >> 8);
    RoRegs N0, N1; N1.y0 = 0.f; N1.y1 = 0.f; N1.r = 0; N1.kd0 = 0; N1.kd1 = 0; N1.v = 0; N1.g = 0;
    if (row < (size_t)mrows) ro_load(N0, row, c, YS, PR, PKD, PV, PG);
    if (row + stride < (size_t)mrows) ro_load(N1, row + stride, c, YS, PR, PKD, PV, PG);
    for (; row < (size_t)mrows; row += 2 * stride) {
        const RoRegs C0 = N0, C1 = N1; const bool two = row + stride < (size_t)mrows;
        if (row + 2 * stride < (size_t)mrows) ro_load(N0, row + 2 * stride, c, YS, PR, PKD, PV, PG);
        if (row + 3 * stride < (size_t)mrows) ro_load(N1, row + 3 * stride, c, YS, PR, PKD, PV, PG);
        const float ya = C0.y0 + C0.y1, yb = C1.y0 + C1.y1;
        const float ma = wave_sum(ya) * (1.f / 64.f), mb = wave_sum(yb) * (1.f / 64.f);
        const float qa = wave_sum(ya * ya) * (1.f / 64.f), qb = wave_sum(yb * yb) * (1.f / 64.f);
        const float da = ya - ma, db = yb - mb;
        const float va = fmaxf(qa - ma * ma, 0.f), vb = fmaxf(qb - mb * mb, 0.f);
        const float ba = wave_sum(bf2f(C0.r) * (bf2f(C0.kd0) + bf2f(C0.kd1)) * rk), bb = wave_sum(bf2f(C1.r) * (bf2f(C1.kd0) + bf2f(C1.kd1)) * rk);
        const float oa = (da * rsqrtf(va + 64e-5f) * lg + lb + ba * bf2f(C0.v)) * bf2f(C0.g), ob = (db * rsqrtf(vb + 64e-5f) * lg + lb + bb * bf2f(C1.v)) * bf2f(C1.g);
        hbuf[row * DM + 768 + c] = f2bf(oa);
        if (two) hbuf[(row + stride) * DM + 768 + c] = f2bf(ob);
    }
}

__device__ __forceinline__ bf16x8 load_rope8(const bf16_t* base, int sgm, bool rope, const float* rc, const float* rs, float scale) {
    const u32x4 own = *(const u32x4*)(base + sgm * 8);
    float o[8];
#pragma unroll
    for (int i = 0; i < 4; ++i) { o[2 * i] = __builtin_bit_cast(float, own[i] << 16); o[2 * i + 1] = __builtin_bit_cast(float, own[i] & 0xffff0000u); }
    if (rope) {
        const u32x4 par = *(const u32x4*)(base + (sgm ^ 2) * 8);
        const int tb = (sgm >> 2) * 16 + (sgm & 1) * 8; const float sgn = (sgm & 2) ? 1.f : -1.f;
#pragma unroll
        for (int i = 0; i < 4; ++i) { const float p0 = __builtin_bit_cast(float, par[i] << 16), p1 = __builtin_bit_cast(float, par[i] & 0xffff0000u);
            o[2 * i] = o[2 * i] * rc[tb + 2 * i] + sgn * p0 * rs[tb + 2 * i]; o[2 * i + 1] = o[2 * i + 1] * rc[tb + 2 * i + 1] + sgn * p1 * rs[tb + 2 * i + 1]; }
    }
    u32x4 w; w.x = cvt_pk_bf16(o[0] * scale, o[1] * scale); w.y = cvt_pk_bf16(o[2] * scale, o[3] * scale); w.z = cvt_pk_bf16(o[4] * scale, o[5] * scale); w.w = cvt_pk_bf16(o[6] * scale, o[7] * scale);
    return __builtin_bit_cast(bf16x8, w);
}
constexpr int KS_PITCH = 72, VT_PITCH = 136, VT_OFF = 128 * KS_PITCH * 2;
__device__ __forceinline__ void attn_unit(const Args& a, int l, int unit, unsigned char* lds) {
    const int tid = opaque_tid(), lane = tid & 63, wave = tid >> 6, fr = lane & 15, quad = lane >> 4;
    bf16_t* Ks = (bf16_t*)lds; bf16_t* Vt = (bf16_t*)(lds + VT_OFF);
    const bf16_t* pxa = (const bf16_t*)(a.ws + WS_PXA); bf16_t* hbuf = (bf16_t*)(a.ws + WS_HBUF);
    const float* rc = (const float*)(a.ws + WS_ROPE); const float* rs = rc + TL * 32;
    const bool isctx = unit >= 256; int b, nblk, kvh, qrow0;
    if (!isctx) { b = unit >> 6; nblk = (unit >> 1) & 31; kvh = unit & 1; qrow0 = b * TL + nblk * 128; }
    else { const int u2 = unit - 256; b = u2 >> 2; nblk = (u2 >> 1) & 1; kvh = u2 & 1; qrow0 = ML + b * CL + nblk * 128; }
    const int qi = wave * 16 + fr; const size_t qrow = (size_t)qrow0 + qi; const int tq = nblk * 128 + qi;
    bf16x8 bq[4][2]; float mrun[4], lsum[4]; f32x4 O[4][4];
#pragma unroll
    for (int g = 0; g < 4; ++g) { const int head = kvh * 4 + g;
#pragma unroll
        for (int ks = 0; ks < 2; ++ks) bq[g][ks] = load_rope8(pxa + qrow * NPXA + 512 + head * 64, 4 * ks + quad, !isctx, rc + tq * 32, rs + tq * 32, 0.18033688011112042f);
        mrun[g] = a.in[I_SINK][l * 8 + head] * 1.4426950408889634f; lsum[g] = quad == 0 ? 1.f : 0.f;
#pragma unroll
        for (int dt = 0; dt < 4; ++dt) O[g][dt] = (f32x4){0.f, 0.f, 0.f, 0.f}; }
    const int nchunk = isctx ? 2 : 5;
    for (int ch = 0; ch < nchunk; ++ch) {
        const bool cchunk = ch < 2; const int lc = ch - 2; const int blk = nblk - 1 + lc;
        if (!cchunk && (blk < 0 || blk > 31)) continue;
        __syncthreads();
#pragma unroll
        for (int it = 0; it < 2; ++it) { const int item = tid + NTHR * it; const int key = item >> 3, sgm = item & 7;
            const size_t krow = cchunk ? (size_t)ML + b * CL + ch * 128 + key : (size_t)b * TL + blk * 128 + key; const int tk = blk * 128 + key;
            const bf16x8 kf = load_rope8(pxa + krow * NPXA + 1024 + kvh * 64, sgm, !cchunk, rc + (cchunk ? 0 : tk) * 32, rs + (cchunk ? 0 : tk) * 32, 1.f);
            *(bf16x8*)(Ks + key * KS_PITCH + sgm * 8) = kf;
            const bf16x8 vf = *(const bf16x8*)(pxa + krow * NPXA + 1152 + kvh * 64 + sgm * 8);
#pragma unroll
            for (int i = 0; i < 8; ++i) Vt[(sgm * 8 + i) * VT_PITCH + key] = (bf16_t)vf[i]; }
        __syncthreads();
#pragma unroll 1
        for (int kt = 0; kt < 4; ++kt) {
            bf16x8 ak[2][2], av[4];
#pragma unroll
            for (int sub = 0; sub < 2; ++sub)
#pragma unroll
                for (int ks = 0; ks < 2; ++ks) ak[sub][ks] = *(const bf16x8*)(Ks + (kt * 32 + sub * 16 + fr) * KS_PITCH + ks * 32 + quad * 8);
#pragma unroll
            for (int dt = 0; dt < 4; ++dt) { const bf16_t* vp = Vt + (dt * 16 + fr) * VT_PITCH + kt * 32 + quad * 4;
                const u32x2 lo = *(const u32x2*)vp, hi = *(const u32x2*)(vp + 16); u32x4 w; w.x = lo.x; w.y = lo.y; w.z = hi.x; w.w = hi.y; av[dt] = __builtin_bit_cast(bf16x8, w); }
#pragma unroll
            for (int g = 0; g < 4; ++g) {
                f32x4 s0 = {0.f, 0.f, 0.f, 0.f}, s1 = {0.f, 0.f, 0.f, 0.f};
                s0 = __builtin_amdgcn_mfma_f32_16x16x32_bf16(ak[0][0], bq[g][0], s0, 0, 0, 0); s0 = __builtin_amdgcn_mfma_f32_16x16x32_bf16(ak[0][1], bq[g][1], s0, 0, 0, 0);
                s1 = __builtin_amdgcn_mfma_f32_16x16x32_bf16(ak[1][0], bq[g][0], s1, 0, 0, 0); s1 = __builtin_amdgcn_mfma_f32_16x16x32_bf16(ak[1][1], bq[g][1], s1, 0, 0, 0);
                if (!cchunk && lc != 1) {
#pragma unroll
                    for (int j = 0; j < 4; ++j) { const int k0 = kt * 32 + quad * 4 + j, k1 = k0 + 16;
                        const bool v0 = lc == 0 ? (k0 >= qi) : (k0 <= qi), v1 = lc == 0 ? (k1 >= qi) : (k1 <= qi);
                        s0[j] = v0 ? s0[j] : -1e30f; s1[j] = v1 ? s1[j] : -1e30f; } }
                float mx = fmaxf(fmaxf(fmaxf(s0[0], s0[1]), fmaxf(s0[2], s0[3])), fmaxf(fmaxf(s1[0], s1[1]), fmaxf(s1[2], s1[3])));
                mx = fmaxf(mx, __shfl_xor(mx, 16)); mx = fmaxf(mx, __shfl_xor(mx, 32));
                const float mold = mrun[g]; const float mn = fmaxf(mold, mx); mrun[g] = mn;
                float p[8];
#pragma unroll
                for (int j = 0; j < 4; ++j) { p[j] = __builtin_amdgcn_exp2f(s0[j] - mn); p[4 + j] = __builtin_amdgcn_exp2f(s1[j] - mn); }
                const float psum = ((p[0] + p[1]) + (p[2] + p[3])) + ((p[4] + p[5]) + (p[6] + p[7]));
                const bool grew = __builtin_amdgcn_ballot_w64(mn != mold) != 0ull;
                if (grew) { const float alpha = __builtin_amdgcn_exp2f(mold - mn); lsum[g] = lsum[g] * alpha + psum;
#pragma unroll
                    for (int dt = 0; dt < 4; ++dt) O[g][dt] = O[g][dt] * alpha; }
                else lsum[g] += psum;
                u32x4 w; w.x = cvt_pk_bf16(p[0], p[1]); w.y = cvt_pk_bf16(p[2], p[3]); w.z = cvt_pk_bf16(p[4], p[5]); w.w = cvt_pk_bf16(p[6], p[7]);
                const bf16x8 bp = __builtin_bit_cast(bf16x8, w);
#pragma unroll
                for (int dt = 0; dt < 4; ++dt) O[g][dt] = __builtin_amdgcn_mfma_f32_16x16x32_bf16(av[dt], bp, O[g][dt], 0, 0, 0);
            }
        }
    }
#pragma unroll
    for (int g = 0; g < 4; ++g) { const int head = kvh * 4 + g;
        float lt = lsum[g]; lt += __shfl_xor(lt, 16); lt += __shfl_xor(lt, 32); const float inv = 1.f / lt;
#pragma unroll
        for (int dt = 0; dt < 4; ++dt) { const f32x4 o = O[g][dt] * inv; u32x2 w; w.x = cvt_pk_bf16(o[0], o[1]); w.y = cvt_pk_bf16(o[2], o[3]);
            *(u32x2*)(hbuf + qrow * DM + 256 + head * 64 + dt * 16 + quad * 4) = w; } }
    __syncthreads();
}

__device__ __forceinline__ void gmlp_unit(const Args& a, int l, int chunk, unsigned char* lds) {
    const int tid = opaque_tid(), lane = tid & 63, wave = tid >> 6, fr = lane & 15, quad = lane >> 4;
    bf16_t* vT = (bf16_t*)lds;
    const bf16_t* pxa = (const bf16_t*)(a.ws + WS_PXA); bf16_t* hbuf = (bf16_t*)(a.ws + WS_HBUF);
    const size_t row0 = (size_t)chunk * 128;
    { const f32x4 lg = *(const f32x4*)(a.in[I_SGLNG] + l * 256 + lane * 4), lb = *(const f32x4*)(a.in[I_SGLNB] + l * 256 + lane * 4);
      u32x2 raws[16];
#pragma unroll
      for (int i = 0; i < 16; ++i) raws[i] = *(const u32x2*)(pxa + (row0 + wave * 16 + i) * NPXA + 256 + lane * 4);
#pragma unroll
      for (int hf = 0; hf < 2; ++hf) {
          unsigned pk[4][4];
#pragma unroll
          for (int i2 = 0; i2 < 4; ++i2) {
              float xn[2][4];
#pragma unroll
              for (int s2 = 0; s2 < 2; ++s2) {
                  const u32x2 raw = raws[hf * 8 + i2 * 2 + s2];
                  float x[4] = { gelu_tanh(__builtin_bit_cast(float, raw.x << 16)), gelu_tanh(__builtin_bit_cast(float, raw.x & 0xffff0000u)), gelu_tanh(__builtin_bit_cast(float, raw.y << 16)), gelu_tanh(__builtin_bit_cast(float, raw.y & 0xffff0000u)) };
                  const float mean = wave_sum((x[0] + x[1]) + (x[2] + x[3])) * (1.f / 256.f);
                  float q = 0.f;
#pragma unroll
                  for (int j = 0; j < 4; ++j) { x[j] -= mean; q += x[j] * x[j]; }
                  const float rstd = rsqrtf(wave_sum(q) * (1.f / 256.f) + 1e-5f);
#pragma unroll
                  for (int j = 0; j < 4; ++j) xn[s2][j] = x[j] * rstd * lg[j] + lb[j]; }
#pragma unroll
              for (int j = 0; j < 4; ++j) pk[j][i2] = cvt_pk_bf16(xn[0][j], xn[1][j]);
          }
#pragma unroll
          for (int j = 0; j < 4; ++j) { u32x4 w; w.x = pk[j][0]; w.y = pk[j][1]; w.z = pk[j][2]; w.w = pk[j][3];
              *(u32x4*)(vT + (lane * 4 + j) * VT_PITCH + wave * 16 + hf * 8) = w; }
      } }
    __syncthreads();
    const int pt = wave;
#pragma unroll 1
    for (int g = 0; g < 4; ++g) {
        bf16x8 af[4];
        const float* wsrc = a.in[I_SGW] + ((size_t)(l * 4 + g) * 128 + pt * 16 + fr) * 128 + quad * 8;
#pragma unroll
        for (int ks = 0; ks < 4; ++ks) { const f32x4 w0 = *(const f32x4*)(wsrc + ks * 32), w1 = *(const f32x4*)(wsrc + ks * 32 + 4);
            u32x4 w; w.x = cvt_pk_bf16(w0[0], w0[1]); w.y = cvt_pk_bf16(w0[2], w0[3]); w.z = cvt_pk_bf16(w1[0], w1[1]); w.w = cvt_pk_bf16(w1[2], w1[3]); af[ks] = __builtin_bit_cast(bf16x8, w); }
        f32x4 bs;
#pragma unroll
        for (int j = 0; j < 4; ++j) bs[j] = a.in[I_SGB][(l * 4 + g) * 128 + pt * 16 + quad * 4 + j];
        unsigned short uraw[4][4];
#pragma unroll
        for (int dt = 0; dt < 4; ++dt)
#pragma unroll
            for (int j = 0; j < 4; ++j) uraw[dt][j] = pxa[(row0 + pt * 16 + quad * 4 + j) * NPXA + g * 64 + dt * 16 + fr];
#pragma unroll
        for (int dt = 0; dt < 4; ++dt) { const int chn = g * 64 + dt * 16 + fr;
            f32x4 acc = {0.f, 0.f, 0.f, 0.f};
#pragma unroll
            for (int ks = 0; ks < 4; ++ks) { const bf16x8 bv = *(const bf16x8*)(vT + chn * VT_PITCH + ks * 32 + quad * 8); acc = __builtin_amdgcn_mfma_f32_16x16x32_bf16(af[ks], bv, acc, 0, 0, 0); }
#pragma unroll
            for (int j = 0; j < 4; ++j) { const size_t row = row0 + pt * 16 + quad * 4 + j;
                const float uu = gelu_tanh(bf2f(uraw[dt][j]));
                hbuf[row * DM + chn] = f2bf(uu * (acc[j] + bs[j])); } }
    }
    __syncthreads();
}

struct PieceOrder { int unit; bool has;
    __device__ __forceinline__ bool next(int i, pg8::Unit& u) const { if (i != 0 || !has) return false; u.pm = unit >> 2; u.pn = unit & 3; return true; }
    __device__ __forceinline__ void a_ready(const pg8::Unit&) const {}
    __device__ __forceinline__ void done(const pg8::Unit&) const {}
};
#define LAS __attribute__((address_space(3)))
constexpr size_t WS_CTL = 768 * 1024, CTL_BYTES = 32768;
constexpr int LDS_BARST_OFF = 131072 + 64;
#define XB_TMO      128
#define XB_XCNT(j)  (256  + 64 * (j))
#define XB_XSUB(j)  (1280 + 64 * (j))
#define XB_XGEN(j)  (2304 + 64 * (j))
#define XB_TOP      3328
#define XB_TOPGEN   3392
#define XCD_BAR_WORDS 3456
#define XB_SPIN_CAP (1u << 18)

__device__ __forceinline__ unsigned xb_ld(unsigned* p)              { return __hip_atomic_load(p, __ATOMIC_RELAXED, __HIP_MEMORY_SCOPE_AGENT); }
__device__ __forceinline__ unsigned xb_add(unsigned* p, unsigned v) { return __hip_atomic_fetch_add(p, v, __ATOMIC_RELAXED, __HIP_MEMORY_SCOPE_AGENT); }
__device__ __forceinline__ unsigned xb_xcc_id() { return (unsigned)__builtin_amdgcn_s_getreg((3 << 11) | 20) & 0xFu; }
#define XB_SPIN(cond, bar) do { unsigned _sp = 0; while (cond) { __builtin_amdgcn_s_sleep(1); \
    if ((++_sp & 255u) == 0u) { if (xb_ld(&(bar)[XB_TMO])) break; if (_sp > XB_SPIN_CAP) { atomicAdd(&(bar)[XB_TMO], 1u); break; } } } } while (0)

struct XcdBarrier {
    unsigned* bar; unsigned x;
    volatile LAS unsigned* st;
};

__device__ __forceinline__ XcdBarrier xcd_barrier_post(unsigned* bar, volatile LAS unsigned* st) {
    XcdBarrier b; b.bar = bar; b.x = xb_xcc_id(); b.st = st;
    if (threadIdx.x == 0) (void)xb_add(&bar[XB_XCNT(b.x)], 1u);
    return b;
}
__device__ __forceinline__ void xcd_barrier_complete(unsigned* bar, unsigned x, unsigned& nloc, unsigned& nx) {
    const unsigned G = gridDim.x * gridDim.y * gridDim.z;
    unsigned sum, cnt, mine, sp = 0u;
    for (;;) {
        sum = 0u; cnt = 0u; mine = 0u;
#pragma unroll
        for (unsigned j = 0; j < 16; ++j) { const unsigned c = xb_ld(&bar[XB_XCNT(j)]); sum += c; cnt += (c > 0u) ? 1u : 0u; mine = (j == x) ? c : mine; }
        if (sum == G) break;
        __builtin_amdgcn_s_sleep(1);
        if ((++sp & 255u) == 0u) { if (xb_ld(&bar[XB_TMO])) break; if (sp > XB_SPIN_CAP) { atomicAdd(&bar[XB_TMO], 1u); break; } }
    }
    nloc = mine > 0u ? mine : 1u; nx = cnt > 0u ? cnt : 1u;
}

__device__ __forceinline__ void xcd_barrier(const XcdBarrier& b) {
    asm volatile("s_waitcnt vmcnt(0)" ::: "memory");
    __syncthreads();
    if (threadIdx.x == 0) {
        unsigned* bar = b.bar;
        __builtin_amdgcn_s_waitcnt(0);
        unsigned nloc = b.st[0], nx = b.st[1];
        if (nloc == 0u) { xcd_barrier_complete(bar, b.x, nloc, nx); b.st[0] = nloc; b.st[1] = nx; }
        const unsigned old = xb_add(&bar[XB_XSUB(b.x)], 1u);
        const unsigned gen = old / nloc;
        if (old + 1u == (gen + 1u) * nloc) {
            __builtin_amdgcn_fence(__ATOMIC_RELEASE, "agent");
            asm volatile("s_waitcnt vmcnt(0)" ::: "memory");
            const unsigned og = xb_add(&bar[XB_TOP], 1u);
            const unsigned tg = og / nx;
            if (og + 1u == (tg + 1u) * nx) xb_add(&bar[XB_TOPGEN], 1u);
            else XB_SPIN(xb_ld(&bar[XB_TOPGEN]) == tg, bar);
            __builtin_amdgcn_fence(__ATOMIC_ACQUIRE, "agent");
            xb_add(&bar[XB_XGEN(b.x)], 1u);
            asm volatile("s_waitcnt vmcnt(0)" ::: "memory");
        } else {
            XB_SPIN(xb_ld(&bar[XB_XGEN(b.x)]) == gen, bar);
            __builtin_amdgcn_fence(__ATOMIC_ACQUIRE, "agent");
            asm volatile("s_waitcnt vmcnt(0)" ::: "memory");
        }
    }
    __syncthreads();
}

constexpr int N_PHASES = 2 + 9 * NL;
template <int MASK> __device__ __forceinline__ void run_phase(const Args& a, int ph, unsigned char* lds) {
    int G = gridDim.x, bid = blockIdx.x; asm volatile("" : "+s"(G), "+s"(bid));
    bf16_t* HB = (bf16_t*)(a.ws + WS_HBUF); float* XC = (float*)(a.ws + WS_XC); bf16_t* YD = (bf16_t*)(a.ws + WS_YD);
    if (ph == 0) { if constexpr (MASK & 1) {
        for (int t = bid; t < 192; t += G) modv_task(a, t, lds);
        for (int t = bid; t < 256; t += G) rope_task(a, t);
        wconv_loop(a, 0, bid, G, lds);
        for (int t = bid; t < 192; t += G) lwconv_task(a, 0, t); }
        return;
    }
    if (ph == 1) { if constexpr (MASK & 2) row_pass(a, MT, nullptr, nullptr, 0, a.in[I_X], a.in[I_CTX], false, nullptr, nullptr, false, nullptr, 0, 0, true, a.in[I_NORMG] + 0, 0, 0, 1); return; }
    const int l = (ph - 2) / 9, s = (ph - 2) % 9;
    const bool last = (l == NL - 1);
    const float* ng = a.in[I_NORMG] + l * 4 * DM;
    const void* xl = l == 0 ? (const void*)a.in[I_X] : (const void*)a.out; const void* xc = l == 0 ? (const void*)a.in[I_CTX] : (const void*)XC;
    void* xmid = last ? (void*)(a.ws + WS_PXA) : (void*)a.out;
    float* YP = (float*)(a.ws + WS_YP);
    const int mpost = last ? ML : MT;
    switch (s) {
    case 0: if constexpr (MASK & 4) { pg8::Gemm g{HB, (const bf16_t*)(a.ws + wbase(l)), MT, NIN, DM, DM}; pg8::StaticOrder S; S.init(MT, NIN, G, bid);
              EpiIn E{(bf16_t*)(a.ws + WS_PXA), (bf16_t*)(a.ws + WS_PXR)};
              pg8::gemm_phase<EpiIn, pg8::StaticOrder, true, true>((PG8_LAS unsigned char*)lds, g, S, E); } break;
    case 1: if constexpr (MASK & 8) { if (bid < PREP_EARLY) { PrepRegs R; prep_issue_loads(R, (const bf16_t*)(a.ws + WS_PXR), prep_tile_of(bid), opaque_tid());
              for (int o = bid; o < PREP_EARLY; o += G) rwkv_prep_tile(a, l, prep_tile_of(o), o + G < PREP_EARLY ? prep_tile_of(o + G) : -1, R, lds); } } break;
    case 2: if constexpr (MASK & 16) { unsigned* pcnt = (unsigned*)(a.ws + WS_CTL) + CW_PREP + 64 * (l * 8);
            if (bid < 128) { for (int rep = 0; rep <= PROBE_SCAN; ++rep) scan_task(a, bid, pcnt, lds); }
            else { { const int w = bid - 128, nw = G - 128;
                if (PREP_EARLY + w < PREP_TILES) { PrepRegs R; prep_issue_loads(R, (const bf16_t*)(a.ws + WS_PXR), prep_tile_of(PREP_EARLY + w), opaque_tid());
                  for (int o = PREP_EARLY + w; o < PREP_TILES; o += nw) { rwkv_prep_tile(a, l, prep_tile_of(o), o + nw < PREP_TILES ? prep_tile_of(o + nw) : -1, R, lds); prep_publish(pcnt + 64 * ((o - PREP_EARLY) / nw)); } } }
            for (int rep = 0; rep <= PROBE_ATT; ++rep) { const int w = bid - 128, nw = G - 128; const int natt = last ? 256 : 272, ngm = last ? 128 : 136;
                for (int u = w; u < natt + ngm; u += nw) { if (u < natt) attn_unit(a, l, u, lds); else gmlp_unit(a, l, u - natt, lds); }
                if (!last && rep == 0) { wconv_loop(a, l + 1, w, nw, lds); for (int t = w; t < 192; t += nw) lwconv_task(a, l + 1, t); } } } } break;
    case 3: if constexpr (MASK & 32) rwkv_out(a, l, mpost); break;
    case 4: if constexpr (MASK & 64) {
              { pg8::Gemm g{HB, (const bf16_t*)(a.ws + wbase(l) + WO_OUT), ML, DM, DM, DM}; pg8::StaticOrder S; S.init(ML, DM, G, bid);
                EpiBf16Out E{YD}; pg8::gemm_phase<EpiBf16Out, pg8::StaticOrder, true, true>((PG8_LAS unsigned char*)lds, g, S, E); }
              if (!last) { const int piece = bid, sl = piece >> 4; PieceOrder S{piece & 15, piece < 64};
                pg8::Gemm g{HB + (size_t)ML * DM + (sl & 3) * 256, (const bf16_t*)(a.ws + wbase(l) + WO_OUT) + (sl & 3) * 256, MC, DM, 256, DM};
                EpiF32 E{YP + (size_t)(sl & 3) * MC * DM}; pg8::gemm_phase<EpiF32, PieceOrder, true, true>((PG8_LAS unsigned char*)lds, g, S, E); } } break;
    case 5: if constexpr (MASK & 2) row_pass(a, mpost, YD, YP, 4, xl, xc, l != 0, xmid, XC, true, ng + 1 * DM, l, 2, true, ng + 2 * DM, l, 3, 4); break;
    case 6: if constexpr (MASK & 128) { pg8::Gemm g{HB, (const bf16_t*)(a.ws + wbase(l) + WO_GU), mpost, 2 * DFF, DM, DM}; pg8::StaticOrder S; S.init(mpost, 2 * DFF, G, bid);
              EpiSwiglu E{(bf16_t*)(a.ws + WS_ACT)}; pg8::gemm_phase<EpiSwiglu, pg8::StaticOrder, true, true>((PG8_LAS unsigned char*)lds, g, S, E); } break;
    case 7: if constexpr (MASK & 512) {
              { pg8::Gemm g{(const bf16_t*)(a.ws + WS_ACT), (const bf16_t*)(a.ws + wbase(l) + WO_DN), ML, DM, DFF, DFF}; pg8::StaticOrder S; S.init(ML, DM, G, bid);
                EpiBf16Out E{YD}; pg8::gemm_phase<EpiBf16Out, pg8::StaticOrder, true, true>((PG8_LAS unsigned char*)lds, g, S, E); }
              if (!last) { const int piece = bid; int sl = piece >> 4; if (sl > 6) sl = 6; PieceOrder S{piece & 15, piece < 112};
                pg8::Gemm g{(const bf16_t*)(a.ws + WS_ACT) + (size_t)ML * DFF + sl * 384, (const bf16_t*)(a.ws + wbase(l) + WO_DN) + sl * 384, MC, DM, sl == 6 ? 512 : 384, DFF};
                EpiF32 E{YP + (size_t)sl * MC * DM}; pg8::gemm_phase<EpiF32, PieceOrder, true, true>((PG8_LAS unsigned char*)lds, g, S, E); } } break;
    case 8: if constexpr (MASK & 256) {
              row_pass(a, mpost, YD, YP, 7, xmid, XC, true, a.out, XC, !last, ng + 3 * DM, l, 5, !last, a.in[I_NORMG] + (last ? 0 : (l + 1) * 4 * DM), last ? 0 : l + 1, 0, 1); } break;
    }
}

template <int MASK> __global__ void __launch_bounds__(NTHR) trunk_fwd(Args args) {
    extern __shared__ __attribute__((aligned(16))) unsigned char lds[];
    cg::grid_group grid = cg::this_grid();
    if (args.ph_lo > args.ph_hi) grid.sync();
    if (threadIdx.x < 4) ((LAS unsigned*)((LAS unsigned char*)lds + LDS_BARST_OFF))[threadIdx.x] = 0u;
    __syncthreads();
    XcdBarrier bar = xcd_barrier_post((unsigned*)(args.ws + WS_CTL), (volatile LAS unsigned*)((LAS unsigned char*)lds + LDS_BARST_OFF));
#define GRID_SYNC() xcd_barrier(bar)
    for (int ph = args.ph_lo; ph < args.ph_hi; ++ph) {
        const int nrep = (ph == PROBE_PH) ? 2 : (PROBE_DUP && ph >= 2) ? 1 + ((PROBE_DUP >> ((ph - 2) % 9)) & 1) : 1;
        for (int rep = 0; rep < nrep; ++rep) {
            run_phase<MASK>(args, ph, lds);
            if (ph + 1 < args.ph_hi || rep + 1 < nrep) GRID_SYNC();
            for (int es = 0; es < PROBE_SYNC; ++es) GRID_SYNC();
        }
    }
}
__host__ inline int phase_mask(int ph) { if (ph == 0) return 1; if (ph == 1) return 2; const int s = (ph - 2) % 9; const int m[9] = {4, 8, 16, 32, 64, 2, 128, 512, 256}; return m[s]; }
__host__ inline const void* kernel_for(int mask) {
#if MK_PER_PHASE
    switch (mask) { case 1: return (const void*)trunk_fwd<1>; case 2: return (const void*)trunk_fwd<2>; case 4: return (const void*)trunk_fwd<4>; case 8: return (const void*)trunk_fwd<8>; case 16: return (const void*)trunk_fwd<16>;
        case 32: return (const void*)trunk_fwd<32>; case 64: return (const void*)trunk_fwd<64>; case 128: return (const void*)trunk_fwd<128>; case 256: return (const void*)trunk_fwd<256>; case 512: return (const void*)trunk_fwd<512>;
        default: return nullptr; }
#else
    (void)mask; return (const void*)trunk_fwd<1023>;
#endif
}

extern "C" void kernel_launch(void* const* d_in, const int* in_sizes, int n_in, void* d_out, int out_size, void* d_ws, size_t ws_size, hipStream_t stream) {
    static int grid = 0;
    if (grid == 0) {
        if (n_in != N_IN || out_size != ML * DM || ws_size < WS_END2) { fprintf(stderr, "kernel_launch: unexpected shapes: n_in %d out %d ws %zu (need %zu)\n", n_in, out_size, ws_size, (size_t)WS_END2); grid = -1; return; }
        int dev = 0, cus = 0, per_cu = 0;
        (void)hipGetDevice(&dev); (void)hipDeviceGetAttribute(&cus, hipDeviceAttributeMultiprocessorCount, dev);
#if MK_PER_PHASE
        for (int mk = 1; mk <= 512; mk <<= 1) {
#else
        for (int mk = 1023; mk <= 1023; ++mk) {
#endif
            if (hipFuncSetAttribute(kernel_for(mk), hipFuncAttributeMaxDynamicSharedMemorySize, LDS_BYTES) != hipSuccess) { fprintf(stderr, "kernel_launch: hipFuncSetAttribute failed\n"); grid = -1; return; }
            if (hipOccupancyMaxActiveBlocksPerMultiprocessor(&per_cu, kernel_for(mk), NTHR, LDS_BYTES) != hipSuccess || per_cu < 1) { fprintf(stderr, "kernel_launch: occupancy query says %d blocks per CU\n", per_cu); grid = -1; return; }
        }
        grid = cus;
        if (grid != 256) fprintf(stderr, "kernel_launch: note: %d CUs (the phase split assumes 256)\n", grid);
    }
    if (grid < 0) return;
    if (hipMemsetAsync((char*)d_ws + WS_CTL, 0, CTL_BYTES, stream) != hipSuccess) { fprintf(stderr, "kernel_launch: memset of the barrier words failed\n"); return; }
    Args a{};
    for (int i = 0; i < N_IN; ++i) a.in[i] = (const float*)d_in[i];
    a.out = (float*)d_out; a.ws = (unsigned char*)d_ws;
#if MK_PER_PHASE
    for (int ph = 0; ph < N_PHASES; ++ph) { a.ph_lo = ph; a.ph_hi = ph + 1; void* kargs[] = {&a};
        hipError_t e = hipLaunchCooperativeKernel(kernel_for(phase_mask(ph)), dim3(grid), dim3(NTHR), kargs, LDS_BYTES, stream);
        if (e != hipSuccess) { fprintf(stderr, "kernel_launch: launch of phase %d failed: %s\n", ph, hipGetErrorString(e)); break; } }
#else
    a.ph_lo = 0; a.ph_hi = N_PHASES; void* kargs[] = {&a};
    hipError_t e = hipLaunchCooperativeKernel(kernel_for(1023), dim3(grid), dim3(NTHR), kargs, LDS_BYTES, stream);
    if (e != hipSuccess) fprintf(stderr, "kernel_launch: cooperative launch failed: %s (grid %d)\n", hipGetErrorString(e), grid);
#endif
}
```

```cpp
#include <hip/hip_runtime.h>
#include <hip/hip_cooperative_groups.h>
#include <cstdio>
#include <cstdint>
namespace cg = cooperative_groups;
__device__ __forceinline__ int opaque_tid() { int t = threadIdx.x; asm volatile("" : "+v"(t)); return t; }
namespace pg8 {
#define PG8_LAS __attribute__((address_space(3)))
typedef unsigned short bf16_t;
typedef short bf16x8 __attribute__((ext_vector_type(8)));
typedef float f32x4 __attribute__((ext_vector_type(4)));
typedef unsigned u32x4 __attribute__((ext_vector_type(4)));
constexpr int BM = 256, BK = 64, HALF = 128, HTB = HALF * BK * 2  , STAGE_BYTES = 8 * HTB, NXCD = 8, WGM = 8;

__host__ __device__ __forceinline__ int lds_byte(int r, int c) { const int st = (r >> 4) * 2 + (c >> 5), rr = r & 15, cc = c & 31, ob = rr * 64 + cc * 2; return st * 1024 + (ob ^ (((ob >> 9) & 1) << 5)); }
__host__ __device__ __forceinline__ void stage_rc(int b, int& R, int& C) { const int st = b / 1024, sb = b % 1024, swz = sb ^ (((sb >> 9) & 1) << 5); R = (st >> 1) * 16 + swz / 64; C = (st & 1) * 32 + (swz % 64) / 2; }
__host__ __device__ __forceinline__ int perm32(int rho) { const int n = rho >> 4, i = rho & 15; return 8 * (i >> 2) + 4 * n + (i & 3); }

struct Unit { int pm, pn; };
struct Gemm { const bf16_t* A; const bf16_t* Bt; int M, N, K, ld; };

struct StaticOrder {
    int nM, nN, nwg, G, c;
    __host__ __device__ void init(int M, int N, int G_, int c_) { nM = M / BM; nN = N / BM; nwg = nM * nN; G = G_; c = c_; }
    __host__ __device__ bool next(int i, Unit& u) const {
        const long L = (long)i * G + c; if (L >= nwg) return false;
        int wgid = (int)L; { const int q = nwg / NXCD, r = nwg % NXCD, xcd = wgid % NXCD, off = wgid / NXCD; wgid = (xcd < r ? xcd * (q + 1) : r * (q + 1) + (xcd - r) * q) + off; }
        const int nig = WGM * nN, gid = wgid / nig, fm = gid * WGM, gsz = (nM - fm) < WGM ? (nM - fm) : WGM;
        u.pm = fm + ((wgid % nig) % gsz); u.pn = (wgid % nig) / gsz; return true;
    }
    __device__ __forceinline__ void a_ready(const Unit&) const {}
    __device__ __forceinline__ void done(const Unit&) const {}
};
__device__ __forceinline__ unsigned cvt_pk_bf16(float lo, float hi) { unsigned r; asm volatile("v_cvt_pk_bf16_f32 %0, %1, %2" : "=v"(r) : "v"(lo), "v"(hi)); return r; }
template <class Epi, class Sched, bool ALIGN_EPI = false, bool SP2 = false>
__device__ __forceinline__ void gemm_phase(PG8_LAS unsigned char* lds, const Gemm g, const Sched& S, const Epi& E) {
    const int tid = opaque_tid(), wid = __builtin_amdgcn_readfirstlane(tid >> 6), lane = tid & 63, wr = wid >> 2, wc = wid & 3, fr = lane & 15, fq = lane >> 4;
    const int K = g.ld, nt = g.K / BK;
    unsigned voffA[2], voffB[2];
#pragma unroll
    for (int i = 0; i < 2; ++i) { int R, C; stage_rc(tid * 16 + i * 8192, R, C); const int Rb = Epi::PERM ? ((R & ~31) + perm32(R & 31)) : R;
        voffA[i] = (unsigned)(R * K + C) * 2u; voffB[i] = (unsigned)(Rb * K + C) * 2u; }
    const size_t kstep = (size_t)(BK * 2);
    const size_t hstep = (size_t)HALF * K * 2;
    const size_t tstep = 2 * hstep;
    const unsigned ldsw = (unsigned)wid * 1024u;
    const int aoff = lds_byte(wr * 64 + fr, fq * 8), boff = lds_byte(wc * 32 + fr, fq * 8);
#define PG8_SA(b, h) (((b) * 2 + (h)) * HTB)
#define PG8_SB(b, h) ((4 + (b) * 2 + (h)) * HTB)
#define PG8_STAGE(bufoff, gbase, voff) do { _Pragma("unroll") for (int _i = 0; _i < 2; ++_i) \
        __builtin_amdgcn_global_load_lds((const unsigned*)((const char*)(gbase) + (voff)[_i]), (PG8_LAS unsigned*)(lds + (bufoff) + ldsw + _i * 8192), 16, 0, 0); } while (0)
#define PG8_LDA(dst, b, h) do { _Pragma("unroll") for (int m = 0; m < 4; ++m) _Pragma("unroll") for (int k = 0; k < 2; ++k) dst[m][k] = *(const PG8_LAS bf16x8*)(lds + PG8_SA(b, h) + aoff + m * 2048 + k * 1024); } while (0)
#define PG8_LDB(dst, b, h) do { _Pragma("unroll") for (int n = 0; n < 2; ++n) _Pragma("unroll") for (int k = 0; k < 2; ++k) dst[n][k] = *(const PG8_LAS bf16x8*)(lds + PG8_SB(b, h) + boff + n * 2048 + k * 1024); } while (0)
#define PG8_MMA(ai, bj, At, Bt) do { __builtin_amdgcn_s_setprio(1); _Pragma("unroll") for (int m = 0; m < 4; ++m) _Pragma("unroll") for (int n = 0; n < 2; ++n) _Pragma("unroll") for (int k = 0; k < 2; ++k) \
        acc[ai][bj][m][n] = __builtin_amdgcn_mfma_f32_16x16x32_bf16(Bt[n][k], At[m][k], acc[ai][bj][m][n], 0, 0, 0); __builtin_amdgcn_s_setprio(0); } while (0)
#define PG8_WAIT_V(n) asm volatile("s_waitcnt vmcnt(" #n ")" ::: "memory")
#define PG8_WAIT_L(n) asm volatile("s_waitcnt lgkmcnt(" #n ")" ::: "memory")
#define PG8_BAR __builtin_amdgcn_s_barrier()
#define PG8_SCHED __builtin_amdgcn_sched_barrier(0)
    Unit cur, nxt; int ui = 0;
    if (!S.next(0, cur)) return;
    f32x4 acc[2][2][4][2];
#pragma unroll
    for (int a = 0; a < 2; ++a)
#pragma unroll
        for (int b = 0; b < 2; ++b)
#pragma unroll
            for (int m = 0; m < 4; ++m)
#pragma unroll
                for (int n = 0; n < 2; ++n) acc[a][b][m][n] = (f32x4){0.f, 0.f, 0.f, 0.f};
    bf16x8 At[4][2], B0[2][2], B1[2][2];
    const char* cA = (const char*)g.A + (size_t)cur.pm * tstep; const char* cB = (const char*)g.Bt + (size_t)cur.pn * tstep;
    S.a_ready(cur);
    if constexpr (SP2) {
        PG8_STAGE(PG8_SB(0, 0), cB, voffB); PG8_STAGE(PG8_SB(0, 1), cB + hstep, voffB); PG8_STAGE(PG8_SA(0, 0), cA, voffA); PG8_STAGE(PG8_SA(0, 1), cA + hstep, voffA);
        if (wr == 1) PG8_BAR;
        PG8_WAIT_V(2); PG8_BAR;
        PG8_STAGE(PG8_SB(1, 0), cB + kstep, voffB); PG8_STAGE(PG8_SA(1, 0), cA + kstep, voffA); PG8_STAGE(PG8_SB(1, 1), cB + hstep + kstep, voffB);
        PG8_WAIT_V(6); PG8_BAR;
    } else {
        PG8_STAGE(PG8_SB(0, 0), cB, voffB); PG8_STAGE(PG8_SA(0, 0), cA, voffA); PG8_STAGE(PG8_SB(0, 1), cB + hstep, voffB); PG8_STAGE(PG8_SA(0, 1), cA + hstep, voffA);
        if (wr == 1) PG8_BAR;
        PG8_WAIT_V(4); PG8_BAR;
        PG8_STAGE(PG8_SB(1, 0), cB + kstep, voffB); PG8_STAGE(PG8_SA(1, 0), cA + kstep, voffA); PG8_STAGE(PG8_SB(1, 1), cB + hstep + kstep, voffB);
        PG8_WAIT_V(6); PG8_BAR;
    }
    for (;;) {
        const bool has_next = S.next(ui + 1, nxt);
        const char* nA = has_next ? (const char*)g.A + (size_t)nxt.pm * tstep : cA; const char* nB = has_next ? (const char*)g.Bt + (size_t)nxt.pn * tstep : cB;
        for (int t = 0; t < nt; t += 2) {
            const bool last = (t == nt - 2);
            const char* a1 = cA + (size_t)(t + 1) * kstep;
            const char* a2 = last ? nA : cA + (size_t)(t + 2) * kstep; const char* b2 = last ? nB : cB + (size_t)(t + 2) * kstep;
            const char* a3 = a2 + kstep; const char* b3 = b2 + kstep;
            if (last && has_next) S.a_ready(nxt);
            if constexpr (SP2) {
            PG8_LDB(B0, 0, 0); PG8_LDB(B1, 0, 1); PG8_SCHED; PG8_LDA(At, 0, 0); PG8_STAGE(PG8_SA(1, 1), a1 + hstep, voffA);
            PG8_WAIT_V(8); PG8_WAIT_L(0); PG8_BAR; PG8_MMA(0, 0, At, B0); PG8_MMA(0, 1, At, B1); PG8_BAR; PG8_SCHED;
            PG8_LDA(At, 0, 1); PG8_STAGE(PG8_SB(0, 0), b2, voffB); PG8_STAGE(PG8_SB(0, 1), b2 + hstep, voffB); PG8_STAGE(PG8_SA(0, 0), a2, voffA);
            PG8_WAIT_V(8); PG8_WAIT_L(0); PG8_BAR; PG8_MMA(1, 0, At, B0); PG8_MMA(1, 1, At, B1); PG8_BAR; PG8_SCHED;
            PG8_LDB(B0, 1, 0); PG8_LDB(B1, 1, 1); PG8_SCHED; PG8_LDA(At, 1, 0); PG8_STAGE(PG8_SA(0, 1), a2 + hstep, voffA);
            PG8_WAIT_V(8); PG8_WAIT_L(0); PG8_BAR; PG8_MMA(0, 0, At, B0); PG8_MMA(0, 1, At, B1); PG8_BAR; PG8_SCHED;
            PG8_LDA(At, 1, 1); PG8_STAGE(PG8_SB(1, 0), b3, voffB); PG8_STAGE(PG8_SB(1, 1), b3 + hstep, voffB); PG8_STAGE(PG8_SA(1, 0), a3, voffA);
            PG8_WAIT_V(8); PG8_WAIT_L(0); PG8_BAR; PG8_MMA(1, 0, At, B0); PG8_MMA(1, 1, At, B1); PG8_BAR; PG8_SCHED;
            } else {
            PG8_LDB(B0, 0, 0); PG8_SCHED; PG8_LDA(At, 0, 0); PG8_STAGE(PG8_SA(1, 1), a1 + hstep, voffA);
            PG8_WAIT_L(8); PG8_BAR; PG8_WAIT_L(0); PG8_MMA(0, 0, At, B0); PG8_BAR; PG8_SCHED;
            PG8_LDB(B1, 0, 1); PG8_STAGE(PG8_SB(0, 0), b2, voffB);
            PG8_BAR; PG8_WAIT_L(0); PG8_MMA(0, 1, At, B1); PG8_BAR;
            PG8_LDA(At, 0, 1); PG8_STAGE(PG8_SA(0, 0), a2, voffA);
            PG8_BAR; PG8_WAIT_L(0); PG8_MMA(1, 0, At, B0); PG8_BAR; PG8_SCHED;
            PG8_STAGE(PG8_SB(0, 1), b2 + hstep, voffB);
            PG8_WAIT_V(6); PG8_BAR; PG8_MMA(1, 1, At, B1); PG8_BAR;
            PG8_LDB(B0, 1, 0); PG8_SCHED; PG8_LDA(At, 1, 0); PG8_STAGE(PG8_SA(0, 1), a2 + hstep, voffA);
            PG8_WAIT_L(8); PG8_BAR; PG8_WAIT_L(0); PG8_MMA(0, 0, At, B0); PG8_BAR; PG8_SCHED;
            PG8_LDB(B1, 1, 1); PG8_STAGE(PG8_SB(1, 0), b3, voffB);
            PG8_BAR; PG8_WAIT_L(0); PG8_MMA(0, 1, At, B1); PG8_BAR;
            PG8_LDA(At, 1, 1); PG8_STAGE(PG8_SA(1, 0), a3, voffA);
            PG8_BAR; PG8_WAIT_L(0); PG8_MMA(1, 0, At, B0); PG8_BAR; PG8_SCHED;
            PG8_STAGE(PG8_SB(1, 1), b3 + hstep, voffB);
            PG8_WAIT_V(6); PG8_BAR; PG8_MMA(1, 1, At, B1); PG8_BAR;
            }
        }
        if constexpr (ALIGN_EPI) { if (wr == 0) PG8_BAR; }
        if constexpr (!Epi::AFTER_DRAIN) { E(acc, cur, wr, wc, fr, fq); S.done(cur); }
        if (!has_next) break;
#pragma unroll
        for (int a = 0; a < 2; ++a)
#pragma unroll
            for (int b = 0; b < 2; ++b)
#pragma unroll
                for (int m = 0; m < 4; ++m)
#pragma unroll
                    for (int n = 0; n < 2; ++n) acc[a][b][m][n] = (f32x4){0.f, 0.f, 0.f, 0.f};
        cur = nxt; cA = nA; cB = nB; ++ui;
        if constexpr (ALIGN_EPI) { if (wr == 1) PG8_BAR; }
    }
    PG8_WAIT_V(0);
    if constexpr (!ALIGN_EPI) { if (wr == 0) PG8_BAR; }
    PG8_BAR;
    if constexpr (Epi::AFTER_DRAIN) { E.fused(acc, cur, wr, wc, fr, fq, lds, wid, lane); S.done(cur); }
#undef PG8_SA
#undef PG8_SB
#undef PG8_STAGE
#undef PG8_LDA
#undef PG8_LDB
#undef PG8_MMA
#undef PG8_WAIT_V
#undef PG8_WAIT_L
#undef PG8_BAR
#undef PG8_SCHED
}
}

#ifndef PROBE_DUP
#define PROBE_DUP 0
#endif
#ifndef PROBE_PH
#define PROBE_PH -1
#endif
#ifndef PROBE_SYNC
#define PROBE_SYNC 0
#endif
#ifndef PROBE_SCANC
#define PROBE_SCANC 0
#endif
#ifndef PROBE_SCAN
#define PROBE_SCAN 0
#endif
#ifndef PROBE_ATT
#define PROBE_ATT 0
#endif
#ifndef MK_PER_PHASE
#define MK_PER_PHASE 0
#endif
using pg8::bf16_t; using pg8::bf16x8; using pg8::f32x4; using pg8::u32x4;
typedef __bf16 bf16x2v __attribute__((ext_vector_type(2)));
typedef float f32x2c __attribute__((ext_vector_type(2)));
__device__ __forceinline__ unsigned cvt_pk_bf16(float lo, float hi) { const f32x2c v = {lo, hi}; return __builtin_bit_cast(unsigned, __builtin_convertvector(v, bf16x2v)); }
typedef unsigned u32x2 __attribute__((ext_vector_type(2)));
typedef short bf16x4 __attribute__((ext_vector_type(4)));

constexpr int DM = 1024, NB = 4, TL = 4096, CL = 256, NL = 4;
constexpr int ML = NB * TL, MC = NB * CL, MT = ML + MC;
constexpr int NIN = 2560, NPXA = 1280, NPXR = 1152, DFF = 2816, INC = 2432;
constexpr int NTHR = 512;
constexpr int LDS_BYTES = 147456;
constexpr size_t MiB = 1u << 20;
constexpr size_t WS_MODV = 0, WS_ROPE = 1 * MiB, WS_XC = 2 * MiB, WS_WIN = 6 * MiB, WS_WOUT = 11 * MiB, WS_WGU = 13 * MiB, WS_WDN = 24 * MiB;
constexpr size_t WS_HBUF = 30 * MiB, WS_PXA = 64 * MiB, WS_PXR = 107 * MiB, WS_PREP = 184 * MiB, WS_END = 354 * MiB;
constexpr size_t WS_WB1 = 146 * MiB;
constexpr size_t WS_LW = 512 * 1024, WS_LW1 = 832 * 1024;
__device__ __forceinline__ size_t wbase(int l) { return (l & 1) ? WS_WB1 : WS_WIN; }
__device__ __forceinline__ size_t lwbase(int l) { return (l & 1) ? WS_LW1 : WS_LW; }
constexpr size_t WO_OUT = 5 * MiB, WO_GU = 7 * MiB, WO_DN = 18 * MiB;
constexpr size_t WS_YS = 312 * MiB;
constexpr size_t WS_ACT = WS_PREP, WS_YD = 278 * MiB, WS_YP = 346 * MiB, WS_END2 = 374 * MiB;
constexpr size_t PREP_W = 0, PREP_KA = (size_t)MT * 512 * 4, PREP_KD = 2 * PREP_KA, PREP_KK = PREP_KD + (size_t)MT * 512 * 2, PREP_R = PREP_KK + (size_t)MT * 256 * 4,
                 PREP_V = PREP_R + (size_t)MT * 256 * 2, PREP_G = PREP_V + (size_t)MT * 256 * 2;
static_assert(WS_HBUF + (size_t)MT * 1024 * 2 <= WS_PXA && WS_PXA + (size_t)MT * NPXA * 2 <= WS_PXR && WS_PXR + (size_t)MT * NPXR * 4 <= WS_PREP, "ws map 1");
static_assert(WS_PREP + PREP_G + (size_t)MT * 256 * 2 <= WS_YS && WS_YS + (size_t)MT * 512 * 4 <= WS_YP && WS_ACT + (size_t)MT * DFF * 2 <= WS_YD && WS_YD + (size_t)MT * 1024 * 4 <= WS_END, "ws map 2");

enum { I_X = 0, I_C, I_CTX, I_CCTX, I_WMOD, I_BMOD, I_NORMG, I_WIN, I_WOUT, I_SGLNG, I_SGLNB, I_SGW, I_SGB, I_SINK, I_MU, I_W0, I_W2, I_A0, I_A2, I_KK, I_KA, I_RK, I_G2, I_LNXG, I_LNXB, I_WGU, I_WDN, N_IN };
struct Args { const float* in[N_IN]; float* out; unsigned char* ws; int ph_lo, ph_hi; };

__device__ __forceinline__ float bf2f(unsigned short h) { return __builtin_bit_cast(float, (unsigned)h << 16); }
__device__ __forceinline__ unsigned cvt_pk_bf16(float lo, float hi);
__device__ __forceinline__ unsigned short f2bf(float f) { return (unsigned short)(cvt_pk_bf16(f, 0.f) & 0xffffu); }
__device__ __forceinline__ f32x4 bf4_to_f32(u32x2 r) { f32x4 o; o[0] = __builtin_bit_cast(float, r.x << 16); o[1] = __builtin_bit_cast(float, r.x & 0xffff0000u); o[2] = __builtin_bit_cast(float, r.y << 16); o[3] = __builtin_bit_cast(float, r.y & 0xffff0000u); return o; }
__device__ __forceinline__ u32x2 f32_to_bf4(f32x4 v) { u32x2 w; w.x = cvt_pk_bf16(v[0], v[1]); w.y = cvt_pk_bf16(v[2], v[3]); return w; }
template <int CTRL> __device__ __forceinline__ float dppf(float x) { return __builtin_bit_cast(float, __builtin_amdgcn_mov_dpp(__builtin_bit_cast(int, x), CTRL, 0xf, 0xf, true)); }
__device__ __forceinline__ float row16_sum(float x) { x += dppf<0xB1>(x); x += dppf<0x4E>(x); x += dppf<0x141>(x); x += dppf<0x128>(x); return x; }
__device__ __forceinline__ float wave_sum(float v) {
    v = row16_sum(v);
    const float r0 = __builtin_bit_cast(float, __builtin_amdgcn_readlane(__builtin_bit_cast(int, v), 0)), r1 = __builtin_bit_cast(float, __builtin_amdgcn_readlane(__builtin_bit_cast(int, v), 16)),
                r2 = __builtin_bit_cast(float, __builtin_amdgcn_readlane(__builtin_bit_cast(int, v), 32)), r3 = __builtin_bit_cast(float, __builtin_amdgcn_readlane(__builtin_bit_cast(int, v), 48));
    return (r0 + r1) + (r2 + r3);
}
__device__ __forceinline__ float gelu_tanh(float x) { const float u = 0.7978845608028654f * (x + 0.044715f * x * x * x); const float t = 1.f - 2.f * __builtin_amdgcn_rcpf(1.f + __expf(2.f * u)); return 0.5f * x * (1.f + t); }
__device__ __forceinline__ float sigmoidf_(float x) { return 1.f / (1.f + __expf(-x)); }

struct EpiIn {
    static constexpr bool PERM = true, AFTER_DRAIN = false;
    bf16_t* pxa; bf16_t* pxr;
    __device__ __forceinline__ void operator()(const f32x4 (&acc)[2][2][4][2], const pg8::Unit& u, int wr, int wc, int fr, int fq) const {
        const int row0 = u.pm * 256 + wr * 64 + fr, colt = u.pn * 256 + wc * 32 + 8 * fq;
#pragma unroll
        for (int ai = 0; ai < 2; ++ai)
#pragma unroll
            for (int m = 0; m < 4; ++m) { const size_t row = (size_t)(row0 + ai * 128 + m * 16);
#pragma unroll
                for (int bj = 0; bj < 2; ++bj) { const int col = colt + bj * 128; const f32x4 v0 = acc[ai][bj][m][0], v1 = acc[ai][bj][m][1];
                    u32x4 w; w.x = cvt_pk_bf16(v0[0], v0[1]); w.y = cvt_pk_bf16(v0[2], v0[3]); w.z = cvt_pk_bf16(v1[0], v1[1]); w.w = cvt_pk_bf16(v1[2], v1[3]);
                    if (u.pn < 5) *(u32x4*)(pxa + row * NPXA + col) = w;
                    else { const int cc = col - NPXA; if (cc < NPXR) *(u32x4*)(pxr + row * NPXR + cc) = w; } } }
    }
};
struct EpiF32 {
    static constexpr bool PERM = true, AFTER_DRAIN = false;
    float* O; static constexpr int ldc = DM;
    __device__ __forceinline__ void operator()(const f32x4 (&acc)[2][2][4][2], const pg8::Unit& u, int wr, int wc, int fr, int fq) const {
        const int row0 = u.pm * 256 + wr * 64 + fr, colt = u.pn * 256 + wc * 32 + 8 * fq;
#pragma unroll
        for (int ai = 0; ai < 2; ++ai)
#pragma unroll
            for (int m = 0; m < 4; ++m) { float* rp = O + (size_t)(row0 + ai * 128 + m * 16) * ldc + colt;
#pragma unroll
                for (int bj = 0; bj < 2; ++bj) { *(f32x4*)(rp + bj * 128) = acc[ai][bj][m][0]; *(f32x4*)(rp + bj * 128 + 4) = acc[ai][bj][m][1]; } }
    }
};
struct EpiBf16Out {
    static constexpr bool PERM = true, AFTER_DRAIN = false;
    bf16_t* O;
    __device__ __forceinline__ void operator()(const f32x4 (&acc)[2][2][4][2], const pg8::Unit& u, int wr, int wc, int fr, int fq) const {
        const int row0 = u.pm * 256 + wr * 64 + fr, colt = u.pn * 256 + wc * 32 + 8 * fq;
#pragma unroll
        for (int ai = 0; ai < 2; ++ai)
#pragma unroll
            for (int m = 0; m < 4; ++m) { bf16_t* rp = O + (size_t)(row0 + ai * 128 + m * 16) * DM + colt;
#pragma unroll
                for (int bj = 0; bj < 2; ++bj) { const f32x4 v0 = acc[ai][bj][m][0], v1 = acc[ai][bj][m][1];
                    u32x4 w; w.x = cvt_pk_bf16(v0[0], v0[1]); w.y = cvt_pk_bf16(v0[2], v0[3]); w.z = cvt_pk_bf16(v1[0], v1[1]); w.w = cvt_pk_bf16(v1[2], v1[3]);
                    *(u32x4*)(rp + bj * 128) = w; } }
    }
};
struct EpiSwiglu {
    static constexpr bool PERM = true, AFTER_DRAIN = false;
    bf16_t* O;
    __device__ __forceinline__ void operator()(const f32x4 (&acc)[2][2][4][2], const pg8::Unit& u, int wr, int wc, int fr, int fq) const {
        const int row0 = u.pm * 256 + wr * 64 + fr, col = u.pn * 128 + wc * 32 + 8 * fq;
#pragma unroll
        for (int ai = 0; ai < 2; ++ai)
#pragma unroll
            for (int m = 0; m < 4; ++m) { float r[8];
#pragma unroll
                for (int n = 0; n < 2; ++n)
#pragma unroll
                    for (int j = 0; j < 4; ++j) { const float g = acc[ai][0][m][n][j], up = acc[ai][1][m][n][j]; r[n * 4 + j] = g * __builtin_amdgcn_rcpf(1.f + __expf(-g)) * up; }
                u32x4 w; w.x = cvt_pk_bf16(r[0], r[1]); w.y = cvt_pk_bf16(r[2], r[3]); w.z = cvt_pk_bf16(r[4], r[5]); w.w = cvt_pk_bf16(r[6], r[7]);
                *(u32x4*)(O + (size_t)(row0 + ai * 128 + m * 16) * DFF + col) = w; }
    }
};

__device__ __forceinline__ void modv_task(const Args& a, int task, unsigned char* lds) {
    float* act = (float*)lds; float* red = act + 5 * 1024;
    const int tid = opaque_tid();
    for (int i = tid; i < 5 * 1024; i += NTHR) { const int r = i >> 10, k = i & 1023; const float v = r < 4 ? a.in[I_C][r * 1024 + k] : a.in[I_CCTX][k]; act[i] = v / (1.f + expf(-v)); }
    __syncthreads();
    const int l = task / 48, cb = task % 48, cl = tid & 127, kq = tid >> 7;
    const float* W = a.in[I_WMOD] + (size_t)l * 1024 * 6144 + cb * 128 + cl;
    float a0 = 0.f, a1 = 0.f, a2 = 0.f, a3 = 0.f, a4 = 0.f;
    for (int k0 = kq * 256; k0 < kq * 256 + 256; k0 += 16) { float wv[16];
#pragma unroll
        for (int u = 0; u < 16; ++u) wv[u] = W[(size_t)(k0 + u) * 6144];
#pragma unroll
        for (int u = 0; u < 16; ++u) { const int k = k0 + u; const float w = wv[u]; a0 += act[k] * w; a1 += act[1024 + k] * w; a2 += act[2048 + k] * w; a3 += act[3072 + k] * w; a4 += act[4096 + k] * w; } }
    red[(kq * 5 + 0) * 128 + cl] = a0; red[(kq * 5 + 1) * 128 + cl] = a1; red[(kq * 5 + 2) * 128 + cl] = a2; red[(kq * 5 + 3) * 128 + cl] = a3; red[(kq * 5 + 4) * 128 + cl] = a4;
    __syncthreads();
    float* modv = (float*)(a.ws + WS_MODV);
    for (int i = tid; i < 640; i += NTHR) { const int r = i >> 7, c2 = i & 127;
        const float s = red[(0 * 5 + r) * 128 + c2] + red[(1 * 5 + r) * 128 + c2] + red[(2 * 5 + r) * 128 + c2] + red[(3 * 5 + r) * 128 + c2];
        modv[(size_t)(l * 5 + r) * 6144 + cb * 128 + c2] = s + a.in[I_BMOD][l * 6144 + cb * 128 + c2]; }
    __syncthreads();
}
__device__ __forceinline__ void rope_task(const Args& a, int task) {
    const int idx = task * NTHR + opaque_tid(); const int t = idx >> 5, j = idx & 31, axis = j >> 4, f = j & 15;
    const float pos = (float)(axis == 0 ? (t >> 6) : (t & 63));
    const float inv = powf(10000.0f, -(float)f / 16.0f);
    const float ang = pos * inv;
    float* rc = (float*)(a.ws + WS_ROPE); float* rs = rc + TL * 32;
    rc[idx] = cosf(ang); rs[idx] = sinf(ang);
}
constexpr int WCONV_TASKS = 640 + 256 + 1408 + 704;
struct WconvDesc { const float* src; bf16_t* dst; int Ksz, Nsrc, kt, n0, sc0; bool zero; };
__device__ __forceinline__ WconvDesc wconv_decode(const Args& a, int l, int task) {
    WconvDesc D; D.zero = false;
    if (task < 640) { const int nt = task >> 4; D.kt = task & 15; D.Ksz = 1024; D.Nsrc = INC; D.src = a.in[I_WIN] + (size_t)l * 1024 * INC; D.dst = (bf16_t*)(a.ws + wbase(l)); D.n0 = nt * 64; const int n0 = D.n0;
        if (n0 < 1024) D.sc0 = n0; else if (n0 < 1280) D.sc0 = 1408 + (n0 - 1024); else if (n0 < 1664) D.sc0 = 1024 + (n0 - 1280); else if (n0 < 2432) D.sc0 = n0; else { D.sc0 = 0; D.zero = true; } }
    else if (task < 896) { const int t = task - 640; const int nt = t >> 4; D.kt = t & 15; D.Ksz = 1024; D.Nsrc = 1024; D.src = a.in[I_WOUT] + (size_t)l * 1024 * 1024; D.dst = (bf16_t*)(a.ws + wbase(l) + WO_OUT); D.n0 = nt * 64; D.sc0 = D.n0; }
    else if (task < 2304) { const int t = task - 896; const int nt = t >> 4; D.kt = t & 15; D.Ksz = 1024; D.Nsrc = 2 * DFF; D.src = a.in[I_WGU] + (size_t)l * 1024 * 2 * DFF; D.dst = (bf16_t*)(a.ws + wbase(l) + WO_GU); D.n0 = nt * 64;
        const int tt = D.n0 >> 8, bj = (D.n0 >> 7) & 1, jj = D.n0 & 127; D.sc0 = bj * DFF + tt * 128 + jj; }
    else { const int t = task - 2304; const int nt = t / 44; D.kt = t % 44; D.Ksz = DFF; D.Nsrc = 1024; D.src = a.in[I_WDN] + (size_t)l * DFF * 1024; D.dst = (bf16_t*)(a.ws + wbase(l) + WO_DN); D.n0 = nt * 64; D.sc0 = D.n0; }
    return D;
}
__device__ __forceinline__ void wconv_issue(f32x4 (&v)[2], const WconvDesc& D, int tid) {
    const int c4 = tid & 15;
#pragma unroll
    for (int h = 0; h < 2; ++h) { const int kr = (tid >> 4) + 32 * h; v[h] = (f32x4){0.f, 0.f, 0.f, 0.f};
        if (!D.zero) v[h] = *(const f32x4*)(D.src + (size_t)(D.kt * 64 + kr) * D.Nsrc + D.sc0 + c4 * 4); }
}
__device__ __forceinline__ void wconv_loop(const Args& a, int l, int first, int stride, unsigned char* lds) {
    if (first >= WCONV_TASKS) return;
    const int tid = opaque_tid();
    float* tile = (float*)lds;
    f32x4 v[2]; WconvDesc D = wconv_decode(a, l, first); wconv_issue(v, D, tid);
    for (int task = first; task < WCONV_TASKS; task += stride) {
        { const int c4 = tid & 15;
#pragma unroll
          for (int h = 0; h < 2; ++h) { const int kr = (tid >> 4) + 32 * h;
              tile[kr * 65 + c4 * 4 + 0] = v[h][0]; tile[kr * 65 + c4 * 4 + 1] = v[h][1]; tile[kr * 65 + c4 * 4 + 2] = v[h][2]; tile[kr * 65 + c4 * 4 + 3] = v[h][3]; } }
        __syncthreads();
        const WconvDesc C = D;
        if (task + stride < WCONV_TASKS) { D = wconv_decode(a, l, task + stride); wconv_issue(v, D, tid); }
        { const int n = tid >> 3, k8 = tid & 7; float r[8];
#pragma unroll
          for (int i = 0; i < 8; ++i) r[i] = tile[(k8 * 8 + i) * 65 + n];
          u32x4 w; w.x = cvt_pk_bf16(r[0], r[1]); w.y = cvt_pk_bf16(r[2], r[3]); w.z = cvt_pk_bf16(r[4], r[5]); w.w = cvt_pk_bf16(r[6], r[7]);
          *(u32x4*)(C.dst + (size_t)(C.n0 + n) * C.Ksz + C.kt * 64 + k8 * 8) = w; }
        __syncthreads();
    }
}

struct RowRegs { f32x4 xv[4], yv[4]; };
__device__ __forceinline__ void row_load(RowRegs& R, int row, int lane, const bf16_t* y, const float* ypart, int nsl, const void* xl_src, const void* xc_src, bool xbf) {
    if (xbf) { const bf16_t* xs = row < ML ? (const bf16_t*)xl_src + (size_t)row * DM : (const bf16_t*)xc_src + (size_t)(row - ML) * DM;
#pragma unroll
        for (int j = 0; j < 4; ++j) R.xv[j] = bf4_to_f32(*(const u32x2*)(xs + j * 256 + lane * 4)); }
    else { const float* xs = row < ML ? (const float*)xl_src + (size_t)row * DM : (const float*)xc_src + (size_t)(row - ML) * DM;
#pragma unroll
        for (int j = 0; j < 4; ++j) R.xv[j] = *(const f32x4*)(xs + j * 256 + lane * 4); }
    if (y) {
        if (row < ML) {
#pragma unroll
            for (int j = 0; j < 4; ++j) R.yv[j] = bf4_to_f32(*(const u32x2*)(y + (size_t)row * DM + j * 256 + lane * 4));
        } else {
#pragma unroll
            for (int j = 0; j < 4; ++j) R.yv[j] = (f32x4){0.f, 0.f, 0.f, 0.f};
#pragma unroll
            for (int sl = 0; sl < 7; ++sl) if (sl < nsl) {
#pragma unroll
                for (int j = 0; j < 4; ++j) R.yv[j] += *(const f32x4*)(ypart + ((size_t)sl * MC + (row - ML)) * DM + j * 256 + lane * 4); }
        }
    }
}
__device__ __forceinline__ void row_process(const Args& a, RowRegs& C, int row, int lane, bool has_y, void* xl_dst, void* xc_dst, bool obf,
                         const f32x4 (&gyv)[4], int l_gate, int gate_idx, bool do_h, const f32x4 (&ghv)[4], int l_h, int shift_idx, int scale_idx, f32x4 (&gtv)[4], f32x4 (&s1v)[4], f32x4 (&s2v)[4], int& cur) {
    const float* modv = (const float*)(a.ws + WS_MODV); bf16_t* hbuf = (bf16_t*)(a.ws + WS_HBUF);
    const int mrow = row < ML ? (row >> 12) : 4;
    if (mrow != cur) { cur = mrow;
    if (has_y) { const float* gate = modv + (size_t)(l_gate * 5 + mrow) * 6144 + gate_idx * 1024;
#pragma unroll
        for (int j = 0; j < 4; ++j) gtv[j] = *(const f32x4*)(gate + j * 256 + lane * 4); }
    if (do_h) { const float* sh = modv + (size_t)(l_h * 5 + mrow) * 6144 + shift_idx * 1024; const float* sc = modv + (size_t)(l_h * 5 + mrow) * 6144 + scale_idx * 1024;
#pragma unroll
        for (int j = 0; j < 4; ++j) { s1v[j] = *(const f32x4*)(sh + j * 256 + lane * 4); s2v[j] = *(const f32x4*)(sc + j * 256 + lane * 4); } } }
    if (has_y) {
        float ss = 0.f;
#pragma unroll
        for (int j = 0; j < 4; ++j) ss += C.yv[j][0] * C.yv[j][0] + C.yv[j][1] * C.yv[j][1] + C.yv[j][2] * C.yv[j][2] + C.yv[j][3] * C.yv[j][3];
        ss = wave_sum(ss); const float rstd = __builtin_amdgcn_rsqf(ss * (1.f / 1024.f) + 1e-6f);
#pragma unroll
        for (int j = 0; j < 4; ++j) C.xv[j] = C.xv[j] + gtv[j] * (C.yv[j] * rstd * gyv[j]);
        if (obf) { bf16_t* xd = row < ML ? (bf16_t*)xl_dst + (size_t)row * DM : (bf16_t*)xc_dst + (size_t)(row - ML) * DM;
#pragma unroll
            for (int j = 0; j < 4; ++j) { const u32x2 w = f32_to_bf4(C.xv[j]); *(u32x2*)(xd + j * 256 + lane * 4) = w; C.xv[j] = bf4_to_f32(w); } }
        else { float* xd = row < ML ? (float*)xl_dst + (size_t)row * DM : (float*)xc_dst + (size_t)(row - ML) * DM;
#pragma unroll
            for (int j = 0; j < 4; ++j) *(f32x4*)(xd + j * 256 + lane * 4) = C.xv[j]; }
    }
    if (do_h) {
        float ss = 0.f;
#pragma unroll
        for (int j = 0; j < 4; ++j) ss += C.xv[j][0] * C.xv[j][0] + C.xv[j][1] * C.xv[j][1] + C.xv[j][2] * C.xv[j][2] + C.xv[j][3] * C.xv[j][3];
        ss = wave_sum(ss); const float rstd = __builtin_amdgcn_rsqf(ss * (1.f / 1024.f) + 1e-6f);
#pragma unroll
        for (int j = 0; j < 4; ++j) { const f32x4 h = (C.xv[j] * rstd * ghv[j]) * (1.f + s2v[j]) + s1v[j];
            u32x2 w; w.x = cvt_pk_bf16(h[0], h[1]); w.y = cvt_pk_bf16(h[2], h[3]);
            *(u32x2*)(hbuf + (size_t)row * DM + j * 256 + lane * 4) = w; }
    }
}
__device__ __forceinline__ void row_pass(const Args& a, int mrows, const bf16_t* y, const float* ypart, int nsl, const void* xl_src, const void* xc_src, bool xbf, void* xl_dst, void* xc_dst, bool obf,
                         const float* gy, int l_gate, int gate_idx, bool do_h, const float* gh, int l_h, int shift_idx, int scale_idx) {
    const int tid = opaque_tid(); const int lane = tid & 63, wave = tid >> 6;
    const int stride = gridDim.x * 8;
    int row = blockIdx.x * 8 + wave;
    f32x4 gyv[4], ghv[4];
#pragma unroll
    for (int j = 0; j < 4; ++j) { gyv[j] = y ? *(const f32x4*)(gy + j * 256 + lane * 4) : (f32x4){0.f, 0.f, 0.f, 0.f}; ghv[j] = do_h ? *(const f32x4*)(gh + j * 256 + lane * 4) : (f32x4){0.f, 0.f, 0.f, 0.f}; }
    f32x4 gtv[4], s1v[4], s2v[4]; int cur = -1;
#pragma unroll
    for (int j = 0; j < 4; ++j) { gtv[j] = (f32x4){0.f, 0.f, 0.f, 0.f}; s1v[j] = gtv[j]; s2v[j] = gtv[j]; }
    RowRegs N0, N1;
    if (row < mrows) row_load(N0, row, lane, y, ypart, nsl, xl_src, xc_src, xbf);
    if (row + stride < mrows) row_load(N1, row + stride, lane, y, ypart, nsl, xl_src, xc_src, xbf);
    for (; row < mrows; row += 2 * stride) {
        RowRegs C0 = N0, C1 = N1;
        const bool two = row + stride < mrows;
        if (row + 2 * stride < mrows) row_load(N0, row + 2 * stride, lane, y, ypart, nsl, xl_src, xc_src, xbf);
        if (row + 3 * stride < mrows) row_load(N1, row + 3 * stride, lane, y, ypart, nsl, xl_src, xc_src, xbf);
        row_process(a, C0, row, lane, y != nullptr, xl_dst, xc_dst, obf, gyv, l_gate, gate_idx, do_h, ghv, l_h, shift_idx, scale_idx, gtv, s1v, s2v, cur);
        if (two) row_process(a, C1, row + stride, lane, y != nullptr, xl_dst, xc_dst, obf, gyv, l_gate, gate_idx, do_h, ghv, l_h, shift_idx, scale_idx, gtv, s1v, s2v, cur);
    }
}


__device__ __forceinline__ void lwconv_task(const Args& a, int l, int frag) {
    const int tid = opaque_tid(); const int lane = tid >> 3, j = tid & 7;
    const float* W; int ct, ks;
    if (frag < 128) { const int m = frag >> 6, rem = frag & 63, d = rem >> 5; ct = (rem >> 1) & 15; ks = rem & 1; W = (m == 0 ? a.in[I_W2] : a.in[I_A2]) + (size_t)(l * 2 + d) * 64 * 256; }
    else { const int rem = frag - 128; ct = rem >> 2; ks = rem & 3; W = a.in[I_G2] + (size_t)l * 128 * 256; }
    const int r = ks * 32 + (lane >> 4) * 8 + j, c = ct * 16 + (lane & 15);
    ((bf16_t*)(a.ws + lwbase(l)))[(size_t)frag * 512 + lane * 8 + j] = f2bf(W[r * 256 + c]);
}
__device__ __forceinline__ bf16x8 lds_afrag(const float* p) {
    const f32x4 x0 = *(const f32x4*)p, x1 = *(const f32x4*)(p + 4);
    u32x4 w; w.x = cvt_pk_bf16(x0[0], x0[1]); w.y = cvt_pk_bf16(x0[2], x0[3]); w.z = cvt_pk_bf16(x1[0], x1[1]); w.w = cvt_pk_bf16(x1[2], x1[3]); return __builtin_bit_cast(bf16x8, w);
}
struct PrepRegs { u32x2 fraw[9], sraw[9]; };
__device__ __forceinline__ void prep_issue_loads(PrepRegs& R, const bf16_t* pxr, int tile, int tid) {
#pragma unroll
    for (int it = 0; it < 9; ++it) {
        const int i = tid + it * NTHR; const int tk = i / (NPXR / 4), j = (i - tk * (NPXR / 4)) * 4; const int row = tile * 16 + tk;
        R.fraw[it] = *(const u32x2*)(pxr + (size_t)row * NPXR + j);
        int nrow; bool valid;
        if (row < ML) { const int t = row & 4095; const int q = j < 384 ? j / 96 : (j - 384) / 192;
            if (q == 0) { valid = (t & 63) > 0; nrow = row - 1; } else if (q == 1) { valid = (t & 63) < 63; nrow = row + 1; }
            else if (q == 2) { valid = t >= 64; nrow = row - 64; } else { valid = t < TL - 64; nrow = row + 64; } }
        else { const int c = (row - ML) & 255; const int hf = j < 384 ? j / 192 : (j - 384) / 384;
            if (hf == 0) { valid = c > 0; nrow = row - 1; } else { valid = c < 255; nrow = row + 1; } }
        R.sraw[it] = (u32x2){0u, 0u}; if (valid) R.sraw[it] = *(const u32x2*)(pxr + (size_t)nrow * NPXR + j);
    }
}
__device__ __forceinline__ void rwkv_prep_tile(const Args& a, int l, int tile, int tile_next, PrepRegs& R, unsigned char* lds) {
    float* mx = (float*)lds; float* rinv = mx + 16 * NPXR;
    const int tid = opaque_tid(), lane = tid & 63, wave = tid >> 6, fr = lane & 15, quad = lane >> 4;
    const bf16_t* pxr = (const bf16_t*)(a.ws + WS_PXR);
    const float* mu = a.in[I_MU] + l * NPXR;
    unsigned char* prep = a.ws + WS_PREP;
    float* PW = (float*)(prep + PREP_W); float* PKA = (float*)(prep + PREP_KA); bf16_t* PKD = (bf16_t*)(prep + PREP_KD); float* PKK = (float*)(prep + PREP_KK);
    bf16_t* PR = (bf16_t*)(prep + PREP_R); bf16_t* PV = (bf16_t*)(prep + PREP_V); bf16_t* PG = (bf16_t*)(prep + PREP_G);
    const size_t row0 = (size_t)tile * 16;
    {
#pragma unroll
        for (int it = 0; it < 9; ++it) {
            const int i = tid + it * NTHR; const int tk = i / (NPXR / 4), j = (i - tk * (NPXR / 4)) * 4; const int row = tile * 16 + tk;
            const f32x4 f = bf4_to_f32(R.fraw[it]), sv = bf4_to_f32(R.sraw[it]);
            const f32x4 muv = *(const f32x4*)(mu + j);
            f32x4 m = f + (sv - f) * muv;
            if (j >= 256 && j < 384) { for (int e = 0; e < 4; ++e) m[e] = __builtin_amdgcn_rcpf(1.f + __expf(-m[e])); }
            else if (j >= 896 && j < 1024) { for (int e = 0; e < 4; ++e) m[e] = 1.f - 2.f * __builtin_amdgcn_rcpf(1.f + __expf(2.f * m[e])); }
            *(f32x4*)(mx + tk * NPXR + j) = m;
            if (j < 256) *(u32x2*)(PR + (size_t)row * 256 + j) = f32_to_bf4(m);
            else if (j >= 640 && j < 896) *(u32x2*)(PV + (size_t)row * 256 + (j - 640)) = f32_to_bf4(m);
        }
    }
    __syncthreads();
    {
#pragma unroll
        for (int tt = 0; tt < 2; ++tt) { const int tk = wave * 2 + tt;
#pragma unroll
            for (int hh = 0; hh < 4; ++hh) { const float x = mx[tk * NPXR + 384 + hh * 64 + lane] * a.in[I_KK][l * 256 + hh * 64 + lane];
                const float ss = wave_sum(x * x); const float ri = fminf(__builtin_amdgcn_rsqf(ss), 1e12f);
                PKK[(row0 + tk) * 256 + hh * 64 + lane] = x * ri; if (lane == 0) rinv[tk * 4 + hh] = ri; } }
    }
    __syncthreads();
    if (tile_next >= 0) prep_issue_loads(R, pxr, tile_next, tid);
    const bf16_t* lw = (const bf16_t*)(a.ws + lwbase(l));
    const size_t orow = row0 + fr;
#pragma unroll 1
    for (int cc = 0; cc < 2; ++cc) {
        const int ct = wave * 2 + cc; const int c0 = ct * 16 + quad * 4; const int hh = ct >> 2;
        const f32x4 kx = *(const f32x4*)(mx + fr * NPXR + 384 + c0);
        const f32x4 kkp = *(const f32x4*)(a.in[I_KK] + l * 256 + c0), kap = *(const f32x4*)(a.in[I_KA] + l * 256 + c0);
        const float ri = rinv[fr * 4 + hh];
        bf16x8 wg[4], ww[2][2], wa[2][2]; f32x4 w0p2[2], a0p2[2];
#pragma unroll
        for (int ks = 0; ks < 4; ++ks) wg[ks] = *(const bf16x8*)(lw + (size_t)(128 + ct * 4 + ks) * 512 + lane * 8);
#pragma unroll
        for (int d = 0; d < 2; ++d) {
#pragma unroll
            for (int ks = 0; ks < 2; ++ks) { ww[d][ks] = *(const bf16x8*)(lw + (size_t)((d * 16 + ct) * 2 + ks) * 512 + lane * 8); wa[d][ks] = *(const bf16x8*)(lw + (size_t)(64 + (d * 16 + ct) * 2 + ks) * 512 + lane * 8); }
            w0p2[d] = *(const f32x4*)(a.in[I_W0] + (l * 2 + d) * 256 + c0); a0p2[d] = *(const f32x4*)(a.in[I_A0] + (l * 2 + d) * 256 + c0); }
        {
            f32x4 acc = {0.f, 0.f, 0.f, 0.f};
#pragma unroll
            for (int ks = 0; ks < 4; ++ks) { const bf16x8 wf = wg[ks]; const bf16x8 af = lds_afrag(mx + fr * NPXR + 256 + ks * 32 + quad * 8);
                acc = __builtin_amdgcn_mfma_f32_16x16x32_bf16(wf, af, acc, 0, 0, 0); }
            *(u32x2*)(PG + orow * 256 + c0) = f32_to_bf4(acc);
        }
#pragma unroll
        for (int d = 0; d < 2; ++d) {
            f32x4 accw = {0.f, 0.f, 0.f, 0.f}, acca = {0.f, 0.f, 0.f, 0.f};
#pragma unroll
            for (int ks = 0; ks < 2; ++ks) {
                const bf16x8 wf = ww[d][ks]; const bf16x8 af = lds_afrag(mx + fr * NPXR + 896 + d * 64 + ks * 32 + quad * 8);
                accw = __builtin_amdgcn_mfma_f32_16x16x32_bf16(wf, af, accw, 0, 0, 0);
                const bf16x8 wf2 = wa[d][ks]; const bf16x8 af2 = lds_afrag(mx + fr * NPXR + 1024 + d * 64 + ks * 32 + quad * 8);
                acca = __builtin_amdgcn_mfma_f32_16x16x32_bf16(wf2, af2, acca, 0, 0, 0); }
            const f32x4 w0p = w0p2[d], a0p = a0p2[d];
            f32x4 wv, kav, kdv;
#pragma unroll
            for (int e = 0; e < 4; ++e) { const float z = w0p[e] + accw[e];
                wv[e] = __expf(-0.6065306597126334f * __builtin_amdgcn_rcpf(1.f + __expf(-z)));
                const float av = __builtin_amdgcn_rcpf(1.f + __expf(-(a0p[e] + acca[e])));
                kav[e] = kx[e] * kkp[e] * ri * av; kdv[e] = kx[e] * (1.f + (av - 1.f) * kap[e]); }
            *(f32x4*)(PW + (orow * 2 + d) * 256 + c0) = wv; *(f32x4*)(PKA + (orow * 2 + d) * 256 + c0) = kav; *(u32x2*)(PKD + (orow * 2 + d) * 256 + c0) = f32_to_bf4(kdv);
        }
    }
    __syncthreads();
}

__device__ __forceinline__ unsigned gl_ld(const unsigned* p) { return __hip_atomic_load(p, __ATOMIC_RELAXED, __HIP_MEMORY_SCOPE_AGENT); }
__device__ __forceinline__ void gl_add(unsigned* p, unsigned v) { (void)__hip_atomic_fetch_add(p, v, __ATOMIC_RELAXED, __HIP_MEMORY_SCOPE_AGENT); }
#ifndef PREP_EARLY_TILES
#define PREP_EARLY_TILES 512
#endif
constexpr int PREP_TILES = MT / 16, PREP_EARLY = PREP_EARLY_TILES, PREP_LATE_ROUNDS = (PREP_TILES - PREP_EARLY + 127) / 128;
constexpr int CW_PREP = 4096;
static_assert(PREP_LATE_ROUNDS <= 8 && PREP_EARLY % 256 == 0 && PREP_EARLY >= 64, "prep split");
__device__ __forceinline__ int prep_tile_of(int o) {
    if (o < 64) return ML / 16 + o;
    const int q = o - 64, b = q & 3, p = q >> 2, i = p >> 1; return b * 256 + ((p & 1) ? 255 - i : i);
}
__device__ __forceinline__ void prep_publish(unsigned* cnt) {
    asm volatile("s_waitcnt vmcnt(0)" ::: "memory");
    __syncthreads();
    if (threadIdx.x == 0) { __builtin_amdgcn_fence(__ATOMIC_RELEASE, "agent"); asm volatile("s_waitcnt vmcnt(0)" ::: "memory"); gl_add(cnt, 1u); }
}
__device__ __forceinline__ void prep_wait_for_chunk(const unsigned* cnt_layer, int ck, int& rd) {
    if (ck < 16 || rd >= PREP_LATE_ROUNDS) return;
    const int ft = ck - 16; const int i = ft < 128 ? ft : 255 - ft; const int oneed = 64 + 8 * i + 7;
    if (oneed < PREP_EARLY) return;
    const int r = (oneed - PREP_EARLY) >> 7;
    if (rd > r) return;
    while (rd <= r) {
        const unsigned expect = (unsigned)((PREP_TILES - PREP_EARLY - rd * 128) < 128 ? (PREP_TILES - PREP_EARLY - rd * 128) : 128);
        unsigned sp = 0; while (gl_ld(cnt_layer + 64 * rd) < expect) { __builtin_amdgcn_s_sleep(2); if (++sp > (1u << 22)) break; }
        ++rd;
    }
    __builtin_amdgcn_fence(__ATOMIC_ACQUIRE, "agent"); asm volatile("s_waitcnt vmcnt(0)" ::: "memory");
}
constexpr int SC_STEPS = 16, SC_NCH = (CL + TL) / SC_STEPS, SC_OPB = 5 * SC_STEPS * 256 + SC_STEPS * 64, SC_PB = SC_STEPS * 16 * 64;
__device__ __forceinline__ int scan_row(int b, int d, int s) {
    if (d == 0) return s < CL ? ML + b * CL + s : b * TL + (s - CL);
    return s < CL ? ML + b * CL + (CL - 1 - s) : b * TL + (TL - 1 - (s - CL));
}
typedef float f32x2 __attribute__((ext_vector_type(2)));
struct ScanStage { f32x4 w, kk, ka; u32x2 kd, r, v; };
struct ScanPtrs { const float *PW, *PKA, *PKK; const bf16_t *PKD, *PR, *PV; float* YS; int b, h, d, rgp; };
__device__ __forceinline__ void scan_issue_loads(ScanStage& R, const ScanPtrs& P, int ck, int lt) {
    const int st = lt >> 4, q4 = lt & 15; const size_t row = (size_t)scan_row(P.b, P.d, ck * SC_STEPS + st); const int co = P.h * 64 + q4 * 4;
    R.w = *(const f32x4*)(P.PW + (row * 2 + P.d) * 256 + co); R.kd = *(const u32x2*)(P.PKD + (row * 2 + P.d) * 256 + co); R.kk = *(const f32x4*)(P.PKK + row * 256 + co);
    R.ka = *(const f32x4*)(P.PKA + (row * 2 + P.d) * 256 + co); R.r = *(const u32x2*)(P.PR + row * 256 + co);
    { const int lv = lt & 63; const size_t rowV = (size_t)scan_row(P.b, P.d, ck * SC_STEPS + (lv >> 2)); R.v = *(const u32x2*)(P.PV + rowV * 256 + P.h * 64 + P.rgp * 16 + (lv & 3) * 4); }
}
__device__ __forceinline__ void scan_store_lds(const ScanStage& R, unsigned char* buf, int lt) {
    const int st = lt >> 4, q4 = lt & 15;
    unsigned char* p = buf + st * 256 + q4 * 16;
    *(f32x4*)(p) = R.w; *(f32x4*)(p + SC_STEPS * 256) = bf4_to_f32(R.kd); *(f32x4*)(p + 2 * SC_STEPS * 256) = R.kk; *(f32x4*)(p + 3 * SC_STEPS * 256) = R.ka; *(f32x4*)(p + 4 * SC_STEPS * 256) = bf4_to_f32(R.r);
    if (lt < 64) { const f32x4 vv = bf4_to_f32(R.v); float* vb = (float*)(buf + 5 * SC_STEPS * 256) + (lt & 3) * 4 * SC_STEPS + (lt >> 2);
        vb[0] = vv[0]; vb[SC_STEPS] = vv[1]; vb[2 * SC_STEPS] = vv[2]; vb[3 * SC_STEPS] = vv[3]; }
}
__device__ __forceinline__ void scan_reduce_y(const ScanPtrs& P, const unsigned char* pb, int ck, int lt) {
    const int st = lt >> 4, row = lt & 15; const float* p = (const float*)(pb + (st * 16 + row) * 64);
    const f32x4 p0 = *(const f32x4*)p, p1 = *(const f32x4*)(p + 4), p2 = *(const f32x4*)(p + 8), p3 = *(const f32x4*)(p + 12);
    const f32x4 q = (p0 + p1) + (p2 + p3);
    const size_t grow = (size_t)scan_row(P.b, P.d, ck * SC_STEPS + st);
    P.YS[(grow * 2 + P.d) * 256 + P.h * 64 + P.rgp * 16 + row] = (q[0] + q[1]) + (q[2] + q[3]);
}
struct ScanOps { f32x4 w4, kd4, kk4, ka4, r4; };
__device__ __forceinline__ void scan_ld_ops(ScanOps& o, const unsigned char* bp, const unsigned char* vp, int st) {
    o.w4 = *(const f32x4*)(bp + st * 256); o.kd4 = *(const f32x4*)(bp + SC_STEPS * 256 + st * 256); o.kk4 = *(const f32x4*)(bp + 2 * SC_STEPS * 256 + st * 256);
    o.ka4 = *(const f32x4*)(bp + 3 * SC_STEPS * 256 + st * 256); o.r4 = *(const f32x4*)(bp + 4 * SC_STEPS * 256 + st * 256);
    (void)vp;
}
#define SCAN_BAR() asm volatile("s_waitcnt lgkmcnt(0)\n\ts_barrier" ::: "memory")
__device__ __forceinline__ void scan_task(const Args& a, int task, const unsigned* prep_cnt, unsigned char* lds) {
    const int tid = opaque_tid(), lane = tid & 63, wave = tid >> 6;
    const int xcd = task & 7, kx = task >> 3; const int chain = xcd * 4 + (kx >> 2); ScanPtrs P;
    P.rgp = kx & 3; P.b = chain >> 3; P.h = (chain >> 1) & 3; P.d = chain & 1;
    unsigned char* prep = a.ws + WS_PREP;
    P.PW = (const float*)(prep + PREP_W); P.PKA = (const float*)(prep + PREP_KA); P.PKD = (const bf16_t*)(prep + PREP_KD); P.PKK = (const float*)(prep + PREP_KK);
    P.PR = (const bf16_t*)(prep + PREP_R); P.PV = (const bf16_t*)(prep + PREP_V); P.YS = (float*)(a.ws + WS_YS);
    unsigned char* pbase = lds + 2 * SC_OPB;
    __syncthreads();
    if (wave >= 4) {
        const int lt = tid - 256; ScanStage R0, R1, R2;
        int rd = 0;
        scan_issue_loads(R0, P, 0, lt); scan_store_lds(R0, lds, lt);
        scan_issue_loads(R1, P, 1, lt); scan_issue_loads(R2, P, 2, lt); scan_issue_loads(R0, P, 3, lt);
        SCAN_BAR();
#define SCAN_LOADER_IT(CK, RS) do { const int ck_ = (CK); if (ck_ < SC_NCH) { \
            if (ck_ + 1 < SC_NCH) scan_store_lds(RS, lds + ((ck_ + 1) & 1) * SC_OPB, lt); \
            if (ck_ + 4 < SC_NCH) { prep_wait_for_chunk(prep_cnt, ck_ + 4, rd); scan_issue_loads(RS, P, ck_ + 4, lt); } \
            if (ck_ >= 1) scan_reduce_y(P, pbase + ((ck_ - 1) & 1) * SC_PB, ck_ - 1, lt); \
            SCAN_BAR(); } } while (0)
        for (int ck = 0; ck < SC_NCH; ck += 3) { SCAN_LOADER_IT(ck, R1); SCAN_LOADER_IT(ck + 1, R2); SCAN_LOADER_IT(ck + 2, R0); }
#undef SCAN_LOADER_IT
        scan_reduce_y(P, pbase + ((SC_NCH - 1) & 1) * SC_PB, SC_NCH - 1, lt);
    } else {
        const int rw = lane >> 4, kq = lane & 15, rowA = wave * 4 + rw;
        f32x2 SL = {0.f, 0.f}, SH = {0.f, 0.f};
        SCAN_BAR();
        for (int ck = 0; ck < SC_NCH; ++ck) {
            const unsigned char* bp = lds + (ck & 1) * SC_OPB + kq * 16;
            const unsigned char* vp = lds + (ck & 1) * SC_OPB + 5 * SC_STEPS * 256 + rowA * (SC_STEPS * 4);
            f32x4 vq[4];
#pragma unroll
            for (int q = 0; q < 4; ++q) vq[q] = *(const f32x4*)(vp + q * 16);
            float* pw = (float*)(pbase + (ck & 1) * SC_PB) + rowA * 16 + kq;
            ScanOps o0, o1, o2;
            scan_ld_ops(o0, bp, vp, 0); scan_ld_ops(o1, bp, vp, 1);
#pragma unroll
            for (int st = 0; st < SC_STEPS; ++st) {
                scan_ld_ops(o2, bp, vp, st + 2 < SC_STEPS ? st + 2 : SC_STEPS - 1);
                const f32x2 wlo = {o0.w4[0], o0.w4[1]}, whi = {o0.w4[2], o0.w4[3]}, kdlo = {o0.kd4[0], o0.kd4[1]}, kdhi = {o0.kd4[2], o0.kd4[3]}, kklo = {o0.kk4[0], o0.kk4[1]}, kkhi = {o0.kk4[2], o0.kk4[3]},
                            kalo = {o0.ka4[0], o0.ka4[1]}, kahi = {o0.ka4[2], o0.ka4[3]}, rlo = {o0.r4[0], o0.r4[1]}, rhi = {o0.r4[2], o0.r4[3]};
                const f32x2 dp = SL * kklo + SH * kkhi;
                const float sa = row16_sum(dp[0] + dp[1]);
                const float va = vq[st >> 2][st & 3];
                const f32x2 TL = SL * wlo + kdlo * va, TH = SH * whi + kdhi * va;
                SL = TL - kalo * sa; SH = TH - kahi * sa;
                const f32x2 yy = SL * rlo + SH * rhi;
                pw[st * 256] = yy[0] + yy[1];
                o0 = o1; o1 = o2;
            }
            SCAN_BAR();
        }
    }
}

struct RoRegs { float y0, y1; unsigned short r, kd0, kd1, v, g; };
__device__ __forceinline__ void ro_load(RoRegs& R, size_t row, int c, const float* YS, const bf16_t* PR, const bf16_t* PKD, const bf16_t* PV, const bf16_t* PG) {
    R.y0 = YS[(row * 2 + 0) * 256 + c]; R.y1 = YS[(row * 2 + 1) * 256 + c]; R.r = PR[row * 256 + c]; R.kd0 = PKD[(row * 2 + 0) * 256 + c]; R.kd1 = PKD[(row * 2 + 1) * 256 + c];
    R.v = PV[row * 256 + c]; R.g = PG[row * 256 + c];
}
__device__ __forceinline__ void rwkv_out(const Args& a, int l, int mrows) {
    const int tid = opaque_tid(), c = tid & 255;
    unsigned char* prep = a.ws + WS_PREP;
    const bf16_t* PKD = (const bf16_t*)(prep + PREP_KD); const bf16_t* PR = (const bf16_t*)(prep + PREP_R); const bf16_t* PV = (const bf16_t*)(prep + PREP_V); const bf16_t* PG = (const bf16_t*)(prep + PREP_G);
    const float* YS = (const float*)(a.ws + WS_YS); bf16_t* hbuf = (bf16_t*)(a.ws + WS_HBUF);
    const float lg = a.in[I_LNXG][l * 256 + c], lb = a.in[I_LNXB][l * 256 + c], rk = a.in[I_RK][l * 256 + c];
    const size_t stride = (size_t)gridDim.x * 2;
    size_t row = (size_t)blockIdx.x * 2 + (tid >> 8);
    RoRegs N0, N1; N1.y0 = 0.f; N1.y1 = 0.f; N1.r = 0; N1.kd0 = 0; N1.kd1 = 0; N1.v = 0; N1.g = 0;
    if (row < (size_t)mrows) ro_load(N0, row, c, YS, PR, PKD, PV, PG);
    if (row + stride < (size_t)mrows) ro_load(N1, row + stride, c, YS, PR, PKD, PV, PG);
    for (; row < (size_t)mrows; row += 2 * stride) {
        const RoRegs C0 = N0, C1 = N1; const bool two = row + stride < (size_t)mrows;
        if (row + 2 * stride < (size_t)mrows) ro_load(N0, row + 2 * stride, c, YS, PR, PKD, PV, PG);
        if (row + 3 * stride < (size_t)mrows) ro_load(N1, row + 3 * stride, c, YS, PR, PKD, PV, PG);
        const float ya = C0.y0 + C0.y1, yb = C1.y0 + C1.y1;
        const float ma = wave_sum(ya) * (1.f / 64.f), mb = wave_sum(yb) * (1.f / 64.f);
        const float qa = wave_sum(ya * ya) * (1.f / 64.f), qb = wave_sum(yb * yb) * (1.f / 64.f);
        const float da = ya - ma, db = yb - mb;
        const float va = fmaxf(qa - ma * ma, 0.f), vb = fmaxf(qb - mb * mb, 0.f);
        const float ba = wave_sum(bf2f(C0.r) * (bf2f(C0.kd0) + bf2f(C0.kd1)) * rk), bb = wave_sum(bf2f(C1.r) * (bf2f(C1.kd0) + bf2f(C1.kd1)) * rk);
        const float oa = (da * __builtin_amdgcn_rsqf(va + 64e-5f) * lg + lb + ba * bf2f(C0.v)) * bf2f(C0.g), ob = (db * __builtin_amdgcn_rsqf(vb + 64e-5f) * lg + lb + bb * bf2f(C1.v)) * bf2f(C1.g);
        hbuf[row * DM + 768 + c] = f2bf(oa);
        if (two) hbuf[(row + stride) * DM + 768 + c] = f2bf(ob);
    }
}

__device__ __forceinline__ bf16x8 load_rope8(const bf16_t* base, int sgm, bool rope, const float* rc, const float* rs, float scale) {
    const u32x4 own = *(const u32x4*)(base + sgm * 8);
    float o[8];
#pragma unroll
    for (int i = 0; i < 4; ++i) { o[2 * i] = __builtin_bit_cast(float, own[i] << 16); o[2 * i + 1] = __builtin_bit_cast(float, own[i] & 0xffff0000u); }
    if (rope) {
        const u32x4 par = *(const u32x4*)(base + (sgm ^ 2) * 8);
        const int tb = (sgm >> 2) * 16 + (sgm & 1) * 8; const float sgn = (sgm & 2) ? 1.f : -1.f;
#pragma unroll
        for (int i = 0; i < 4; ++i) { const float p0 = __builtin_bit_cast(float, par[i] << 16), p1 = __builtin_bit_cast(float, par[i] & 0xffff0000u);
            o[2 * i] = o[2 * i] * rc[tb + 2 * i] + sgn * p0 * rs[tb + 2 * i]; o[2 * i + 1] = o[2 * i + 1] * rc[tb + 2 * i + 1] + sgn * p1 * rs[tb + 2 * i + 1]; }
    }
    u32x4 w; w.x = cvt_pk_bf16(o[0] * scale, o[1] * scale); w.y = cvt_pk_bf16(o[2] * scale, o[3] * scale); w.z = cvt_pk_bf16(o[4] * scale, o[5] * scale); w.w = cvt_pk_bf16(o[6] * scale, o[7] * scale);
    return __builtin_bit_cast(bf16x8, w);
}
constexpr int KS_PITCH = 72, VT_PITCH = 136, VT_OFF = 128 * KS_PITCH * 2;
__device__ __forceinline__ void attn_unit(const Args& a, int l, int unit, unsigned char* lds) {
    const int tid = opaque_tid(), lane = tid & 63, wave = tid >> 6, fr = lane & 15, quad = lane >> 4;
    bf16_t* Ks = (bf16_t*)lds; bf16_t* Vt = (bf16_t*)(lds + VT_OFF);
    const bf16_t* pxa = (const bf16_t*)(a.ws + WS_PXA); bf16_t* hbuf = (bf16_t*)(a.ws + WS_HBUF);
    const float* rc = (const float*)(a.ws + WS_ROPE); const float* rs = rc + TL * 32;
    const bool isctx = unit >= 256; int b, nblk, kvh, qrow0;
    if (!isctx) { b = unit >> 6; nblk = (unit >> 1) & 31; kvh = unit & 1; qrow0 = b * TL + nblk * 128; }
    else { const int u2 = unit - 256; b = u2 >> 2; nblk = (u2 >> 1) & 1; kvh = u2 & 1; qrow0 = ML + b * CL + nblk * 128; }
    const int qi = wave * 16 + fr; const size_t qrow = (size_t)qrow0 + qi; const int tq = nblk * 128 + qi;
    bf16x8 bq[4][2]; float mrun[4], lsum[4]; f32x4 O[4][4];
#pragma unroll
    for (int g = 0; g < 4; ++g) { const int head = kvh * 4 + g;
#pragma unroll
        for (int ks = 0; ks < 2; ++ks) bq[g][ks] = load_rope8(pxa + qrow * NPXA + 512 + head * 64, 4 * ks + quad, !isctx, rc + tq * 32, rs + tq * 32, 0.18033688011112042f);
        mrun[g] = a.in[I_SINK][l * 8 + head] * 1.4426950408889634f; lsum[g] = quad == 0 ? 1.f : 0.f;
#pragma unroll
        for (int dt = 0; dt < 4; ++dt) O[g][dt] = (f32x4){0.f, 0.f, 0.f, 0.f}; }
    const int nchunk = isctx ? 2 : 5;
    for (int ch = 0; ch < nchunk; ++ch) {
        const bool cchunk = ch < 2; const int lc = ch - 2; const int blk = nblk - 1 + lc;
        if (!cchunk && (blk < 0 || blk > 31)) continue;
        __syncthreads();
#pragma unroll
        for (int it = 0; it < 2; ++it) { const int item = tid + NTHR * it; const int key = item >> 3, sgm = item & 7;
            const size_t krow = cchunk ? (size_t)ML + b * CL + ch * 128 + key : (size_t)b * TL + blk * 128 + key; const int tk = blk * 128 + key;
            const bf16x8 kf = load_rope8(pxa + krow * NPXA + 1024 + kvh * 64, sgm, !cchunk, rc + (cchunk ? 0 : tk) * 32, rs + (cchunk ? 0 : tk) * 32, 1.f);
            *(bf16x8*)(Ks + key * KS_PITCH + sgm * 8) = kf;
            const bf16x8 vf = *(const bf16x8*)(pxa + krow * NPXA + 1152 + kvh * 64 + sgm * 8);
#pragma unroll
            for (int i = 0; i < 8; ++i) Vt[(sgm * 8 + i) * VT_PITCH + key] = (bf16_t)vf[i]; }
        __syncthreads();
#pragma unroll 1
        for (int kt = 0; kt < 4; ++kt) {
            bf16x8 ak[2][2], av[4];
#pragma unroll
            for (int sub = 0; sub < 2; ++sub)
#pragma unroll
                for (int ks = 0; ks < 2; ++ks) ak[sub][ks] = *(const bf16x8*)(Ks + (kt * 32 + sub * 16 + fr) * KS_PITCH + ks * 32 + quad * 8);
#pragma unroll
            for (int dt = 0; dt < 4; ++dt) { const bf16_t* vp = Vt + (dt * 16 + fr) * VT_PITCH + kt * 32 + quad * 4;
                const u32x2 lo = *(const u32x2*)vp, hi = *(const u32x2*)(vp + 16); u32x4 w; w.x = lo.x; w.y = lo.y; w.z = hi.x; w.w = hi.y; av[dt] = __builtin_bit_cast(bf16x8, w); }
#pragma unroll
            for (int g = 0; g < 4; ++g) {
                f32x4 s0 = {0.f, 0.f, 0.f, 0.f}, s1 = {0.f, 0.f, 0.f, 0.f};
                s0 = __builtin_amdgcn_mfma_f32_16x16x32_bf16(ak[0][0], bq[g][0], s0, 0, 0, 0); s0 = __builtin_amdgcn_mfma_f32_16x16x32_bf16(ak[0][1], bq[g][1], s0, 0, 0, 0);
                s1 = __builtin_amdgcn_mfma_f32_16x16x32_bf16(ak[1][0], bq[g][0], s1, 0, 0, 0); s1 = __builtin_amdgcn_mfma_f32_16x16x32_bf16(ak[1][1], bq[g][1], s1, 0, 0, 0);
                if (!cchunk && lc != 1) {
#pragma unroll
                    for (int j = 0; j < 4; ++j) { const int k0 = kt * 32 + quad * 4 + j, k1 = k0 + 16;
                        const bool v0 = lc == 0 ? (k0 >= qi) : (k0 <= qi), v1 = lc == 0 ? (k1 >= qi) : (k1 <= qi);
                        s0[j] = v0 ? s0[j] : -1e30f; s1[j] = v1 ? s1[j] : -1e30f; } }
                float mx = fmaxf(fmaxf(fmaxf(s0[0], s0[1]), fmaxf(s0[2], s0[3])), fmaxf(fmaxf(s1[0], s1[1]), fmaxf(s1[2], s1[3])));
                mx = fmaxf(mx, __shfl_xor(mx, 16)); mx = fmaxf(mx, __shfl_xor(mx, 32));
                const float mold = mrun[g]; const float mn = fmaxf(mold, mx); mrun[g] = mn;
                float p[8];
#pragma unroll
                for (int j = 0; j < 4; ++j) { p[j] = __builtin_amdgcn_exp2f(s0[j] - mn); p[4 + j] = __builtin_amdgcn_exp2f(s1[j] - mn); }
                const float psum = ((p[0] + p[1]) + (p[2] + p[3])) + ((p[4] + p[5]) + (p[6] + p[7]));
                const bool grew = __builtin_amdgcn_ballot_w64(mn != mold) != 0ull;
                if (grew) { const float alpha = __builtin_amdgcn_exp2f(mold - mn); lsum[g] = lsum[g] * alpha + psum;
#pragma unroll
                    for (int dt = 0; dt < 4; ++dt) O[g][dt] = O[g][dt] * alpha; }
                else lsum[g] += psum;
                u32x4 w; w.x = cvt_pk_bf16(p[0], p[1]); w.y = cvt_pk_bf16(p[2], p[3]); w.z = cvt_pk_bf16(p[4], p[5]); w.w = cvt_pk_bf16(p[6], p[7]);
                const bf16x8 bp = __builtin_bit_cast(bf16x8, w);
#pragma unroll
                for (int dt = 0; dt < 4; ++dt) O[g][dt] = __builtin_amdgcn_mfma_f32_16x16x32_bf16(av[dt], bp, O[g][dt], 0, 0, 0);
            }
        }
    }
#pragma unroll
    for (int g = 0; g < 4; ++g) { const int head = kvh * 4 + g;
        float lt = lsum[g]; lt += __shfl_xor(lt, 16); lt += __shfl_xor(lt, 32); const float inv = 1.f / lt;
#pragma unroll
        for (int dt = 0; dt < 4; ++dt) { const f32x4 o = O[g][dt] * inv; u32x2 w; w.x = cvt_pk_bf16(o[0], o[1]); w.y = cvt_pk_bf16(o[2], o[3]);
            *(u32x2*)(hbuf + qrow * DM + 256 + head * 64 + dt * 16 + quad * 4) = w; } }
    __syncthreads();
}

__device__ __forceinline__ void gmlp_unit(const Args& a, int l, int chunk, unsigned char* lds) {
    const int tid = opaque_tid(), lane = tid & 63, wave = tid >> 6, fr = lane & 15, quad = lane >> 4;
    bf16_t* vT = (bf16_t*)lds;
    const bf16_t* pxa = (const bf16_t*)(a.ws + WS_PXA); bf16_t* hbuf = (bf16_t*)(a.ws + WS_HBUF);
    const size_t row0 = (size_t)chunk * 128;
    { const f32x4 lg = *(const f32x4*)(a.in[I_SGLNG] + l * 256 + lane * 4), lb = *(const f32x4*)(a.in[I_SGLNB] + l * 256 + lane * 4);
      u32x2 raws[16];
#pragma unroll
      for (int i = 0; i < 16; ++i) raws[i] = *(const u32x2*)(pxa + (row0 + wave * 16 + i) * NPXA + 256 + lane * 4);
#pragma unroll
      for (int hf = 0; hf < 2; ++hf) {
          unsigned pk[4][4];
#pragma unroll
          for (int i2 = 0; i2 < 4; ++i2) {
              float xn[2][4];
#pragma unroll
              for (int s2 = 0; s2 < 2; ++s2) {
                  const u32x2 raw = raws[hf * 8 + i2 * 2 + s2];
                  float x[4] = { gelu_tanh(__builtin_bit_cast(float, raw.x << 16)), gelu_tanh(__builtin_bit_cast(float, raw.x & 0xffff0000u)), gelu_tanh(__builtin_bit_cast(float, raw.y << 16)), gelu_tanh(__builtin_bit_cast(float, raw.y & 0xffff0000u)) };
                  const float mean = wave_sum((x[0] + x[1]) + (x[2] + x[3])) * (1.f / 256.f);
                  float q = 0.f;
#pragma unroll
                  for (int j = 0; j < 4; ++j) { x[j] -= mean; q += x[j] * x[j]; }
                  const float rstd = __builtin_amdgcn_rsqf(wave_sum(q) * (1.f / 256.f) + 1e-5f);
#pragma unroll
                  for (int j = 0; j < 4; ++j) xn[s2][j] = x[j] * rstd * lg[j] + lb[j]; }
#pragma unroll
              for (int j = 0; j < 4; ++j) pk[j][i2] = cvt_pk_bf16(xn[0][j], xn[1][j]);
          }
#pragma unroll
          for (int j = 0; j < 4; ++j) { u32x4 w; w.x = pk[j][0]; w.y = pk[j][1]; w.z = pk[j][2]; w.w = pk[j][3];
              *(u32x4*)(vT + (lane * 4 + j) * VT_PITCH + wave * 16 + hf * 8) = w; }
      } }
    __syncthreads();
    const int pt = wave;
#pragma unroll 1
    for (int g = 0; g < 4; ++g) {
        bf16x8 af[4];
        const float* wsrc = a.in[I_SGW] + ((size_t)(l * 4 + g) * 128 + pt * 16 + fr) * 128 + quad * 8;
#pragma unroll
        for (int ks = 0; ks < 4; ++ks) { const f32x4 w0 = *(const f32x4*)(wsrc + ks * 32), w1 = *(const f32x4*)(wsrc + ks * 32 + 4);
            u32x4 w; w.x = cvt_pk_bf16(w0[0], w0[1]); w.y = cvt_pk_bf16(w0[2], w0[3]); w.z = cvt_pk_bf16(w1[0], w1[1]); w.w = cvt_pk_bf16(w1[2], w1[3]); af[ks] = __builtin_bit_cast(bf16x8, w); }
        f32x4 bs;
#pragma unroll
        for (int j = 0; j < 4; ++j) bs[j] = a.in[I_SGB][(l * 4 + g) * 128 + pt * 16 + quad * 4 + j];
        unsigned short uraw[4][4];
#pragma unroll
        for (int dt = 0; dt < 4; ++dt)
#pragma unroll
            for (int j = 0; j < 4; ++j) uraw[dt][j] = pxa[(row0 + pt * 16 + quad * 4 + j) * NPXA + g * 64 + dt * 16 + fr];
#pragma unroll
        for (int dt = 0; dt < 4; ++dt) { const int chn = g * 64 + dt * 16 + fr;
            f32x4 acc = {0.f, 0.f, 0.f, 0.f};
#pragma unroll
            for (int ks = 0; ks < 4; ++ks) { const bf16x8 bv = *(const bf16x8*)(vT + chn * VT_PITCH + ks * 32 + quad * 8); acc = __builtin_amdgcn_mfma_f32_16x16x32_bf16(af[ks], bv, acc, 0, 0, 0); }
#pragma unroll
            for (int j = 0; j < 4; ++j) { const size_t row = row0 + pt * 16 + quad * 4 + j;
                const float uu = gelu_tanh(bf2f(uraw[dt][j]));
                hbuf[row * DM + chn] = f2bf(uu * (acc[j] + bs[j])); } }
    }
    __syncthreads();
}

struct PieceOrder { int unit; bool has;
    __device__ __forceinline__ bool next(int i, pg8::Unit& u) const { if (i != 0 || !has) return false; u.pm = unit >> 2; u.pn = unit & 3; return true; }
    __device__ __forceinline__ void a_ready(const pg8::Unit&) const {}
    __device__ __forceinline__ void done(const pg8::Unit&) const {}
};
#define LAS __attribute__((address_space(3)))
constexpr size_t WS_CTL = 768 * 1024, CTL_BYTES = 32768;
constexpr int LDS_BARST_OFF = 131072 + 64;
#define XB_TMO      128
#define XB_XCNT(j)  (256  + 64 * (j))
#define XB_XSUB(j)  (1280 + 64 * (j))
#define XB_XGEN(j)  (2304 + 64 * (j))
#define XB_TOP      3328
#define XB_TOPGEN   3392
#define XCD_BAR_WORDS 3456
#define XB_SPIN_CAP (1u << 18)

__device__ __forceinline__ unsigned xb_ld(unsigned* p)              { return __hip_atomic_load(p, __ATOMIC_RELAXED, __HIP_MEMORY_SCOPE_AGENT); }
__device__ __forceinline__ unsigned xb_add(unsigned* p, unsigned v) { return __hip_atomic_fetch_add(p, v, __ATOMIC_RELAXED, __HIP_MEMORY_SCOPE_AGENT); }
__device__ __forceinline__ unsigned xb_xcc_id() { return (unsigned)__builtin_amdgcn_s_getreg((3 << 11) | 20) & 0xFu; }
#define XB_SPIN(cond, bar) do { unsigned _sp = 0; while (cond) { __builtin_amdgcn_s_sleep(1); \
    if ((++_sp & 255u) == 0u) { if (xb_ld(&(bar)[XB_TMO])) break; if (_sp > XB_SPIN_CAP) { atomicAdd(&(bar)[XB_TMO], 1u); break; } } } } while (0)

struct XcdBarrier {
    unsigned* bar; unsigned x;
    volatile LAS unsigned* st;
};

__device__ __forceinline__ XcdBarrier xcd_barrier_post(unsigned* bar, volatile LAS unsigned* st) {
    XcdBarrier b; b.bar = bar; b.x = xb_xcc_id(); b.st = st;
    if (threadIdx.x == 0) (void)xb_add(&bar[XB_XCNT(b.x)], 1u);
    return b;
}
__device__ __forceinline__ void xcd_barrier_complete(unsigned* bar, unsigned x, unsigned& nloc, unsigned& nx) {
    const unsigned G = gridDim.x * gridDim.y * gridDim.z;
    unsigned sum, cnt, mine, sp = 0u;
    for (;;) {
        sum = 0u; cnt = 0u; mine = 0u;
#pragma unroll
        for (unsigned j = 0; j < 16; ++j) { const unsigned c = xb_ld(&bar[XB_XCNT(j)]); sum += c; cnt += (c > 0u) ? 1u : 0u; mine = (j == x) ? c : mine; }
        if (sum == G) break;
        __builtin_amdgcn_s_sleep(1);
        if ((++sp & 255u) == 0u) { if (xb_ld(&bar[XB_TMO])) break; if (sp > XB_SPIN_CAP) { atomicAdd(&bar[XB_TMO], 1u); break; } }
    }
    nloc = mine > 0u ? mine : 1u; nx = cnt > 0u ? cnt : 1u;
}

__device__ __forceinline__ void xcd_barrier(const XcdBarrier& b) {
    asm volatile("s_waitcnt vmcnt(0)" ::: "memory");
    __syncthreads();
    if (threadIdx.x == 0) {
        unsigned* bar = b.bar;
        __builtin_amdgcn_s_waitcnt(0);
        unsigned nloc = b.st[0], nx = b.st[1];
        if (nloc == 0u) { xcd_barrier_complete(bar, b.x, nloc, nx); b.st[0] = nloc; b.st[1] = nx; }
        const unsigned old = xb_add(&bar[XB_XSUB(b.x)], 1u);
        const unsigned gen = old / nloc;
        if (old + 1u == (gen + 1u) * nloc) {
            __builtin_amdgcn_fence(__ATOMIC_RELEASE, "agent");
            asm volatile("s_waitcnt vmcnt(0)" ::: "memory");
            const unsigned og = xb_add(&bar[XB_TOP], 1u);
            const unsigned tg = og / nx;
            if (og + 1u == (tg + 1u) * nx) xb_add(&bar[XB_TOPGEN], 1u);
            else XB_SPIN(xb_ld(&bar[XB_TOPGEN]) == tg, bar);
            __builtin_amdgcn_fence(__ATOMIC_ACQUIRE, "agent");
            xb_add(&bar[XB_XGEN(b.x)], 1u);
            asm volatile("s_waitcnt vmcnt(0)" ::: "memory");
        } else {
            XB_SPIN(xb_ld(&bar[XB_XGEN(b.x)]) == gen, bar);
            __builtin_amdgcn_fence(__ATOMIC_ACQUIRE, "agent");
            asm volatile("s_waitcnt vmcnt(0)" ::: "memory");
        }
    }
    __syncthreads();
}

constexpr int N_PHASES = 2 + 9 * NL;
template <int MASK> __device__ __forceinline__ void run_phase(const Args& a, int ph, unsigned char* lds) {
    int G = gridDim.x, bid = blockIdx.x; asm volatile("" : "+s"(G), "+s"(bid));
    bf16_t* HB = (bf16_t*)(a.ws + WS_HBUF); float* XC = (float*)(a.ws + WS_XC); bf16_t* YD = (bf16_t*)(a.ws + WS_YD);
    if (ph == 0) { if constexpr (MASK & 1) {
        for (int t = bid; t < 192; t += G) modv_task(a, t, lds);
        for (int t = bid; t < 256; t += G) rope_task(a, t);
        wconv_loop(a, 0, bid, G, lds);
        for (int t = bid; t < 192; t += G) lwconv_task(a, 0, t); }
        return;
    }
    if (ph == 1) { if constexpr (MASK & 2) row_pass(a, MT, nullptr, nullptr, 0, a.in[I_X], a.in[I_CTX], false, nullptr, nullptr, false, nullptr, 0, 0, true, a.in[I_NORMG] + 0, 0, 0, 1); return; }
    const int l = (ph - 2) / 9, s = (ph - 2) % 9;
    const bool last = (l == NL - 1);
    const float* ng = a.in[I_NORMG] + l * 4 * DM;
    const void* xl = l == 0 ? (const void*)a.in[I_X] : (const void*)a.out; const void* xc = l == 0 ? (const void*)a.in[I_CTX] : (const void*)XC;
    void* xmid = last ? (void*)(a.ws + WS_PXA) : (void*)a.out;
    float* YP = (float*)(a.ws + WS_YP);
    const int mpost = last ? ML : MT;
    switch (s) {
    case 0: if constexpr (MASK & 4) { pg8::Gemm g{HB, (const bf16_t*)(a.ws + wbase(l)), MT, NIN, DM, DM}; pg8::StaticOrder S; S.init(MT, NIN, G, bid);
              EpiIn E{(bf16_t*)(a.ws + WS_PXA), (bf16_t*)(a.ws + WS_PXR)};
              pg8::gemm_phase<EpiIn, pg8::StaticOrder, true, true>((PG8_LAS unsigned char*)lds, g, S, E); } break;
    case 1: if constexpr (MASK & 8) { if (bid < PREP_EARLY) { PrepRegs R; prep_issue_loads(R, (const bf16_t*)(a.ws + WS_PXR), prep_tile_of(bid), opaque_tid());
              for (int o = bid; o < PREP_EARLY; o += G) rwkv_prep_tile(a, l, prep_tile_of(o), o + G < PREP_EARLY ? prep_tile_of(o + G) : -1, R, lds); } } break;
    case 2: if constexpr (MASK & 16) { unsigned* pcnt = (unsigned*)(a.ws + WS_CTL) + CW_PREP + 64 * (l * 8);
            if (bid < 128) { for (int rep = 0; rep <= PROBE_SCAN; ++rep) scan_task(a, bid, pcnt, lds); }
            else { { const int w = bid - 128, nw = G - 128;
                if (PREP_EARLY + w < PREP_TILES) { PrepRegs R; prep_issue_loads(R, (const bf16_t*)(a.ws + WS_PXR), prep_tile_of(PREP_EARLY + w), opaque_tid());
                  for (int o = PREP_EARLY + w; o < PREP_TILES; o += nw) { rwkv_prep_tile(a, l, prep_tile_of(o), o + nw < PREP_TILES ? prep_tile_of(o + nw) : -1, R, lds); prep_publish(pcnt + 64 * ((o - PREP_EARLY) / nw)); } } }
            for (int rep = 0; rep <= PROBE_ATT; ++rep) { const int w = bid - 128, nw = G - 128; const int natt = last ? 256 : 272, ngm = last ? 128 : 136;
                for (int u = w; u < natt + ngm; u += nw) { if (u < natt) attn_unit(a, l, u, lds); else gmlp_unit(a, l, u - natt, lds); }
                if (!last && rep == 0) { wconv_loop(a, l + 1, w, nw, lds); for (int t = w; t < 192; t += nw) lwconv_task(a, l + 1, t); } } } } break;
    case 3: if constexpr (MASK & 32) rwkv_out(a, l, mpost); break;
    case 4: if constexpr (MASK & 64) {
              { pg8::Gemm g{HB, (const bf16_t*)(a.ws + wbase(l) + WO_OUT), ML, DM, DM, DM}; pg8::StaticOrder S; S.init(ML, DM, G, bid);
                EpiBf16Out E{YD}; pg8::gemm_phase<EpiBf16Out, pg8::StaticOrder, true, true>((PG8_LAS unsigned char*)lds, g, S, E); }
              if (!last) { const int piece = bid, sl = piece >> 4; PieceOrder S{piece & 15, piece < 64};
                pg8::Gemm g{HB + (size_t)ML * DM + (sl & 3) * 256, (const bf16_t*)(a.ws + wbase(l) + WO_OUT) + (sl & 3) * 256, MC, DM, 256, DM};
                EpiF32 E{YP + (size_t)(sl & 3) * MC * DM}; pg8::gemm_phase<EpiF32, PieceOrder, true, true>((PG8_LAS unsigned char*)lds, g, S, E); } } break;
    case 5: if constexpr (MASK & 2) row_pass(a, mpost, YD, YP, 4, xl, xc, l != 0, xmid, XC, true, ng + 1 * DM, l, 2, true, ng + 2 * DM, l, 3, 4); break;
    case 6: if constexpr (MASK & 128) { pg8::Gemm g{HB, (const bf16_t*)(a.ws + wbase(l) + WO_GU), mpost, 2 * DFF, DM, DM}; pg8::StaticOrder S; S.init(mpost, 2 * DFF, G, bid);
              EpiSwiglu E{(bf16_t*)(a.ws + WS_ACT)}; pg8::gemm_phase<EpiSwiglu, pg8::StaticOrder, true, true>((PG8_LAS unsigned char*)lds, g, S, E); } break;
    case 7: if constexpr (MASK & 512) {
              { pg8::Gemm g{(const bf16_t*)(a.ws + WS_ACT), (const bf16_t*)(a.ws + wbase(l) + WO_DN), ML, DM, DFF, DFF}; pg8::StaticOrder S; S.init(ML, DM, G, bid);
                EpiBf16Out E{YD}; pg8::gemm_phase<EpiBf16Out, pg8::StaticOrder, true, true>((PG8_LAS unsigned char*)lds, g, S, E); }
              if (!last) { const int piece = bid; int sl = piece >> 4; if (sl > 6) sl = 6; PieceOrder S{piece & 15, piece < 112};
                pg8::Gemm g{(const bf16_t*)(a.ws + WS_ACT) + (size_t)ML * DFF + sl * 384, (const bf16_t*)(a.ws + wbase(l) + WO_DN) + sl * 384, MC, DM, sl == 6 ? 512 : 384, DFF};
                EpiF32 E{YP + (size_t)sl * MC * DM}; pg8::gemm_phase<EpiF32, PieceOrder, true, true>((PG8_LAS unsigned char*)lds, g, S, E); } } break;
    case 8: if constexpr (MASK & 256) {
              row_pass(a, mpost, YD, YP, 7, xmid, XC, true, a.out, XC, !last, ng + 3 * DM, l, 5, !last, a.in[I_NORMG] + (last ? 0 : (l + 1) * 4 * DM), last ? 0 : l + 1, 0, 1); } break;
    }
}

template <int MASK> __global__ void __launch_bounds__(NTHR) trunk_fwd(Args args) {
    extern __shared__ __attribute__((aligned(16))) unsigned char lds[];
    cg::grid_group grid = cg::this_grid();
    if (args.ph_lo > args.ph_hi) grid.sync();
    if (threadIdx.x < 4) ((LAS unsigned*)((LAS unsigned char*)lds + LDS_BARST_OFF))[threadIdx.x] = 0u;
    __syncthreads();
    XcdBarrier bar = xcd_barrier_post((unsigned*)(args.ws + WS_CTL), (volatile LAS unsigned*)((LAS unsigned char*)lds + LDS_BARST_OFF));
#define GRID_SYNC() xcd_barrier(bar)
    for (int ph = args.ph_lo; ph < args.ph_hi; ++ph) {
        const int nrep = (ph == PROBE_PH) ? 2 : (PROBE_DUP && ph >= 2) ? 1 + ((PROBE_DUP >> ((ph - 2) % 9)) & 1) : 1;
        for (int rep = 0; rep < nrep; ++rep) {
            run_phase<MASK>(args, ph, lds);
            if (ph + 1 < args.ph_hi || rep + 1 < nrep) GRID_SYNC();
            for (int es = 0; es < PROBE_SYNC; ++es) GRID_SYNC();
        }
    }
}
__host__ inline int phase_mask(int ph) { if (ph == 0) return 1; if (ph == 1) return 2; const int s = (ph - 2) % 9; const int m[9] = {4, 8, 16, 32, 64, 2, 128, 512, 256}; return m[s]; }
__host__ inline const void* kernel_for(int mask) {
#if MK_PER_PHASE
    switch (mask) { case 1: return (const void*)trunk_fwd<1>; case 2: return (const void*)trunk_fwd<2>; case 4: return (const void*)trunk_fwd<4>; case 8: return (const void*)trunk_fwd<8>; case 16: return (const void*)trunk_fwd<16>;
        case 32: return (const void*)trunk_fwd<32>; case 64: return (const void*)trunk_fwd<64>; case 128: return (const void*)trunk_fwd<128>; case 256: return (const void*)trunk_fwd<256>; case 512: return (const void*)trunk_fwd<512>;
        default: return nullptr; }
#else
    (void)mask; return (const void*)trunk_fwd<1023>;
#endif
}

extern "C" void kernel_launch(void* const* d_in, const int* in_sizes, int n_in, void* d_out, int out_size, void* d_ws, size_t ws_size, hipStream_t stream) {
    static int grid = 0;
    if (grid == 0) {
        if (n_in != N_IN || out_size != ML * DM || ws_size < WS_END2) { fprintf(stderr, "kernel_launch: unexpected shapes: n_in %d out %d ws %zu (need %zu)\n", n_in, out_size, ws_size, (size_t)WS_END2); grid = -1; return; }
        int dev = 0, cus = 0, per_cu = 0;
        (void)hipGetDevice(&dev); (void)hipDeviceGetAttribute(&cus, hipDeviceAttributeMultiprocessorCount, dev);
#if MK_PER_PHASE
        for (int mk = 1; mk <= 512; mk <<= 1) {
#else
        for (int mk = 1023; mk <= 1023; ++mk) {
#endif
            if (hipFuncSetAttribute(kernel_for(mk), hipFuncAttributeMaxDynamicSharedMemorySize, LDS_BYTES) != hipSuccess) { fprintf(stderr, "kernel_launch: hipFuncSetAttribute failed\n"); grid = -1; return; }
            if (hipOccupancyMaxActiveBlocksPerMultiprocessor(&per_cu, kernel_for(mk), NTHR, LDS_BYTES) != hipSuccess || per_cu < 1) { fprintf(stderr, "kernel_launch: occupancy query says %d blocks per CU\n", per_cu); grid = -1; return; }
        }
        grid = cus;
        if (grid != 256) fprintf(stderr, "kernel_launch: note: %d CUs (the phase split assumes 256)\n", grid);
    }
    if (grid < 0) return;
    if (hipMemsetAsync((char*)d_ws + WS_CTL, 0, CTL_BYTES, stream) != hipSuccess) { fprintf(stderr, "kernel_launch: memset of the barrier words failed\n"); return; }
    Args a{};
    for (int i = 0; i < N_IN; ++i) a.in[i] = (const float*)d_in[i];
    a.out = (float*)d_out; a.ws = (unsigned char*)d_ws;
#if MK_PER_PHASE
    for (int ph = 0; ph < N_PHASES; ++ph) { a.ph_lo = ph; a.ph_hi = ph + 1; void* kargs[] = {&a};
        hipError_t e = hipLaunchCooperativeKernel(kernel_for(phase_mask(ph)), dim3(grid), dim3(NTHR), kargs, LDS_BYTES, stream);
        if (e != hipSuccess) { fprintf(stderr, "kernel_launch: launch of phase %d failed: %s\n", ph, hipGetErrorString(e)); break; } }
#else
    a.ph_lo = 0; a.ph_hi = N_PHASES; void* kargs[] = {&a};
    hipError_t e = hipLaunchCooperativeKernel(kernel_for(1023), dim3(grid), dim3(NTHR), kargs, LDS_BYTES, stream);
    if (e != hipSuccess) fprintf(stderr, "kernel_launch: cooperative launch failed: %s (grid %d)\n", hipGetErrorString(e), grid);
#endif
}
```
